# Optimizing an MI355X kernel written in HIP

```python
import math
import jax, jax.numpy as jnp
from jax import lax
import numpy as np

D_MODEL = 2048
BATCH = 1
SEQ = 16384
DEPTH = 1
DEC_BATCH = 32
DEC_SEQ = 32
PAST_LEN = 1024

CHUNK = 64
LEFT_CHUNKS = 8
BAND_ROWS = LEFT_CHUNKS * CHUNK
MIX_WIDTH = 2 * D_MODEL
D_SSM = MIX_WIDTH // 2
D_ATT = MIX_WIDTH - D_SSM
SSM_HEADDIM = 64
SSM_HEADS = D_SSM // SSM_HEADDIM
SSM_GROUPS = 4
D_STATE = 128
CONV_WIDTH = 4
CONV_DIM = D_SSM + 2 * SSM_GROUPS * D_STATE
SSD_BLOCK = CHUNK
ATT_HEAD_DIM = 128
ATT_HEADS = D_ATT // ATT_HEAD_DIM
REL_CLIP = 128
N_REL = 2 * REL_CLIP + 1
EPS = 1e-6
D_IN_PROJ = D_SSM + CONV_DIM + SSM_HEADS + 4 * D_ATT
OFF_Z = 0
OFF_XBC = OFF_Z + D_SSM
OFF_DT = OFF_XBC + CONV_DIM
OFF_Q = OFF_DT + SSM_HEADS
OFF_K = OFF_Q + D_ATT
OFF_V = OFF_K + D_ATT
OFF_G = OFF_V + D_ATT

kernel_name = "hybrid_ssd_chunkband_stream_step"


def rms_norm(x, w):
    xf = x.astype(jnp.float32)
    xf = xf * lax.rsqrt(jnp.mean(xf * xf, axis=-1, keepdims=True) + EPS)
    return (xf * w.astype(jnp.float32)).astype(x.dtype)


def ssd_chunked(xh, dt, A, Bm, Cm, init_state, block):
    b, L, H, P = xh.shape
    G, N = Bm.shape[2], Bm.shape[3]
    R = H // G
    nb = L // block
    x5 = xh.astype(jnp.float32).reshape(b, nb, block, G, R, P)
    dt5 = dt.reshape(b, nb, block, G, R)
    B5 = Bm.astype(jnp.float32).reshape(b, nb, block, G, N)
    C5 = Cm.astype(jnp.float32).reshape(b, nb, block, G, N)
    acum = jnp.cumsum(dt5 * A.reshape(G, R), axis=2)
    causal = jnp.tril(jnp.ones((block, block), dtype=bool))
    seg = acum[:, :, :, None] - acum[:, :, None, :]
    decay = jnp.exp(jnp.where(causal[:, :, None, None], seg, -jnp.inf))
    cb = jnp.einsum('bcign,bcjgn->bcijg', C5, B5)
    m = cb[..., None] * decay * dt5[:, :, None]
    y_diag = jnp.einsum('bcijgr,bcjgrp->bcigrp', m, x5)

    def step(S, inp):
        Bc, Cc, xc, dtc, acc = inp
        y_off = jnp.einsum('bign,bgrpn->bigrp', Cc, S) * jnp.exp(acc)[..., None]
        w = jnp.exp(acc[:, -1:] - acc) * dtc
        st = jnp.einsum('bjgn,bjgrp->bgrpn', Bc, xc * w[..., None])
        S = S * jnp.exp(acc[:, -1])[..., None, None] + st
        return S, y_off

    xs = (jnp.moveaxis(B5, 1, 0), jnp.moveaxis(C5, 1, 0), jnp.moveaxis(x5, 1, 0),
          jnp.moveaxis(dt5, 1, 0), jnp.moveaxis(acum, 1, 0))
    S0 = init_state.astype(jnp.float32).reshape(b, G, R, P, N)
    S_final, y_off = lax.scan(step, S0, xs)
    y = y_diag + jnp.moveaxis(y_off, 0, 1)
    return y.reshape(b, L, H, P), S_final.reshape(b, H, P, N)


def band_attention(q, k_full, v_full, rel_bias, q_block, hist_rows, hist_valid):
    b, L, H, hd = q.shape
    n_blocks = L // q_block
    span = hist_rows + q_block
    i_idx = jnp.arange(q_block)[:, None]
    j_idx = jnp.arange(span)[None, :]
    rel = jnp.clip(i_idx + hist_rows - j_idx, -REL_CLIP, REL_CLIP) + REL_CLIP
    bias = rel_bias[:, rel].astype(jnp.float32)
    scale = hd ** -0.5
    key_idx = jnp.arange(span)

    def one_block(c):
        start = c * q_block
        qb = lax.dynamic_slice_in_dim(q, start, q_block, axis=1)
        kb = lax.dynamic_slice_in_dim(k_full, start, span, axis=1)
        vb = lax.dynamic_slice_in_dim(v_full, start, span, axis=1)
        s = jnp.einsum('bqhd,bkhd->bhqk', qb, kb).astype(jnp.float32) * scale + bias
        valid = jnp.logical_or(start + key_idx >= hist_rows, hist_valid)
        s = jnp.where(valid[None, None, None, :], s, -jnp.inf)
        p = jax.nn.softmax(s, axis=-1).astype(vb.dtype)
        return jnp.einsum('bhqk,bkhd->bqhd', p, vb)

    out = lax.map(one_block, jnp.arange(n_blocks))
    return jnp.moveaxis(out, 0, 1).reshape(b, L, H, hd)


def hybrid_layer(x, conv_hist, ssm_init, k_hist, v_hist, hist_valid, ssd_block, att_block,
                 norm_w, w_in, conv_w, conv_b, dt_bias, a_log, d_skip, ssm_norm_w,
                 q_norm_w, k_norm_w, rel_bias, w_out):
    b, L, _ = x.shape
    h = rms_norm(x, norm_w)
    proj = h @ w_in
    z = proj[..., OFF_Z:OFF_XBC]
    xbc = proj[..., OFF_XBC:OFF_DT]
    dt_raw = proj[..., OFF_DT:OFF_Q]
    q = proj[..., OFF_Q:OFF_K]
    k = proj[..., OFF_K:OFF_V]
    v = proj[..., OFF_V:OFF_G]
    g = proj[..., OFF_G:]

    xbc_pad = jnp.concatenate([conv_hist.astype(xbc.dtype), xbc], axis=1)
    conv = conv_b
    for t in range(CONV_WIDTH):
        conv = conv + conv_w[t] * xbc_pad[:, t:t + L]
    xbc_act = jax.nn.silu(conv)
    new_conv = xbc_pad[:, -(CONV_WIDTH - 1):]
    gn = SSM_GROUPS * D_STATE
    xs_h = xbc_act[..., :D_SSM].reshape(b, L, SSM_HEADS, SSM_HEADDIM)
    Bm = xbc_act[..., D_SSM:D_SSM + gn].reshape(b, L, SSM_GROUPS, D_STATE)
    Cm = xbc_act[..., D_SSM + gn:].reshape(b, L, SSM_GROUPS, D_STATE)
    dt = jax.nn.softplus(dt_raw.astype(jnp.float32) + dt_bias.astype(jnp.float32))
    A = -jnp.exp(a_log.astype(jnp.float32))
    y_ssm, new_ssm = ssd_chunked(xs_h, dt, A, Bm, Cm, ssm_init, ssd_block)
    y_ssm = y_ssm + d_skip.astype(jnp.float32)[:, None] * xs_h.astype(jnp.float32)
    y_ssm = y_ssm.reshape(b, L, D_SSM) * jax.nn.silu(z.astype(jnp.float32))
    y_ssm = rms_norm(y_ssm.reshape(b, L, SSM_GROUPS, D_SSM // SSM_GROUPS),
                     ssm_norm_w.reshape(SSM_GROUPS, D_SSM // SSM_GROUPS))
    y_ssm = y_ssm.reshape(b, L, D_SSM).astype(x.dtype)

    qh = rms_norm(q.reshape(b, L, ATT_HEADS, ATT_HEAD_DIM), q_norm_w)
    kh = rms_norm(k.reshape(b, L, ATT_HEADS, ATT_HEAD_DIM), k_norm_w)
    vh = v.reshape(b, L, ATT_HEADS, ATT_HEAD_DIM)
    k_full = jnp.concatenate([k_hist.astype(kh.dtype), kh], axis=1)
    v_full = jnp.concatenate([v_hist.astype(vh.dtype), vh], axis=1)
    att = band_attention(qh, k_full, v_full, rel_bias, att_block, k_hist.shape[1], hist_valid)
    y_att = (att.reshape(b, L, D_ATT) * jax.nn.silu(g)).astype(x.dtype)

    mixed = jnp.concatenate([y_ssm, y_att], axis=-1)
    y = x + mixed @ w_out
    return y, new_conv, new_ssm.astype(x.dtype), kh, vh


def setup_inputs(seed: int = 0) -> dict:
    key = jax.random.key(seed)
    ks = jax.random.split(key, 20)
    band_rows = min(BAND_ROWS, PAST_LEN)
    f32 = jnp.float32
    x_prompt = jax.random.normal(ks[0], (BATCH, SEQ, D_MODEL), f32)
    x_sample = jax.random.normal(ks[1], (DEC_BATCH, DEC_SEQ, D_MODEL), f32)
    state_conv = jax.random.normal(ks[2], (DEPTH, DEC_BATCH, CONV_WIDTH - 1, CONV_DIM), f32)
    state_ssm = 0.1 * jax.random.normal(ks[3], (DEPTH, DEC_BATCH, SSM_HEADS, SSM_HEADDIM, D_STATE), f32)
    cache_k = jax.random.normal(ks[4], (DEPTH, DEC_BATCH, band_rows, ATT_HEADS, ATT_HEAD_DIM), f32)
    cache_v = jax.random.normal(ks[5], (DEPTH, DEC_BATCH, band_rows, ATT_HEADS, ATT_HEAD_DIM), f32)
    norm_w = 1.0 + 0.02 * jax.random.normal(ks[6], (DEPTH, D_MODEL), f32)
    w_in = jax.random.normal(ks[7], (DEPTH, D_MODEL, D_IN_PROJ), f32) * D_MODEL ** -0.5
    conv_w = jax.random.normal(ks[8], (DEPTH, CONV_WIDTH, CONV_DIM), f32) * CONV_WIDTH ** -0.5
    conv_b = 0.02 * jax.random.normal(ks[9], (DEPTH, CONV_DIM), f32)
    dt0 = jnp.exp(jax.random.uniform(ks[10], (DEPTH, SSM_HEADS), f32,
                                     minval=math.log(1e-3), maxval=math.log(1e-1)))
    dt_bias = dt0 + jnp.log(-jnp.expm1(-dt0))
    a_log = jnp.log(jax.random.uniform(ks[11], (DEPTH, SSM_HEADS), f32, minval=1.0, maxval=16.0))
    d_skip = 1.0 + 0.1 * jax.random.normal(ks[12], (DEPTH, SSM_HEADS), f32)
    ssm_norm_w = 1.0 + 0.02 * jax.random.normal(ks[13], (DEPTH, D_SSM), f32)
    q_norm_w = 1.0 + 0.02 * jax.random.normal(ks[14], (DEPTH, ATT_HEAD_DIM), f32)
    k_norm_w = 1.0 + 0.02 * jax.random.normal(ks[15], (DEPTH, ATT_HEAD_DIM), f32)
    rel_bias = 0.1 * jax.random.normal(ks[16], (DEPTH, ATT_HEADS, N_REL), f32)
    w_out = jax.random.normal(ks[17], (DEPTH, MIX_WIDTH, D_MODEL), f32) * MIX_WIDTH ** -0.5
    return {"x_prompt": x_prompt, "x_sample": x_sample,
            "state_conv": state_conv, "state_ssm": state_ssm,
            "cache_k": cache_k, "cache_v": cache_v,
            "norm_w": norm_w, "w_in": w_in, "conv_w": conv_w, "conv_b": conv_b,
            "dt_bias": dt_bias, "a_log": a_log, "d_skip": d_skip, "ssm_norm_w": ssm_norm_w,
            "q_norm_w": q_norm_w, "k_norm_w": k_norm_w, "rel_bias": rel_bias, "w_out": w_out}


def reference(x_prompt, x_sample, state_conv, state_ssm, cache_k, cache_v,
              norm_w, w_in, conv_w, conv_b, dt_bias, a_log, d_skip, ssm_norm_w,
              q_norm_w, k_norm_w, rel_bias, w_out):
    bp, Lp, _ = x_prompt.shape
    Ls = x_sample.shape[1]
    keep = min(BAND_ROWS, Lp)
    xp = x_prompt
    xs = x_sample
    p_conv, p_ssm, p_k, p_v = [], [], [], []
    s_conv, s_ssm, s_k, s_v = [], [], [], []
    for l in range(DEPTH):
        params = (norm_w[l], w_in[l], conv_w[l], conv_b[l], dt_bias[l], a_log[l], d_skip[l],
                  ssm_norm_w[l], q_norm_w[l], k_norm_w[l], rel_bias[l], w_out[l])
        zc = jnp.zeros((bp, CONV_WIDTH - 1, CONV_DIM), xp.dtype)
        zs = jnp.zeros((bp, SSM_HEADS, SSM_HEADDIM, D_STATE), jnp.float32)
        zk = jnp.zeros((bp, BAND_ROWS, ATT_HEADS, ATT_HEAD_DIM), xp.dtype)
        xp, c1, s1, k1, v1 = hybrid_layer(xp, zc, zs, zk, zk, False, SSD_BLOCK, CHUNK, *params)
        p_conv.append(c1)
        p_ssm.append(s1)
        p_k.append(k1[:, Lp - keep:])
        p_v.append(v1[:, Lp - keep:])
        xs, c2, s2, k2, v2 = hybrid_layer(xs, state_conv[l], state_ssm[l], cache_k[l], cache_v[l],
                                          True, Ls, Ls, *params)
        s_conv.append(c2)
        s_ssm.append(s2)
        s_k.append(k2)
        s_v.append(v2)
    return (xp, xs,
            jnp.stack(p_conv), jnp.stack(p_ssm), jnp.stack(p_k), jnp.stack(p_v),
            jnp.stack(s_conv), jnp.stack(s_ssm), jnp.stack(s_k), jnp.stack(s_v))
```

```cpp
#include <hip/hip_runtime.h>
#include <cstdio>
#include <cstdint>
constexpr int TP = 16384, TS = 1024, MTOK = TP + TS;
constexpr int DM = 2048, DSSM = 2048, DATT = 2048, CONVD = 3072, NHS = 32, NHA = 16, HD = 128, PH = 64, NST = 128;
constexpr int NIN = 13312;
constexpr int SRC_LD = 13344;
constexpr float EPS = 1e-6f;
constexpr size_t O_YP = 0, O_YS = 33554432, O_PCONV = 35651584, O_PSSM = 35660800, O_PK = 35922944, O_PV = 36971520, O_SCONV = 38020096, O_SSSM = 38315008, O_SK = 46703616, O_SV = 48800768, O_END = 50897920;
constexpr size_t MiB = 1u << 20;
constexpr size_t WS_CTL = 0, CTL_ZERO_BYTES = 1 * MiB;
constexpr size_t WS_H = 1 * MiB;
constexpr size_t WS_WIN = WS_H + 68 * MiB;
constexpr size_t WS_WDT = WS_WIN + 52 * MiB;
constexpr size_t WS_WOUT = WS_WDT + 1 * MiB;
constexpr size_t WS_ZQ = WS_WOUT + 16 * MiB;
constexpr size_t WS_K = WS_ZQ + 136 * MiB;
constexpr size_t WS_V = WS_K + 68 * MiB;
constexpr size_t WS_G = WS_V + 68 * MiB;
constexpr size_t WS_DT = WS_G + 68 * MiB;
constexpr size_t WS_RSTD = WS_DT + 3 * MiB;
constexpr size_t WS_END = WS_RSTD + 1 * MiB;
constexpr size_t WS_SEG = WS_H;
constexpr size_t WS_SEGDEC = WS_RSTD + 512 * 1024;
constexpr int CW_TMO = 0, CW_CODE = 1, CW_BAR = 4096;
constexpr int RING_OFF = 0, RING_BYTES = 131072;
constexpr int LDSCTL_OFF = 155648, MISC_OFF = LDSCTL_OFF + 320;
constexpr int EPI_P_OFF = 131072;
constexpr int LDS_BYTES = 160 * 1024;
constexpr int NWAVES = 8;
namespace pg8 {
#define PG8_LAS __attribute__((address_space(3)))
typedef unsigned short bf16_t;
typedef short bf16x8 __attribute__((ext_vector_type(8)));
typedef float f32x4 __attribute__((ext_vector_type(4)));
typedef unsigned u32x4 __attribute__((ext_vector_type(4)));
constexpr int BM = 256, BK = 64, HALF = 128, HTB = HALF * BK * 2  , STAGE_BYTES = 8 * HTB, NXCD = 8, WGM = 8;

__host__ __device__ __forceinline__ int lds_byte(int r, int c) { const int st = (r >> 4) * 2 + (c >> 5), rr = r & 15, cc = c & 31, ob = rr * 64 + cc * 2; return st * 1024 + (ob ^ (((ob >> 9) & 1) << 5)); }
__host__ __device__ __forceinline__ void stage_rc(int b, int& R, int& C) { const int st = b / 1024, sb = b % 1024, swz = sb ^ (((sb >> 9) & 1) << 5); R = (st >> 1) * 16 + swz / 64; C = (st & 1) * 32 + (swz % 64) / 2; }
__host__ __device__ __forceinline__ int perm32(int rho) { const int n = rho >> 4, i = rho & 15; return 8 * (i >> 2) + 4 * n + (i & 3); }

struct Unit { int pm, pn; };
struct Gemm { const bf16_t* A; const bf16_t* Bt; int M, N, K; };

struct StaticOrder {
    int nM, nN, nwg, G, c;
    __host__ __device__ void init(int M, int N, int G_, int c_) { nM = M / BM; nN = N / BM; nwg = nM * nN; G = G_; c = c_; }
    __host__ __device__ bool next(int i, Unit& u) const {
        const long L = (long)i * G + c; if (L >= nwg) return false;
        int wgid = (int)L; { const int q = nwg / NXCD, r = nwg % NXCD, xcd = wgid % NXCD, off = wgid / NXCD; wgid = (xcd < r ? xcd * (q + 1) : r * (q + 1) + (xcd - r) * q) + off; }
        const int nig = WGM * nN, gid = wgid / nig, fm = gid * WGM, gsz = (nM - fm) < WGM ? (nM - fm) : WGM;
        u.pm = fm + ((wgid % nig) % gsz); u.pn = (wgid % nig) / gsz; return true;
    }
    __device__ __forceinline__ void a_ready(const Unit&) const {}
    __device__ __forceinline__ void done(const Unit&) const {}
};

__device__ __forceinline__ unsigned cvt_pk_bf16(float lo, float hi) { unsigned r; asm volatile("v_cvt_pk_bf16_f32 %0, %1, %2" : "=v"(r) : "v"(lo), "v"(hi)); return r; }
template <class Epi, class Sched, bool ALIGN_EPI = false, bool SP2 = false>
__device__ __forceinline__ void gemm_phase(PG8_LAS unsigned char* lds, const Gemm g, const Sched& S, const Epi& E) {
    const int tid = threadIdx.x, wid = __builtin_amdgcn_readfirstlane(tid >> 6), lane = tid & 63, wr = wid >> 2, wc = wid & 3, fr = lane & 15, fq = lane >> 4;
    const int K = g.K, nt = K / BK;
    unsigned voffA[2], voffB[2];
#pragma unroll
    for (int i = 0; i < 2; ++i) { int R, C; stage_rc(tid * 16 + i * 8192, R, C); const int Rb = Epi::PERM ? ((R & ~31) + perm32(R & 31)) : R;
        voffA[i] = (unsigned)(R * K + C) * 2u; voffB[i] = (unsigned)(Rb * K + C) * 2u; }
    const size_t kstep = (size_t)(BK * 2);
    const size_t hstep = (size_t)HALF * K * 2;
    const size_t tstep = 2 * hstep;
    const unsigned ldsw = (unsigned)wid * 1024u;
    const int aoff = lds_byte(wr * 64 + fr, fq * 8), boff = lds_byte(wc * 32 + fr, fq * 8);
#define PG8_SA(b, h) (((b) * 2 + (h)) * HTB)
#define PG8_SB(b, h) ((4 + (b) * 2 + (h)) * HTB)
#define PG8_STAGE(bufoff, gbase, voff) do { _Pragma("unroll") for (int _i = 0; _i < 2; ++_i) \
        __builtin_amdgcn_global_load_lds((const unsigned*)((const char*)(gbase) + (voff)[_i]), (PG8_LAS unsigned*)(lds + (bufoff) + ldsw + _i * 8192), 16, 0, 0); } while (0)
#define PG8_LDA(dst, b, h) do { _Pragma("unroll") for (int m = 0; m < 4; ++m) _Pragma("unroll") for (int k = 0; k < 2; ++k) dst[m][k] = *(const PG8_LAS bf16x8*)(lds + PG8_SA(b, h) + aoff + m * 2048 + k * 1024); } while (0)
#define PG8_LDB(dst, b, h) do { _Pragma("unroll") for (int n = 0; n < 2; ++n) _Pragma("unroll") for (int k = 0; k < 2; ++k) dst[n][k] = *(const PG8_LAS bf16x8*)(lds + PG8_SB(b, h) + boff + n * 2048 + k * 1024); } while (0)
#define PG8_MMA(ai, bj, At, Bt) do { __builtin_amdgcn_s_setprio(1); _Pragma("unroll") for (int m = 0; m < 4; ++m) _Pragma("unroll") for (int n = 0; n < 2; ++n) _Pragma("unroll") for (int k = 0; k < 2; ++k) \
        acc[ai][bj][m][n] = __builtin_amdgcn_mfma_f32_16x16x32_bf16(Bt[n][k], At[m][k], acc[ai][bj][m][n], 0, 0, 0); __builtin_amdgcn_s_setprio(0); } while (0)
#define PG8_WAIT_V(n) asm volatile("s_waitcnt vmcnt(" #n ")" ::: "memory")
#define PG8_WAIT_L(n) asm volatile("s_waitcnt lgkmcnt(" #n ")" ::: "memory")
#define PG8_BAR __builtin_amdgcn_s_barrier()
#define PG8_SCHED __builtin_amdgcn_sched_barrier(0)
    Unit cur, nxt; int ui = 0;
    if (!S.next(0, cur)) return;
    f32x4 acc[2][2][4][2];
#pragma unroll
    for (int a = 0; a < 2; ++a)
#pragma unroll
        for (int b = 0; b < 2; ++b)
#pragma unroll
            for (int m = 0; m < 4; ++m)
#pragma unroll
                for (int n = 0; n < 2; ++n) acc[a][b][m][n] = (f32x4){0.f, 0.f, 0.f, 0.f};
    bf16x8 At[4][2], B0[2][2], B1[2][2];
    const char* cA = (const char*)g.A + (size_t)cur.pm * tstep; const char* cB = (const char*)g.Bt + (size_t)cur.pn * tstep;
    S.a_ready(cur);
    if constexpr (SP2) {
        PG8_STAGE(PG8_SB(0, 0), cB, voffB); PG8_STAGE(PG8_SB(0, 1), cB + hstep, voffB); PG8_STAGE(PG8_SA(0, 0), cA, voffA); PG8_STAGE(PG8_SA(0, 1), cA + hstep, voffA);
        if (wr == 1) PG8_BAR;
        PG8_WAIT_V(2); PG8_BAR;
        PG8_STAGE(PG8_SB(1, 0), cB + kstep, voffB); PG8_STAGE(PG8_SA(1, 0), cA + kstep, voffA); PG8_STAGE(PG8_SB(1, 1), cB + hstep + kstep, voffB);
        PG8_WAIT_V(6); PG8_BAR;
    } else {
        PG8_STAGE(PG8_SB(0, 0), cB, voffB); PG8_STAGE(PG8_SA(0, 0), cA, voffA); PG8_STAGE(PG8_SB(0, 1), cB + hstep, voffB); PG8_STAGE(PG8_SA(0, 1), cA + hstep, voffA);
        if (wr == 1) PG8_BAR;
        PG8_WAIT_V(4); PG8_BAR;
        PG8_STAGE(PG8_SB(1, 0), cB + kstep, voffB); PG8_STAGE(PG8_SA(1, 0), cA + kstep, voffA); PG8_STAGE(PG8_SB(1, 1), cB + hstep + kstep, voffB);
        PG8_WAIT_V(6); PG8_BAR;
    }
    for (;;) {
        const bool has_next = S.next(ui + 1, nxt);
        const char* nA = has_next ? (const char*)g.A + (size_t)nxt.pm * tstep : cA; const char* nB = has_next ? (const char*)g.Bt + (size_t)nxt.pn * tstep : cB;
        for (int t = 0; t < nt; t += 2) {
            const bool last = (t == nt - 2);
            const char* a1 = cA + (size_t)(t + 1) * kstep;
            const char* a2 = last ? nA : cA + (size_t)(t + 2) * kstep; const char* b2 = last ? nB : cB + (size_t)(t + 2) * kstep;
            const char* a3 = a2 + kstep; const char* b3 = b2 + kstep;
            if (last && has_next) S.a_ready(nxt);
            if constexpr (SP2) {
            PG8_LDB(B0, 0, 0); PG8_LDB(B1, 0, 1); PG8_SCHED; PG8_LDA(At, 0, 0); PG8_STAGE(PG8_SA(1, 1), a1 + hstep, voffA);
            PG8_WAIT_V(8); PG8_WAIT_L(0); PG8_BAR; PG8_MMA(0, 0, At, B0); PG8_MMA(0, 1, At, B1); PG8_BAR; PG8_SCHED;
            PG8_LDA(At, 0, 1); PG8_STAGE(PG8_SB(0, 0), b2, voffB); PG8_STAGE(PG8_SB(0, 1), b2 + hstep, voffB); PG8_STAGE(PG8_SA(0, 0), a2, voffA);
            PG8_WAIT_V(8); PG8_WAIT_L(0); PG8_BAR; PG8_MMA(1, 0, At, B0); PG8_MMA(1, 1, At, B1); PG8_BAR; PG8_SCHED;
            PG8_LDB(B0, 1, 0); PG8_LDB(B1, 1, 1); PG8_SCHED; PG8_LDA(At, 1, 0); PG8_STAGE(PG8_SA(0, 1), a2 + hstep, voffA);
            PG8_WAIT_V(8); PG8_WAIT_L(0); PG8_BAR; PG8_MMA(0, 0, At, B0); PG8_MMA(0, 1, At, B1); PG8_BAR; PG8_SCHED;
            PG8_LDA(At, 1, 1); PG8_STAGE(PG8_SB(1, 0), b3, voffB); PG8_STAGE(PG8_SB(1, 1), b3 + hstep, voffB); PG8_STAGE(PG8_SA(1, 0), a3, voffA);
            PG8_WAIT_V(8); PG8_WAIT_L(0); PG8_BAR; PG8_MMA(1, 0, At, B0); PG8_MMA(1, 1, At, B1); PG8_BAR; PG8_SCHED;
            } else {
            PG8_LDB(B0, 0, 0); PG8_SCHED; PG8_LDA(At, 0, 0); PG8_STAGE(PG8_SA(1, 1), a1 + hstep, voffA);
            PG8_WAIT_L(8); PG8_BAR; PG8_WAIT_L(0); PG8_MMA(0, 0, At, B0); PG8_BAR; PG8_SCHED;
            PG8_LDB(B1, 0, 1); PG8_STAGE(PG8_SB(0, 0), b2, voffB);
            PG8_BAR; PG8_WAIT_L(0); PG8_MMA(0, 1, At, B1); PG8_BAR;
            PG8_LDA(At, 0, 1); PG8_STAGE(PG8_SA(0, 0), a2, voffA);
            PG8_BAR; PG8_WAIT_L(0); PG8_MMA(1, 0, At, B0); PG8_BAR; PG8_SCHED;
            PG8_STAGE(PG8_SB(0, 1), b2 + hstep, voffB);
            PG8_WAIT_V(6); PG8_BAR; PG8_MMA(1, 1, At, B1); PG8_BAR;
            PG8_LDB(B0, 1, 0); PG8_SCHED; PG8_LDA(At, 1, 0); PG8_STAGE(PG8_SA(0, 1), a2 + hstep, voffA);
            PG8_WAIT_L(8); PG8_BAR; PG8_WAIT_L(0); PG8_MMA(0, 0, At, B0); PG8_BAR; PG8_SCHED;
            PG8_LDB(B1, 1, 1); PG8_STAGE(PG8_SB(1, 0), b3, voffB);
            PG8_BAR; PG8_WAIT_L(0); PG8_MMA(0, 1, At, B1); PG8_BAR;
            PG8_LDA(At, 1, 1); PG8_STAGE(PG8_SA(1, 0), a3, voffA);
            PG8_BAR; PG8_WAIT_L(0); PG8_MMA(1, 0, At, B0); PG8_BAR; PG8_SCHED;
            PG8_STAGE(PG8_SB(1, 1), b3 + hstep, voffB);
            PG8_WAIT_V(6); PG8_BAR; PG8_MMA(1, 1, At, B1); PG8_BAR;
            }
        }
        if constexpr (ALIGN_EPI) { if (wr == 0) PG8_BAR; }
        if constexpr (!Epi::AFTER_DRAIN) { E(acc, cur, wr, wc, fr, fq); S.done(cur); }
        if (!has_next) break;
#pragma unroll
        for (int a = 0; a < 2; ++a)
#pragma unroll
            for (int b = 0; b < 2; ++b)
#pragma unroll
                for (int m = 0; m < 4; ++m)
#pragma unroll
                    for (int n = 0; n < 2; ++n) acc[a][b][m][n] = (f32x4){0.f, 0.f, 0.f, 0.f};
        cur = nxt; cA = nA; cB = nB; ++ui;
        if constexpr (ALIGN_EPI) { if (wr == 1) PG8_BAR; }
    }
    PG8_WAIT_V(0);
    if constexpr (!ALIGN_EPI) { if (wr == 0) PG8_BAR; }
    PG8_BAR;
    if constexpr (Epi::AFTER_DRAIN) { E.fused(acc, cur, wr, wc, fr, fq, lds, wid, lane); S.done(cur); }
#undef PG8_SA
#undef PG8_SB
#undef PG8_STAGE
#undef PG8_LDA
#undef PG8_LDB
#undef PG8_MMA
#undef PG8_WAIT_V
#undef PG8_WAIT_L
#undef PG8_BAR
#undef PG8_SCHED
}
}

#ifndef PG8_SP2
#define PG8_SP2 true
#endif
#ifndef PG8_ALIGN
#define PG8_ALIGN true
#endif
namespace pg8 {
__device__ __forceinline__ float silu_f(float v) { return v * __builtin_amdgcn_rcpf(1.0f + __builtin_amdgcn_exp2f(-1.4426950408889634f * v)); }
__device__ __forceinline__ u32x4 pack8(const f32x4& a, const f32x4& b) { u32x4 w; w.x = cvt_pk_bf16(a[0], a[1]); w.y = cvt_pk_bf16(a[2], a[3]); w.z = cvt_pk_bf16(b[0], b[1]); w.w = cvt_pk_bf16(b[2], b[3]); return w; }
struct EpiIn {
    static constexpr bool PERM = true, AFTER_DRAIN = false;
    const float* rstd; bf16_t* ZQ; bf16_t* XBC; bf16_t* Kb; bf16_t* Vb; bf16_t* Gb; const float* qw; const float* kw; float* out; PG8_LAS float* P;
    __device__ __forceinline__ void operator()(f32x4 (&acc)[2][2][4][2], const Unit& u, int wr, int wc, int fr, int fq) const {
        const int pn = u.pn, rbase = u.pm * BM + wr * 64 + fr, lc = wc * 32 + 8 * fq;
#pragma unroll
        for (int ai = 0; ai < 2; ++ai)
#pragma unroll
            for (int m = 0; m < 4; ++m) { const float rs = rstd[rbase + ai * HALF + m * 16];
#pragma unroll
                for (int bj = 0; bj < 2; ++bj) { acc[ai][bj][m][0] = acc[ai][bj][m][0] * rs; acc[ai][bj][m][1] = acc[ai][bj][m][1] * rs; } }
        if (pn < 8 || pn >= 44) {
            bf16_t* base = pn < 8 ? ZQ + pn * BM + lc : Gb + (pn - 44) * BM + lc; const int ld = pn < 8 ? 4096 : 2048;
#pragma unroll
            for (int ai = 0; ai < 2; ++ai)
#pragma unroll
                for (int m = 0; m < 4; ++m) { bf16_t* rowp = base + (size_t)(rbase + ai * HALF + m * 16) * ld;
#pragma unroll
                    for (int bj = 0; bj < 2; ++bj) { f32x4 a = acc[ai][bj][m][0], b = acc[ai][bj][m][1];
#pragma unroll
                        for (int e = 0; e < 4; ++e) { a[e] = silu_f(a[e]); b[e] = silu_f(b[e]); }
                        *(u32x4*)(rowp + bj * HALF) = pack8(a, b); } }
        } else if (pn < 20) {
            const int cx = (pn - 8) * BM + lc;
#pragma unroll
            for (int ai = 0; ai < 2; ++ai)
#pragma unroll
                for (int m = 0; m < 4; ++m) { const int row = rbase + ai * HALF + m * 16; bf16_t* rowp = XBC + (size_t)row * CONVD + cx;
#pragma unroll
                    for (int bj = 0; bj < 2; ++bj) *(u32x4*)(rowp + bj * HALF) = pack8(acc[ai][bj][m][0], acc[ai][bj][m][1]);
                    if ((m & 1) && fr >= 13 && row >= TP - 3) {
                        float* o = row < TP ? out + O_PCONV + (size_t)(row - (TP - 3)) * CONVD + cx
                                            : out + O_SCONV + (size_t)(((row - TP) >> 5) * 3 + ((row & 31) - 29)) * CONVD + cx;
#pragma unroll
                        for (int bj = 0; bj < 2; ++bj) { *(f32x4*)(o + bj * HALF) = acc[ai][bj][m][0]; *(f32x4*)(o + bj * HALF + 4) = acc[ai][bj][m][1]; } } }
        } else if (pn < 36) {
            const bool isq = pn < 28;
#pragma unroll
            for (int ai = 0; ai < 2; ++ai)
#pragma unroll
                for (int m = 0; m < 4; ++m)
#pragma unroll
                    for (int bj = 0; bj < 2; ++bj) { const f32x4 a = acc[ai][bj][m][0], b = acc[ai][bj][m][1];
                        float s = (a[0] * a[0] + a[1] * a[1]) + (a[2] * a[2] + a[3] * a[3]) + (b[0] * b[0] + b[1] * b[1]) + (b[2] * b[2] + b[3] * b[3]);
                        s += __shfl_xor(s, 16); s += __shfl_xor(s, 32);
                        if (fq == 0) P[((ai * HALF + wr * 64 + m * 16 + fr) * 2 + bj) * 4 + wc] = s; }
            asm volatile("s_waitcnt lgkmcnt(0)" ::: "memory"); __builtin_amdgcn_s_barrier(); asm volatile("" ::: "memory");
            const float* nw = isq ? qw : kw; const f32x4 w0 = *(const f32x4*)(nw + lc), w1 = *(const f32x4*)(nw + lc + 4);
            const float extra = isq ? 0.1275174313f : 1.0f;
            bf16_t* base = isq ? ZQ + 2048 + (pn - 20) * BM + lc : Kb + (pn - 28) * BM + lc; const int ld = isq ? 4096 : 2048;
            const int ck = (pn - 28) * BM + lc;
#pragma unroll
            for (int ai = 0; ai < 2; ++ai)
#pragma unroll
                for (int m = 0; m < 4; ++m) { const int row = rbase + ai * HALF + m * 16; bf16_t* rowp = base + (size_t)row * ld;
#pragma unroll
                    for (int bj = 0; bj < 2; ++bj) { const f32x4 p4 = *(const PG8_LAS f32x4*)(P + ((ai * HALF + wr * 64 + m * 16 + fr) * 2 + bj) * 4);
                        const float sc = __builtin_amdgcn_rsqf(((p4[0] + p4[1]) + (p4[2] + p4[3])) * (1.0f / 128.0f) + EPS) * extra;
                        const f32x4 a = acc[ai][bj][m][0] * sc * w0, b = acc[ai][bj][m][1] * sc * w1;
                        *(u32x4*)(rowp + bj * HALF) = pack8(a, b);
                        if (!isq && row >= TP - 512) { float* o = (row < TP ? out + O_PK + (size_t)(row - (TP - 512)) * 2048 : out + O_SK + (size_t)(row - TP) * 2048) + ck + bj * HALF;
                            *(f32x4*)o = a; *(f32x4*)(o + 4) = b; } } }
        } else {
            const int cv = (pn - 36) * BM + lc;
#pragma unroll
            for (int ai = 0; ai < 2; ++ai)
#pragma unroll
                for (int m = 0; m < 4; ++m) { const int row = rbase + ai * HALF + m * 16; bf16_t* rowp = Vb + (size_t)row * 2048 + cv;
#pragma unroll
                    for (int bj = 0; bj < 2; ++bj) { *(u32x4*)(rowp + bj * HALF) = pack8(acc[ai][bj][m][0], acc[ai][bj][m][1]);
                        if (row >= TP - 512) { float* o = (row < TP ? out + O_PV + (size_t)(row - (TP - 512)) * 2048 : out + O_SV + (size_t)(row - TP) * 2048) + cv + bj * HALF;
                            *(f32x4*)o = acc[ai][bj][m][0]; *(f32x4*)(o + 4) = acc[ai][bj][m][1]; } } }
        }
    }
};
struct EpiOut {
    static constexpr bool PERM = false, AFTER_DRAIN = false;
    const float* xp; const float* xs; float* out;
    __device__ __forceinline__ void operator()(f32x4 (&acc)[2][2][4][2], const Unit& u, int wr, int wc, int fr, int fq) const {
        const int row0 = u.pm * BM + wr * 64 + fr, col0 = u.pn * BM + wc * 32 + 4 * fq;
        const float* xb = u.pm < TP / BM ? xp + (size_t)row0 * DM : xs + (size_t)(row0 - TP) * DM;
        float* ob = out + (size_t)row0 * DM;
#pragma unroll
        for (int ai = 0; ai < 2; ++ai)
#pragma unroll
            for (int m = 0; m < 4; ++m) { const size_t off = (size_t)(ai * HALF + m * 16) * DM + col0;
#pragma unroll
                for (int bj = 0; bj < 2; ++bj)
#pragma unroll
                    for (int n = 0; n < 2; ++n) { const f32x4 xv = *(const f32x4*)(xb + off + bj * HALF + n * 16); *(f32x4*)(ob + off + bj * HALF + n * 16) = acc[ai][bj][m][n] + xv; } }
    }
};
}
#define GAS __attribute__((address_space(1)))
#define LAS __attribute__((address_space(3)))
typedef unsigned short bf16;
typedef unsigned v4u __attribute__((ext_vector_type(4)));
typedef float f32x4 __attribute__((ext_vector_type(4)));
typedef short bf16x8 __attribute__((ext_vector_type(8)));
typedef GAS unsigned gu32;
typedef GAS unsigned long long gu64;
#define RLX_AGENT __ATOMIC_RELAXED, __HIP_MEMORY_SCOPE_AGENT
#define LDS_WAIT() asm volatile("s_waitcnt lgkmcnt(0)" ::: "memory")
#define VM_WAIT() asm volatile("s_waitcnt vmcnt(0)" ::: "memory")
__device__ __forceinline__ unsigned long long rt() { return __builtin_amdgcn_s_memrealtime(); }
__device__ __forceinline__ unsigned f2bf(float f) { unsigned u = __builtin_bit_cast(unsigned, f); return (u + 0x7fffu + ((u >> 16) & 1u)) >> 16; }
__device__ __forceinline__ unsigned pk2(float lo, float hi) { return f2bf(lo) | (f2bf(hi) << 16); }

#define XB_TMO      128
#define XB_XCNT(j)  (256  + 64 * (j))
#define XB_XSUB(j)  (1280 + 64 * (j))
#define XB_XGEN(j)  (2304 + 64 * (j))
#define XB_TOP      3328
#define XB_TOPGEN   3392
#define XCD_BAR_WORDS 3456
#define XB_SPIN_CAP (1u << 18)

__device__ __forceinline__ unsigned xb_ld(unsigned* p)              { return __hip_atomic_load(p, __ATOMIC_RELAXED, __HIP_MEMORY_SCOPE_AGENT); }
__device__ __forceinline__ unsigned xb_add(unsigned* p, unsigned v) { return __hip_atomic_fetch_add(p, v, __ATOMIC_RELAXED, __HIP_MEMORY_SCOPE_AGENT); }
__device__ __forceinline__ unsigned xb_xcc_id() { return (unsigned)__builtin_amdgcn_s_getreg((3 << 11) | 20) & 0xFu; }
#define XB_SPIN(cond, bar) do { unsigned _sp = 0; while (cond) { __builtin_amdgcn_s_sleep(1); \
    if ((++_sp & 255u) == 0u) { if (xb_ld(&(bar)[XB_TMO])) break; if (_sp > XB_SPIN_CAP) { atomicAdd(&(bar)[XB_TMO], 1u); break; } } } } while (0)

struct XcdBarrier {
    unsigned* bar; unsigned x;
    volatile LAS unsigned* st;
};

__device__ __forceinline__ XcdBarrier xcd_barrier_post(unsigned* bar, volatile LAS unsigned* st) {
    XcdBarrier b; b.bar = bar; b.x = xb_xcc_id(); b.st = st;
    if (threadIdx.x == 0) (void)xb_add(&bar[XB_XCNT(b.x)], 1u);
    return b;
}
__device__ __forceinline__ void xcd_barrier_complete(unsigned* bar, unsigned x, unsigned& nloc, unsigned& nx) {
    const unsigned G = gridDim.x * gridDim.y * gridDim.z;
    unsigned sum, cnt, mine, sp = 0u;
    for (;;) {
        sum = 0u; cnt = 0u; mine = 0u;
#pragma unroll
        for (unsigned j = 0; j < 16; ++j) { const unsigned c = xb_ld(&bar[XB_XCNT(j)]); sum += c; cnt += (c > 0u) ? 1u : 0u; mine = (j == x) ? c : mine; }
        if (sum == G) break;
        __builtin_amdgcn_s_sleep(1);
        if ((++sp & 255u) == 0u) { if (xb_ld(&bar[XB_TMO])) break; if (sp > XB_SPIN_CAP) { atomicAdd(&bar[XB_TMO], 1u); break; } }
    }
    nloc = mine > 0u ? mine : 1u; nx = cnt > 0u ? cnt : 1u;
}

__device__ __forceinline__ void xcd_barrier(const XcdBarrier& b) {
    asm volatile("s_waitcnt vmcnt(0)" ::: "memory");
    __syncthreads();
    if (threadIdx.x == 0) {
        unsigned* bar = b.bar;
        __builtin_amdgcn_s_waitcnt(0);
        unsigned nloc = b.st[0], nx = b.st[1];
        if (nloc == 0u) { xcd_barrier_complete(bar, b.x, nloc, nx); b.st[0] = nloc; b.st[1] = nx; }
        const unsigned old = xb_add(&bar[XB_XSUB(b.x)], 1u);
        const unsigned gen = old / nloc;
        if (old + 1u == (gen + 1u) * nloc) {
            __builtin_amdgcn_fence(__ATOMIC_RELEASE, "agent");
            asm volatile("s_waitcnt vmcnt(0)" ::: "memory");
            const unsigned og = xb_add(&bar[XB_TOP], 1u);
            const unsigned tg = og / nx;
            if (og + 1u == (tg + 1u) * nx) xb_add(&bar[XB_TOPGEN], 1u);
            else XB_SPIN(xb_ld(&bar[XB_TOPGEN]) == tg, bar);
            __builtin_amdgcn_fence(__ATOMIC_ACQUIRE, "agent");
            xb_add(&bar[XB_XGEN(b.x)], 1u);
            asm volatile("s_waitcnt vmcnt(0)" ::: "memory");
        } else {
            XB_SPIN(xb_ld(&bar[XB_XGEN(b.x)]) == gen, bar);
            __builtin_amdgcn_fence(__ATOMIC_ACQUIRE, "agent");
            asm volatile("s_waitcnt vmcnt(0)" ::: "memory");
        }
    }
    __syncthreads();
}

struct Frame {
    LAS unsigned char* lds; volatile LAS unsigned* MISC; gu32* ctl;
    int tid, lane, wave, vcu, G;
};
__device__ __forceinline__ float wave_sum(float v) {
#pragma unroll
    for (int o = 1; o < 64; o <<= 1) v += __shfl_xor(v, o);
    return v;
}
__device__ __forceinline__ void p0_transpose_item(const float* W, size_t ldw, int k0, int n0, bf16* dst, size_t ldt, const float* sc, LAS float* scr, int lane) {
#pragma unroll 8
    for (int i = 0; i < 32; ++i) { const int kk = 2 * i + (lane >> 5); float v = W[(size_t)(k0 + kk) * ldw + n0 + (lane & 31)]; if (sc) v *= sc[k0 + kk]; scr[kk * 33 + (lane & 31)] = v; }
    LDS_WAIT(); asm volatile("" ::: "memory");
    const int c = lane & 7;
#pragma unroll
    for (int j = 0; j < 4; ++j) { const int n = (lane >> 3) + 8 * j; const LAS float* s = scr + (8 * c) * 33 + n;
        v4u o; o.x = pk2(s[0 * 33], s[1 * 33]); o.y = pk2(s[2 * 33], s[3 * 33]); o.z = pk2(s[4 * 33], s[5 * 33]); o.w = pk2(s[6 * 33], s[7 * 33]);
        *(GAS v4u*)(dst + (size_t)n * ldt + k0 + 8 * c) = o; }
    LDS_WAIT(); asm volatile("" ::: "memory");
}
__device__ __forceinline__ void p0a_weights(Frame& F, const float* w_in, const float* w_out, const float* norm_w, bf16* WinT, bf16* WdtT, bf16* WoutT) {
    LAS float* scr = (LAS float*)(F.lds + RING_OFF + F.wave * 16384);
    const int gw = F.wave * F.G + F.vcu, NGW = F.G * NWAVES;
    constexpr int NB_IN = SRC_LD / 32  , I_IN = 32 * NB_IN, I_OUT = 64 * 64;
    for (int it = gw; it < I_IN + I_OUT; it += NGW) {
        if (it < I_IN) { const int kb = it / NB_IN, nb = it % NB_IN;
            bf16* dst = nb < 160 ? WinT + (size_t)(32 * nb) * 2048 : (nb == 160 ? WdtT : WinT + (size_t)(32 * (nb - 1)) * 2048);
            p0_transpose_item(w_in, SRC_LD, 64 * kb, 32 * nb, dst, 2048, norm_w, scr, F.lane);
        } else { const int r = it - I_IN, kb = r / 64, nb = r % 64;
            p0_transpose_item(w_out, 2048, 64 * kb, 32 * nb, WoutT + (size_t)(32 * nb) * 4096, 4096, nullptr, scr, F.lane); }
    }
}
typedef float f32x4v __attribute__((ext_vector_type(4)));
__device__ __forceinline__ void p0b_rows(Frame& F, const float* xp, const float* xs, const bf16* WdtT, const float* dt_bias, bf16* H, float* rstd, float* dtb) {
    const int gw = F.wave * F.G + F.vcu, NGW = F.G * NWAVES, lane = F.lane, r = lane & 15, kq = lane >> 4;
    for (int blk = gw; blk < MTOK / 16; blk += NGW) {
        const int row = blk * 16 + r;
        const float* xr = (row < TP ? xp + (size_t)row * DM : xs + (size_t)(row - TP) * DM) + 8 * kq;
        bf16* hr = H + (size_t)row * DM + 8 * kq;
        const bf16* w0 = WdtT + (size_t)r * DM + 8 * kq; const bf16* w1 = w0 + (size_t)16 * DM;
        f32x4v a0 = {0.f, 0.f, 0.f, 0.f}, a1 = {0.f, 0.f, 0.f, 0.f}; float ss = 0.f;
#pragma unroll 4
        for (int s = 0; s < 64; ++s) {
            const f32x4v u = *(const f32x4v*)(xr + 32 * s), v = *(const f32x4v*)(xr + 32 * s + 4);
            ss += (u[0] * u[0] + u[1] * u[1]) + (u[2] * u[2] + u[3] * u[3]) + (v[0] * v[0] + v[1] * v[1]) + (v[2] * v[2] + v[3] * v[3]);
            v4u p; p.x = pg8::cvt_pk_bf16(u[0], u[1]); p.y = pg8::cvt_pk_bf16(u[2], u[3]); p.z = pg8::cvt_pk_bf16(v[0], v[1]); p.w = pg8::cvt_pk_bf16(v[2], v[3]);
            *(v4u*)(hr + 32 * s) = p;
            const bf16x8 af = __builtin_bit_cast(bf16x8, p);
            const bf16x8 b0 = *(const bf16x8*)(w0 + 32 * s), b1 = *(const bf16x8*)(w1 + 32 * s);
            a0 = __builtin_amdgcn_mfma_f32_16x16x32_bf16(af, b0, a0, 0, 0, 0);
            a1 = __builtin_amdgcn_mfma_f32_16x16x32_bf16(af, b1, a1, 0, 0, 0);
        }
        ss += __shfl_xor(ss, 16); ss += __shfl_xor(ss, 32);
        const float rs = __builtin_amdgcn_rsqf(ss * (1.0f / DM) + EPS);
        if (lane < 16) rstd[row] = rs;
        const float bia0 = dt_bias[r], bia1 = dt_bias[16 + r];
#pragma unroll
        for (int i = 0; i < 4; ++i) {
            const float rsi = __shfl(rs, 4 * kq + i);
            float v0 = a0[i] * rsi + bia0, v1 = a1[i] * rsi + bia1;
            v0 = v0 > 20.f ? v0 : __logf(1.0f + __expf(v0)); v1 = v1 > 20.f ? v1 : __logf(1.0f + __expf(v1));
            float* o = dtb + (size_t)(blk * 16 + 4 * kq + i) * 32;
            o[r] = v0; o[16 + r] = v1;
        }
    }
}
typedef _Float16 f16;
constexpr size_t WS_XACT = WS_H;
__device__ __forceinline__ float bf2f(unsigned short b) { return __uint_as_float((unsigned)b << 16); }
__device__ __forceinline__ unsigned short f2bf_rne(float f) { unsigned u = __float_as_uint(f); return (unsigned short)((u + 0x7fffu + ((u >> 16) & 1u)) >> 16); }
__device__ __forceinline__ float silu_n(float v) { return v / (1.0f + __expf(-v)); }
__global__ void __launch_bounds__(256) nv_conv(const unsigned short* __restrict__ XBC, const float* __restrict__ state_conv, const float* __restrict__ conv_w, const float* __restrict__ conv_b, f16* __restrict__ XACT) {
    const size_t total = (size_t)MTOK * CONVD;
    for (size_t i = (size_t)blockIdx.x * 256 + threadIdx.x; i < total; i += (size_t)gridDim.x * 256) {
        const int m = (int)(i / CONVD), c = (int)(i % CONVD);
        float acc = conv_b[c];
        for (int t = 0; t < 4; ++t) {
            float v;
            if (m < TP) { const int sp = m - 3 + t; v = sp >= 0 ? bf2f(XBC[(size_t)sp * CONVD + c]) : 0.f; }
            else { const int b = (m - TP) >> 5, ts = (m - TP) & 31, sp = ts - 3 + t;
                v = sp >= 0 ? bf2f(XBC[(size_t)(TP + b * 32 + sp) * CONVD + c]) : state_conv[((size_t)b * 3 + (sp + 3)) * CONVD + c]; }
            acc += conv_w[(size_t)t * CONVD + c] * v;
        }
        XACT[i] = (f16)silu_n(acc);
    }
}
__global__ void __launch_bounds__(256) nv_ssd(const f16* __restrict__ XACT, const float* __restrict__ DT, const float* __restrict__ a_log, const float* __restrict__ d_skip,
                                              const float* __restrict__ state_ssm, const unsigned short* __restrict__ ZQ, float* __restrict__ YPRE, float* __restrict__ out) {
    const int seq = blockIdx.x / NHS, head = blockIdx.x % NHS, g = head >> 3, p = threadIdx.x >> 2, nq = threadIdx.x & 3;
    const int L = seq == 0 ? TP : 32, row0 = seq == 0 ? 0 : TP + (seq - 1) * 32;
    const float A = -__expf(a_log[head]), Dk = d_skip[head];
    float S[32];
    if (seq == 0) {
#pragma unroll
        for (int i = 0; i < 32; ++i) S[i] = 0.f; }
    else { const float* s0 = state_ssm + (((size_t)(seq - 1) * NHS + head) * PH + p) * NST + nq * 32;
#pragma unroll
        for (int i = 0; i < 32; ++i) S[i] = s0[i]; }
    for (int t = 0; t < L; ++t) {
        const size_t m = (size_t)row0 + t;
        const float dtv = DT[m * 32 + head], dA = __expf(dtv * A);
        const float xv = (float)XACT[m * CONVD + head * PH + p], xd = xv * dtv;
        const f16* Bp = XACT + m * CONVD + 2048 + g * NST + nq * 32; const f16* Cp = Bp + 512;
        float y = 0.f;
#pragma unroll
        for (int i = 0; i < 32; ++i) { S[i] = S[i] * dA + xd * (float)Bp[i]; y += S[i] * (float)Cp[i]; }
        y += __shfl_xor(y, 1); y += __shfl_xor(y, 2);
        if (nq == 0) { y += Dk * xv; y *= bf2f(ZQ[m * 4096 + head * PH + p]); YPRE[m * DSSM + head * PH + p] = y; }
    }
    float* so = (seq == 0 ? out + O_PSSM : out + O_SSSM + (size_t)(seq - 1) * (NHS * PH * NST)) + ((size_t)head * PH + p) * NST + nq * 32;
#pragma unroll
    for (int i = 0; i < 32; ++i) so[i] = S[i];
}
__global__ void __launch_bounds__(256) nv_ssmnorm(const float* __restrict__ YPRE, const float* __restrict__ ssm_norm_w, unsigned short* __restrict__ ZQ) {
    const int m = blockIdx.x, g = threadIdx.x >> 6, lane = threadIdx.x & 63;
    const float* y = YPRE + (size_t)m * DSSM + g * 512; float v[8]; float ss = 0.f;
#pragma unroll
    for (int i = 0; i < 8; ++i) { v[i] = y[lane + 64 * i]; ss += v[i] * v[i]; }
#pragma unroll
    for (int o = 1; o < 64; o <<= 1) ss += __shfl_xor(ss, o);
    const float rs = rsqrtf(ss * (1.0f / 512.0f) + EPS);
#pragma unroll
    for (int i = 0; i < 8; ++i) ZQ[(size_t)m * 4096 + g * 512 + lane + 64 * i] = f2bf_rne(v[i] * rs * ssm_norm_w[g * 512 + lane + 64 * i]);
}
__global__ void __launch_bounds__(64) nv_attn(unsigned short* __restrict__ ZQ, const unsigned short* __restrict__ Kb, const unsigned short* __restrict__ Vb, const unsigned short* __restrict__ Gb,
                                              const float* __restrict__ cache_k, const float* __restrict__ cache_v, const float* __restrict__ rel_bias) {
    __shared__ float qs[128]; __shared__ float sc[576];
    const int m = blockIdx.x / NHA, h = blockIdx.x % NHA, lane = threadIdx.x;
    unsigned short* qp = ZQ + (size_t)m * 4096 + 2048 + h * HD;
    qs[lane] = bf2f(qp[lane]); qs[lane + 64] = bf2f(qp[lane + 64]);
    __syncthreads();
    int nk, qi; const bool smp = m >= TP; int b = 0, c = 0, j0 = 0;
    if (!smp) { c = m >> 6; qi = m & 63; j0 = c < 8 ? (8 - c) * 64 : 0; nk = 576; }
    else { b = (m - TP) >> 5; qi = (m - TP) & 31; nk = 544; }
    const float* bias = rel_bias + (size_t)h * 257;
    float mx = -1e30f;
    for (int j = j0 + lane; j < nk; j += 64) {
        float s = 0.f;
        if (!smp || j >= 512) { const unsigned short* kr = Kb + (size_t)(smp ? TP + b * 32 + (j - 512) : 64 * c - 512 + j) * 2048 + h * HD;
            const uint4* k4 = (const uint4*)kr;
            for (int d8 = 0; d8 < 16; ++d8) { const uint4 w = k4[d8]; const unsigned ww[4] = {w.x, w.y, w.z, w.w};
#pragma unroll
                for (int e = 0; e < 4; ++e) s += qs[d8 * 8 + 2 * e] * __uint_as_float(ww[e] << 16) + qs[d8 * 8 + 2 * e + 1] * __uint_as_float(ww[e] & 0xffff0000u); } }
        else { const float4* k4 = (const float4*)(cache_k + (((size_t)b * 512 + j) * NHA + h) * HD);
            for (int d4 = 0; d4 < 32; ++d4) { const float4 w = k4[d4]; s += qs[d4 * 4] * w.x + qs[d4 * 4 + 1] * w.y + qs[d4 * 4 + 2] * w.z + qs[d4 * 4 + 3] * w.w; } }
        int rel = qi + 512 - j; rel = rel < -128 ? -128 : (rel > 128 ? 128 : rel);
        s += bias[rel + 128] * 1.4426950408889634f;
        sc[j] = s; mx = fmaxf(mx, s);
    }
#pragma unroll
    for (int o = 1; o < 64; o <<= 1) mx = fmaxf(mx, __shfl_xor(mx, o));
    float l = 0.f;
    for (int j = j0 + lane; j < nk; j += 64) { const float pv = exp2f(sc[j] - mx); sc[j] = pv; l += pv; }
#pragma unroll
    for (int o = 1; o < 64; o <<= 1) l += __shfl_xor(l, o);
    __syncthreads();
    float o0 = 0.f, o1 = 0.f;
    for (int j = j0; j < nk; ++j) { const float pv = sc[j];
        if (!smp || j >= 512) { const unsigned short* vr = Vb + (size_t)(smp ? TP + b * 32 + (j - 512) : 64 * c - 512 + j) * 2048 + h * HD; o0 += pv * bf2f(vr[lane]); o1 += pv * bf2f(vr[lane + 64]); }
        else { const float* vr = cache_v + (((size_t)b * 512 + j) * NHA + h) * HD; o0 += pv * vr[lane]; o1 += pv * vr[lane + 64]; } }
    const float il = 1.0f / l; const unsigned short* gp = Gb + (size_t)m * 2048 + h * HD;
    qp[lane] = f2bf_rne(o0 * il * bf2f(gp[lane])); qp[lane + 64] = f2bf_rne(o1 * il * bf2f(gp[lane + 64]));
}
__global__ void __launch_bounds__(128) nv_outproj(const unsigned short* __restrict__ ZQ, const float* __restrict__ w_out, const float* __restrict__ xp, const float* __restrict__ xs, float* __restrict__ out) {
    __shared__ float at[128][16];
    const int rb = blockIdx.x / 16, cb = blockIdx.x % 16, col = cb * 128 + threadIdx.x, r0 = rb * 16;
    float acc[16];
#pragma unroll
    for (int r = 0; r < 16; ++r) acc[r] = 0.f;
    for (int k0 = 0; k0 < 4096; k0 += 128) {
        __syncthreads();
        for (int e = threadIdx.x; e < 2048; e += 128) { const int r = e >> 7, kk = e & 127; at[kk][r] = bf2f(ZQ[(size_t)(r0 + r) * 4096 + k0 + kk]); }
        __syncthreads();
        for (int kk = 0; kk < 128; ++kk) { const float w = w_out[(size_t)(k0 + kk) * DM + col];
#pragma unroll
            for (int r = 0; r < 16; ++r) acc[r] += at[kk][r] * w; }
    }
#pragma unroll
    for (int r = 0; r < 16; ++r) { const int row = r0 + r; const float xv = row < TP ? xp[(size_t)row * DM + col] : xs[(size_t)(row - TP) * DM + col]; out[(size_t)row * DM + col] = xv + acc[r]; }
}
struct Args { const float* in[18]; float* out; unsigned char* ws; int ph_lo, ph_hi, li, pad; };
constexpr int N_PHASES = 3;
__global__ void __launch_bounds__(NWAVES * 64, 2) hyb_fwd(Args args) {
    extern __shared__ __attribute__((aligned(16))) unsigned char lds[];
    Frame F;
    F.lds = (LAS unsigned char*)lds; F.MISC = (volatile LAS unsigned*)(F.lds + MISC_OFF);
    F.tid = threadIdx.x; F.lane = F.tid & 63; F.wave = __builtin_amdgcn_readfirstlane(F.tid >> 6);
    F.G = gridDim.x; { const int bx = blockIdx.x; F.vcu = (F.G % 8 == 0) ? (bx % 8) * (F.G / 8) + bx / 8 : bx; }
    unsigned char* ws = args.ws; F.ctl = (gu32*)(ws + WS_CTL);
    const float* x_prompt = args.in[0]; const float* x_sample = args.in[1]; const float* norm_w = args.in[6]; const float* w_in = args.in[7];
    const float* dt_bias = args.in[10]; const float* q_norm_w = args.in[14]; const float* k_norm_w = args.in[15]; const float* w_out = args.in[17];
    bf16* Hb = (bf16*)(ws + WS_H); bf16* WinT = (bf16*)(ws + WS_WIN); bf16* WdtT = (bf16*)(ws + WS_WDT); bf16* WoutT = (bf16*)(ws + WS_WOUT);
    bf16* ZQ = (bf16*)(ws + WS_ZQ); bf16* Kb = (bf16*)(ws + WS_K); bf16* Vb = (bf16*)(ws + WS_V); bf16* Gb = (bf16*)(ws + WS_G);
    float* DTb = (float*)(ws + WS_DT); float* RSTD = (float*)(ws + WS_RSTD); bf16* XBC = (bf16*)args.out;
    for (int u = F.tid; u < (LDS_BYTES - LDSCTL_OFF) / 4; u += NWAVES * 64) ((LAS unsigned*)(F.lds + LDSCTL_OFF))[u] = 0u;
    __syncthreads();
    XcdBarrier bar = xcd_barrier_post((unsigned*)(F.ctl + CW_BAR) + args.li * XCD_BAR_WORDS, F.MISC + 8);
    const int lo = args.ph_lo, hi = args.ph_hi;
#define IN(k) (lo <= (k) && (k) < hi)
#define BOTH(k) (IN(k) && IN((k) + 1))
    if (IN(0)) { p0a_weights(F, w_in, w_out, norm_w, WinT, WdtT, WoutT); if (BOTH(0)) xcd_barrier(bar); }
    if (IN(1)) { p0b_rows(F, x_prompt, x_sample, WdtT, dt_bias, Hb, RSTD, DTb); if (BOTH(1)) xcd_barrier(bar); }
    if (IN(2)) {
        pg8::Gemm g{Hb, WinT, MTOK, NIN, DM}; pg8::StaticOrder S; S.init(MTOK, NIN, F.G, (int)blockIdx.x);
        pg8::EpiIn E{RSTD, ZQ, XBC, Kb, Vb, Gb, q_norm_w, k_norm_w, args.out, (PG8_LAS float*)(F.lds + EPI_P_OFF)};
        pg8::gemm_phase<pg8::EpiIn, pg8::StaticOrder, true, true>(F.lds + RING_OFF, g, S, E);
        if (BOTH(2)) xcd_barrier(bar);
    }
#undef IN
#undef BOTH
}
static void naive_tail(void* const* d_in, void* d_out, void* d_ws, hipStream_t stream) {
    unsigned char* ws = (unsigned char*)d_ws; float* out = (float*)d_out;
    const float* x_prompt = (const float*)d_in[0]; const float* x_sample = (const float*)d_in[1]; const float* state_conv = (const float*)d_in[2]; const float* state_ssm = (const float*)d_in[3];
    const float* cache_k = (const float*)d_in[4]; const float* cache_v = (const float*)d_in[5]; const float* conv_w = (const float*)d_in[8]; const float* conv_b = (const float*)d_in[9];
    const float* a_log = (const float*)d_in[11]; const float* d_skip = (const float*)d_in[12]; const float* ssm_norm_w = (const float*)d_in[13]; const float* rel_bias = (const float*)d_in[16]; const float* w_out = (const float*)d_in[17];
    unsigned short* ZQ = (unsigned short*)(ws + WS_ZQ); unsigned short* Kb = (unsigned short*)(ws + WS_K); unsigned short* Vb = (unsigned short*)(ws + WS_V); unsigned short* Gb = (unsigned short*)(ws + WS_G);
    float* DTb = (float*)(ws + WS_DT); f16* XACT = (f16*)(ws + WS_XACT);
    hipLaunchKernelGGL(nv_conv, dim3(8192), dim3(256), 0, stream, (const unsigned short*)d_out, state_conv, conv_w, conv_b, XACT);
    hipLaunchKernelGGL(nv_ssd, dim3(33 * NHS), dim3(256), 0, stream, (const f16*)XACT, (const float*)DTb, a_log, d_skip, state_ssm, (const unsigned short*)ZQ, out, out);
    hipLaunchKernelGGL(nv_ssmnorm, dim3(MTOK), dim3(256), 0, stream, (const float*)out, ssm_norm_w, ZQ);
    hipLaunchKernelGGL(nv_attn, dim3(MTOK * NHA), dim3(64), 0, stream, ZQ, (const unsigned short*)Kb, (const unsigned short*)Vb, (const unsigned short*)Gb, cache_k, cache_v, rel_bias);
    hipLaunchKernelGGL(nv_outproj, dim3((MTOK / 16) * 16), dim3(128), 0, stream, (const unsigned short*)ZQ, w_out, x_prompt, x_sample, out);
}
extern "C" void kernel_launch(void* const* d_in, const int* in_sizes, int n_in, void* d_out, int out_size, void* d_ws, size_t ws_size, hipStream_t stream) {
    static int grid = 0;
    if (grid == 0) {
        if (n_in != 18 || in_sizes[0] != TP * DM || (size_t)out_size != O_END || ws_size < WS_END) { fprintf(stderr, "kernel_launch: shape mismatch n_in %d in0 %d out %d ws %zu (need %zu)\n", n_in, n_in > 0 ? in_sizes[0] : -1, out_size, ws_size, (size_t)WS_END); grid = -1; return; }
        int dev = 0, cus = 0;
        if (hipGetDevice(&dev) != hipSuccess || hipDeviceGetAttribute(&cus, hipDeviceAttributeMultiprocessorCount, dev) != hipSuccess) { grid = -1; return; }
        if (hipFuncSetAttribute((const void*)hyb_fwd, hipFuncAttributeMaxDynamicSharedMemorySize, LDS_BYTES) != hipSuccess) { fprintf(stderr, "kernel_launch: hipFuncSetAttribute failed\n"); grid = -1; return; }
        (void)hipGetLastError();
        grid = cus;
    }
    if (grid < 0) return;
    if (hipMemsetAsync((char*)d_ws + WS_CTL, 0, CTL_ZERO_BYTES, stream) != hipSuccess) return;
    Args a{};
    for (int i = 0; i < 18; ++i) a.in[i] = (const float*)d_in[i];
    a.out = (float*)d_out; a.ws = (unsigned char*)d_ws;
#ifndef N_LAUNCH_SPLIT
#define N_LAUNCH_SPLIT 1
#endif
#if N_LAUNCH_SPLIT
    for (int li = 0; li < N_PHASES; ++li) { a.ph_lo = li; a.ph_hi = li + 1; a.li = li; hipLaunchKernelGGL(hyb_fwd, dim3(grid), dim3(NWAVES * 64), LDS_BYTES, stream, a); }
#else
    a.ph_lo = 0; a.ph_hi = N_PHASES; a.li = 0; hipLaunchKernelGGL(hyb_fwd, dim3(grid), dim3(NWAVES * 64), LDS_BYTES, stream, a);
#endif
    naive_tail(d_in, d_out, d_ws, stream);
}
```

```cpp
#include <hip/hip_runtime.h>
#include <cstdio>
#include <cstdint>
constexpr int TP = 16384, TS = 1024, MTOK = TP + TS;
constexpr int DM = 2048, DSSM = 2048, DATT = 2048, CONVD = 3072, NHS = 32, NHA = 16, HD = 128, PH = 64, NST = 128;
constexpr int NIN = 13312;
constexpr int SRC_LD = 13344;
constexpr float EPS = 1e-6f;
constexpr size_t O_YP = 0, O_YS = 33554432, O_PCONV = 35651584, O_PSSM = 35660800, O_PK = 35922944, O_PV = 36971520, O_SCONV = 38020096, O_SSSM = 38315008, O_SK = 46703616, O_SV = 48800768, O_END = 50897920;
constexpr size_t MiB = 1u << 20;
constexpr size_t WS_CTL = 0, CTL_ZERO_BYTES = 32 * 1024;
constexpr size_t WS_H = 1 * MiB;
constexpr size_t WS_WIN = WS_H + 68 * MiB;
constexpr size_t WS_WDT = WS_WIN + 52 * MiB;
constexpr size_t WS_WOUT = WS_WDT + 1 * MiB;
constexpr size_t WS_ZQ = WS_WOUT + 16 * MiB;
constexpr size_t WS_K = WS_ZQ + 136 * MiB;
constexpr size_t WS_V = WS_K + 68 * MiB;
constexpr size_t WS_G = WS_V + 68 * MiB;
constexpr size_t WS_DT = WS_G + 68 * MiB;
constexpr size_t WS_RSTD = WS_DT + 3 * MiB;
constexpr size_t WS_END = WS_RSTD + 1 * MiB;
constexpr size_t WS_SEG = WS_H;
constexpr size_t WS_SEGDEC = WS_RSTD + 512 * 1024;
constexpr int CW_TMO = 0, CW_CODE = 1, CW_BAR = 4096;
constexpr int RING_OFF = 0, RING_BYTES = 131072;
constexpr int LDSCTL_OFF = 157696, MISC_OFF = LDSCTL_OFF + 320;
constexpr int EPI_P_OFF = 131072;
constexpr int LDS_BYTES = 160 * 1024;
constexpr int NWAVES = 8;
namespace pg8 {
#define PG8_LAS __attribute__((address_space(3)))
typedef unsigned short bf16_t;
typedef short bf16x8 __attribute__((ext_vector_type(8)));
typedef float f32x4 __attribute__((ext_vector_type(4)));
typedef unsigned u32x4 __attribute__((ext_vector_type(4)));
constexpr int BM = 256, BK = 64, HALF = 128, HTB = HALF * BK * 2  , STAGE_BYTES = 8 * HTB, NXCD = 8, WGM = 8;

__host__ __device__ __forceinline__ int lds_byte(int r, int c) { const int st = (r >> 4) * 2 + (c >> 5), rr = r & 15, cc = c & 31, ob = rr * 64 + cc * 2; return st * 1024 + (ob ^ (((ob >> 9) & 1) << 5)); }
__host__ __device__ __forceinline__ void stage_rc(int b, int& R, int& C) { const int st = b / 1024, sb = b % 1024, swz = sb ^ (((sb >> 9) & 1) << 5); R = (st >> 1) * 16 + swz / 64; C = (st & 1) * 32 + (swz % 64) / 2; }
__host__ __device__ __forceinline__ int perm32(int rho) { const int n = rho >> 4, i = rho & 15; return 8 * (i >> 2) + 4 * n + (i & 3); }

struct Unit { int pm, pn; };
struct Gemm { const bf16_t* A; const bf16_t* Bt; int M, N, K, ld; };

struct StaticOrder {
    int nM, nN, nwg, G, c;
    __host__ __device__ __forceinline__ void init(int M, int N, int G_, int c_, int lim_ = -1) { nM = M / BM; nN = N / BM; nwg = nM * nN; G = G_; c = c_; lim = lim_ < 0 ? nwg : lim_; }
    int lim;
    __host__ __device__ __forceinline__ bool next(int i, Unit& u) const { const long L = (long)i * G + c; if (L >= lim) return false; map((int)L, u); return true; }
    __host__ __device__ __forceinline__ void map(int L, Unit& u) const {
        int wgid = L; { const int q = nwg / NXCD, r = nwg % NXCD, xcd = wgid % NXCD, off = wgid / NXCD; wgid = (xcd < r ? xcd * (q + 1) : r * (q + 1) + (xcd - r) * q) + off; }
        const int nig = WGM * nN, gid = wgid / nig, fm = gid * WGM, gsz = (nM - fm) < WGM ? (nM - fm) : WGM;
        u.pm = fm + ((wgid % nig) % gsz); u.pn = (wgid % nig) / gsz;
    }
    __device__ __forceinline__ void a_ready(const Unit&) const {}
    __device__ __forceinline__ void done(const Unit&) const {}
};

__device__ __forceinline__ unsigned cvt_pk_bf16(float lo, float hi) { unsigned r; asm volatile("v_cvt_pk_bf16_f32 %0, %1, %2" : "=v"(r) : "v"(lo), "v"(hi)); return r; }
template <class Epi, class Sched, bool ALIGN_EPI = false, bool SP2 = false>
__device__ __forceinline__ void gemm_phase(PG8_LAS unsigned char* lds, const Gemm g, const Sched& S, const Epi& E, const int tid) {
    const int wid = __builtin_amdgcn_readfirstlane(tid >> 6), lane = tid & 63, wr = wid >> 2, wc = wid & 3, fr = lane & 15, fq = lane >> 4;
    const int K = g.ld, nt = g.K / BK;
    unsigned voffA[2], voffB[2];
#pragma unroll
    for (int i = 0; i < 2; ++i) { int R, C; stage_rc(tid * 16 + i * 8192, R, C); const int Rb = Epi::PERM ? ((R & ~31) + perm32(R & 31)) : R;
        voffA[i] = (unsigned)(R * K + C) * 2u; voffB[i] = (unsigned)(Rb * K + C) * 2u; }
    const size_t kstep = (size_t)(BK * 2);
    const size_t hstep = (size_t)HALF * K * 2;
    const size_t tstep = 2 * hstep;
    const unsigned ldsw = (unsigned)wid * 1024u;
    const int aoff = lds_byte(wr * 64 + fr, fq * 8), boff = lds_byte(wc * 32 + fr, fq * 8);
#define PG8_SA(b, h) (((b) * 2 + (h)) * HTB)
#define PG8_SB(b, h) ((4 + (b) * 2 + (h)) * HTB)
#define PG8_STAGE(bufoff, gbase, voff) do { _Pragma("unroll") for (int _i = 0; _i < 2; ++_i) \
        __builtin_amdgcn_global_load_lds((const unsigned*)((const char*)(gbase) + (voff)[_i]), (PG8_LAS unsigned*)(lds + (bufoff) + ldsw + _i * 8192), 16, 0, 0); } while (0)
#define PG8_LDA(dst, b, h) do { _Pragma("unroll") for (int m = 0; m < 4; ++m) _Pragma("unroll") for (int k = 0; k < 2; ++k) dst[m][k] = *(const PG8_LAS bf16x8*)(lds + PG8_SA(b, h) + aoff + m * 2048 + k * 1024); } while (0)
#define PG8_LDB(dst, b, h) do { _Pragma("unroll") for (int n = 0; n < 2; ++n) _Pragma("unroll") for (int k = 0; k < 2; ++k) dst[n][k] = *(const PG8_LAS bf16x8*)(lds + PG8_SB(b, h) + boff + n * 2048 + k * 1024); } while (0)
#define PG8_MMA(ai, bj, At, Bt) do { __builtin_amdgcn_s_setprio(1); _Pragma("unroll") for (int m = 0; m < 4; ++m) _Pragma("unroll") for (int n = 0; n < 2; ++n) _Pragma("unroll") for (int k = 0; k < 2; ++k) \
        acc[ai][bj][m][n] = __builtin_amdgcn_mfma_f32_16x16x32_bf16(Bt[n][k], At[m][k], acc[ai][bj][m][n], 0, 0, 0); __builtin_amdgcn_s_setprio(0); } while (0)
#define PG8_WAIT_V(n) asm volatile("s_waitcnt vmcnt(" #n ")" ::: "memory")
#define PG8_WAIT_L(n) asm volatile("s_waitcnt lgkmcnt(" #n ")" ::: "memory")
#define PG8_BAR __builtin_amdgcn_s_barrier()
#define PG8_SCHED __builtin_amdgcn_sched_barrier(0)
    Unit cur, nxt; int ui = 0;
    if (!S.next(0, cur)) return;
    f32x4 acc[2][2][4][2];
#pragma unroll
    for (int a = 0; a < 2; ++a)
#pragma unroll
        for (int b = 0; b < 2; ++b)
#pragma unroll
            for (int m = 0; m < 4; ++m)
#pragma unroll
                for (int n = 0; n < 2; ++n) acc[a][b][m][n] = (f32x4){0.f, 0.f, 0.f, 0.f};
    bf16x8 At[4][2], B0[2][2], B1[2][2];
    const char* cA = (const char*)g.A + (size_t)cur.pm * tstep; const char* cB = (const char*)g.Bt + (size_t)cur.pn * tstep;
    S.a_ready(cur);
    if constexpr (SP2) {
        PG8_STAGE(PG8_SB(0, 0), cB, voffB); PG8_STAGE(PG8_SB(0, 1), cB + hstep, voffB); PG8_STAGE(PG8_SA(0, 0), cA, voffA); PG8_STAGE(PG8_SA(0, 1), cA + hstep, voffA);
        if (wr == 1) PG8_BAR;
        PG8_WAIT_V(2); PG8_BAR;
        PG8_STAGE(PG8_SB(1, 0), cB + kstep, voffB); PG8_STAGE(PG8_SA(1, 0), cA + kstep, voffA); PG8_STAGE(PG8_SB(1, 1), cB + hstep + kstep, voffB);
        PG8_WAIT_V(6); PG8_BAR;
    } else {
        PG8_STAGE(PG8_SB(0, 0), cB, voffB); PG8_STAGE(PG8_SA(0, 0), cA, voffA); PG8_STAGE(PG8_SB(0, 1), cB + hstep, voffB); PG8_STAGE(PG8_SA(0, 1), cA + hstep, voffA);
        if (wr == 1) PG8_BAR;
        PG8_WAIT_V(4); PG8_BAR;
        PG8_STAGE(PG8_SB(1, 0), cB + kstep, voffB); PG8_STAGE(PG8_SA(1, 0), cA + kstep, voffA); PG8_STAGE(PG8_SB(1, 1), cB + hstep + kstep, voffB);
        PG8_WAIT_V(6); PG8_BAR;
    }
    int fresh = 0;
    for (;;) {
        const bool has_next = S.next(ui + 1, nxt);
        const char* nA = has_next ? (const char*)g.A + (size_t)nxt.pm * tstep : cA; const char* nB = has_next ? (const char*)g.Bt + (size_t)nxt.pn * tstep : cB;
        for (int t = 0; t < nt; t += 2) {
            const bool last = (t == nt - 2);
            const char* a1 = cA + (size_t)(t + 1) * kstep;
            const char* a2 = last ? nA : cA + (size_t)(t + 2) * kstep; const char* b2 = last ? nB : cB + (size_t)(t + 2) * kstep;
            const char* a3 = a2 + kstep; const char* b3 = b2 + kstep;
            if (last && has_next) S.a_ready(nxt);
            if constexpr (SP2) {
            const bool relax = Epi::EPI_VMEM > 0 && __builtin_amdgcn_readfirstlane(fresh) != 0;
            PG8_LDB(B0, 0, 0); PG8_LDB(B1, 0, 1); PG8_SCHED; PG8_LDA(At, 0, 0); PG8_STAGE(PG8_SA(1, 1), a1 + hstep, voffA);
            if (relax) { asm volatile("s_waitcnt vmcnt(%0)" :: "n"(8 + Epi::EPI_VMEM) : "memory"); } else { PG8_WAIT_V(8); }
            PG8_WAIT_L(0); PG8_BAR; PG8_MMA(0, 0, At, B0); PG8_MMA(0, 1, At, B1); PG8_BAR; PG8_SCHED;
            PG8_LDA(At, 0, 1); PG8_STAGE(PG8_SB(0, 0), b2, voffB); PG8_STAGE(PG8_SB(0, 1), b2 + hstep, voffB); PG8_STAGE(PG8_SA(0, 0), a2, voffA);
            if (relax) { asm volatile("s_waitcnt vmcnt(%0)" :: "n"(8 + Epi::EPI_VMEM) : "memory"); } else { PG8_WAIT_V(8); }
            PG8_WAIT_L(0); PG8_BAR; PG8_MMA(1, 0, At, B0); PG8_MMA(1, 1, At, B1); PG8_BAR; PG8_SCHED;
            PG8_LDB(B0, 1, 0); PG8_LDB(B1, 1, 1); PG8_SCHED; PG8_LDA(At, 1, 0); PG8_STAGE(PG8_SA(0, 1), a2 + hstep, voffA);
            PG8_WAIT_V(8); PG8_WAIT_L(0); PG8_BAR; PG8_MMA(0, 0, At, B0); PG8_MMA(0, 1, At, B1); PG8_BAR; PG8_SCHED;
            PG8_LDA(At, 1, 1); PG8_STAGE(PG8_SB(1, 0), b3, voffB); PG8_STAGE(PG8_SB(1, 1), b3 + hstep, voffB); PG8_STAGE(PG8_SA(1, 0), a3, voffA);
            PG8_WAIT_V(8); PG8_WAIT_L(0); PG8_BAR; PG8_MMA(1, 0, At, B0); PG8_MMA(1, 1, At, B1); PG8_BAR; PG8_SCHED;
            fresh = 0;
            } else {
            PG8_LDB(B0, 0, 0); PG8_SCHED; PG8_LDA(At, 0, 0); PG8_STAGE(PG8_SA(1, 1), a1 + hstep, voffA);
            PG8_WAIT_L(8); PG8_BAR; PG8_WAIT_L(0); PG8_MMA(0, 0, At, B0); PG8_BAR; PG8_SCHED;
            PG8_LDB(B1, 0, 1); PG8_STAGE(PG8_SB(0, 0), b2, voffB);
            PG8_BAR; PG8_WAIT_L(0); PG8_MMA(0, 1, At, B1); PG8_BAR;
            PG8_LDA(At, 0, 1); PG8_STAGE(PG8_SA(0, 0), a2, voffA);
            PG8_BAR; PG8_WAIT_L(0); PG8_MMA(1, 0, At, B0); PG8_BAR; PG8_SCHED;
            PG8_STAGE(PG8_SB(0, 1), b2 + hstep, voffB);
            PG8_WAIT_V(6); PG8_BAR; PG8_MMA(1, 1, At, B1); PG8_BAR;
            PG8_LDB(B0, 1, 0); PG8_SCHED; PG8_LDA(At, 1, 0); PG8_STAGE(PG8_SA(0, 1), a2 + hstep, voffA);
            PG8_WAIT_L(8); PG8_BAR; PG8_WAIT_L(0); PG8_MMA(0, 0, At, B0); PG8_BAR; PG8_SCHED;
            PG8_LDB(B1, 1, 1); PG8_STAGE(PG8_SB(1, 0), b3, voffB);
            PG8_BAR; PG8_WAIT_L(0); PG8_MMA(0, 1, At, B1); PG8_BAR;
            PG8_LDA(At, 1, 1); PG8_STAGE(PG8_SA(1, 0), a3, voffA);
            PG8_BAR; PG8_WAIT_L(0); PG8_MMA(1, 0, At, B0); PG8_BAR; PG8_SCHED;
            PG8_STAGE(PG8_SB(1, 1), b3 + hstep, voffB);
            PG8_WAIT_V(6); PG8_BAR; PG8_MMA(1, 1, At, B1); PG8_BAR;
            }
        }
        if constexpr (ALIGN_EPI) { if (wr == 0) PG8_BAR; }
        if constexpr (!Epi::AFTER_DRAIN) { int fr_ = fr, fq_ = fq; asm volatile("" : "+v"(fr_), "+v"(fq_));
            E(acc, cur, wr, wc, fr_, fq_); S.done(cur); }
        if (!has_next) break;
#pragma unroll
        for (int a = 0; a < 2; ++a)
#pragma unroll
            for (int b = 0; b < 2; ++b)
#pragma unroll
                for (int m = 0; m < 4; ++m)
#pragma unroll
                    for (int n = 0; n < 2; ++n) acc[a][b][m][n] = (f32x4){0.f, 0.f, 0.f, 0.f};
        cur = nxt; cA = nA; cB = nB; ++ui; fresh = 1;
        if constexpr (ALIGN_EPI) { if (wr == 1) PG8_BAR; }
    }
    PG8_WAIT_V(0);
    if constexpr (!ALIGN_EPI) { if (wr == 0) PG8_BAR; }
    PG8_BAR;
    if constexpr (Epi::AFTER_DRAIN) { E.fused(acc, cur, wr, wc, fr, fq, lds, wid, lane); S.done(cur); }
#undef PG8_SA
#undef PG8_SB
#undef PG8_STAGE
#undef PG8_LDA
#undef PG8_LDB
#undef PG8_MMA
#undef PG8_WAIT_V
#undef PG8_WAIT_L
#undef PG8_BAR
#undef PG8_SCHED
}
}

#ifndef PG8_SP2
#define PG8_SP2 true
#endif
#ifndef PG8_ALIGN
#define PG8_ALIGN true
#endif
namespace pg8 {
__device__ __forceinline__ float silu_f(float v) { return v * __builtin_amdgcn_rcpf(1.0f + __builtin_amdgcn_exp2f(-1.4426950408889634f * v)); }
__device__ __forceinline__ u32x4 pack8(const f32x4& a, const f32x4& b) { u32x4 w; w.x = cvt_pk_bf16(a[0], a[1]); w.y = cvt_pk_bf16(a[2], a[3]); w.z = cvt_pk_bf16(b[0], b[1]); w.w = cvt_pk_bf16(b[2], b[3]); return w; }
struct EpiIn {
    static constexpr bool PERM = true, AFTER_DRAIN = false;
    static constexpr int EPI_VMEM = 16;
    const float* rstd; bf16_t* ZQ; bf16_t* XBC; bf16_t* Kb; bf16_t* Vb; bf16_t* Gb; const float* qw; const float* kw; float* out; PG8_LAS float* P;
    __device__ __forceinline__ void operator()(f32x4 (&acc)[2][2][4][2], const Unit& u, int wr, int wc, int fr, int fq) const {
        const int pn = u.pn, rbase = u.pm * BM + wr * 64 + fr, lc = wc * 32 + 8 * fq;
#pragma unroll
        for (int ai = 0; ai < 2; ++ai)
#pragma unroll
            for (int m = 0; m < 4; ++m) { const float rs = rstd[rbase + ai * HALF + m * 16];
#pragma unroll
                for (int bj = 0; bj < 2; ++bj) { acc[ai][bj][m][0] = acc[ai][bj][m][0] * rs; acc[ai][bj][m][1] = acc[ai][bj][m][1] * rs; } }
        if (pn < 8 || pn >= 44) {
            bf16_t* base = pn < 8 ? ZQ + pn * BM + lc : Gb + (pn - 44) * BM + lc; const int ld = pn < 8 ? 4096 : 2048;
#pragma unroll
            for (int ai = 0; ai < 2; ++ai)
#pragma unroll
                for (int m = 0; m < 4; ++m) { bf16_t* rowp = base + (size_t)(rbase + ai * HALF + m * 16) * ld;
#pragma unroll
                    for (int bj = 0; bj < 2; ++bj) { f32x4 a = acc[ai][bj][m][0], b = acc[ai][bj][m][1];
#pragma unroll
                        for (int e = 0; e < 4; ++e) { a[e] = silu_f(a[e]); b[e] = silu_f(b[e]); }
                        *(u32x4*)(rowp + bj * HALF) = pack8(a, b); } }
        } else if (pn < 20) {
            const int cx = (pn - 8) * BM + lc;
#pragma unroll
            for (int ai = 0; ai < 2; ++ai)
#pragma unroll
                for (int m = 0; m < 4; ++m) { const int row = rbase + ai * HALF + m * 16; bf16_t* rowp = XBC + (size_t)row * CONVD + cx;
#pragma unroll
                    for (int bj = 0; bj < 2; ++bj) *(u32x4*)(rowp + bj * HALF) = pack8(acc[ai][bj][m][0], acc[ai][bj][m][1]);
                    if ((m & 1) && fr >= 13 && row >= TP - 3) {
                        float* o = row < TP ? out + O_PCONV + (size_t)(row - (TP - 3)) * CONVD + cx
                                            : out + O_SCONV + (size_t)(((row - TP) >> 5) * 3 + ((row & 31) - 29)) * CONVD + cx;
#pragma unroll
                        for (int bj = 0; bj < 2; ++bj) { *(f32x4*)(o + bj * HALF) = acc[ai][bj][m][0]; *(f32x4*)(o + bj * HALF + 4) = acc[ai][bj][m][1]; } } }
        } else if (pn < 36) {
            const bool isq = pn < 28;
#pragma unroll
            for (int ai = 0; ai < 2; ++ai)
#pragma unroll
                for (int m = 0; m < 4; ++m)
#pragma unroll
                    for (int bj = 0; bj < 2; ++bj) { const f32x4 a = acc[ai][bj][m][0], b = acc[ai][bj][m][1];
                        float s = (a[0] * a[0] + a[1] * a[1]) + (a[2] * a[2] + a[3] * a[3]) + (b[0] * b[0] + b[1] * b[1]) + (b[2] * b[2] + b[3] * b[3]);
                        s += __shfl_xor(s, 16); s += __shfl_xor(s, 32);
                        if (fq == 0) P[((ai * HALF + wr * 64 + m * 16 + fr) * 2 + bj) * 4 + wc] = s; }
            const float* nw = isq ? qw : kw; const f32x4 w0 = *(const f32x4*)(nw + lc), w1 = *(const f32x4*)(nw + lc + 4);
            asm volatile("s_waitcnt lgkmcnt(0)" ::: "memory"); __builtin_amdgcn_s_barrier(); asm volatile("" ::: "memory");
            const float extra = isq ? 0.1275174313f : 1.0f;
            bf16_t* base = isq ? ZQ + 2048 + (pn - 20) * BM + lc : Kb + (pn - 28) * BM + lc; const int ld = isq ? 4096 : 2048;
            const int ck = (pn - 28) * BM + lc;
#pragma unroll
            for (int ai = 0; ai < 2; ++ai)
#pragma unroll
                for (int m = 0; m < 4; ++m) { const int row = rbase + ai * HALF + m * 16; bf16_t* rowp = base + (size_t)row * ld;
#pragma unroll
                    for (int bj = 0; bj < 2; ++bj) { const f32x4 p4 = *(const PG8_LAS f32x4*)(P + ((ai * HALF + wr * 64 + m * 16 + fr) * 2 + bj) * 4);
                        const float sc = __builtin_amdgcn_rsqf(((p4[0] + p4[1]) + (p4[2] + p4[3])) * (1.0f / 128.0f) + EPS) * extra;
                        const f32x4 a = acc[ai][bj][m][0] * sc * w0, b = acc[ai][bj][m][1] * sc * w1;
                        *(u32x4*)(rowp + bj * HALF) = pack8(a, b);
                        if (!isq && row >= TP - 512) { float* o = (row < TP ? out + O_PK + (size_t)(row - (TP - 512)) * 2048 : out + O_SK + (size_t)(row - TP) * 2048) + ck + bj * HALF;
                            *(f32x4*)o = a; *(f32x4*)(o + 4) = b; } } }
        } else {
            const int cv = (pn - 36) * BM + lc;
#pragma unroll
            for (int ai = 0; ai < 2; ++ai)
#pragma unroll
                for (int m = 0; m < 4; ++m) { const int row = rbase + ai * HALF + m * 16; bf16_t* rowp = Vb + (size_t)row * 2048 + cv;
#pragma unroll
                    for (int bj = 0; bj < 2; ++bj) { *(u32x4*)(rowp + bj * HALF) = pack8(acc[ai][bj][m][0], acc[ai][bj][m][1]);
                        if (row >= TP - 512) { float* o = (row < TP ? out + O_PV + (size_t)(row - (TP - 512)) * 2048 : out + O_SV + (size_t)(row - TP) * 2048) + cv + bj * HALF;
                            *(f32x4*)o = acc[ai][bj][m][0]; *(f32x4*)(o + 4) = acc[ai][bj][m][1]; } } }
        }
    }
};
struct EpiOut {
    static constexpr bool PERM = false, AFTER_DRAIN = false;
    static constexpr int EPI_VMEM = 0;
    const float* xp; const float* xs; float* out;
    __device__ __forceinline__ void operator()(f32x4 (&acc)[2][2][4][2], const Unit& u, int wr, int wc, int fr, int fq) const {
        const int row0 = u.pm * BM + wr * 64 + fr, col0 = u.pn * BM + wc * 32 + 4 * fq;
        const float* xb = u.pm < TP / BM ? xp + (size_t)row0 * DM : xs + (size_t)(row0 - TP) * DM;
        float* ob = out + (size_t)row0 * DM;
#pragma unroll
        for (int ai = 0; ai < 2; ++ai) {
            f32x4 xv[4][2][2];
#pragma unroll
            for (int m = 0; m < 4; ++m)
#pragma unroll
                for (int bj = 0; bj < 2; ++bj)
#pragma unroll
                    for (int n = 0; n < 2; ++n) xv[m][bj][n] = *(const f32x4*)(xb + (size_t)(ai * HALF + m * 16) * DM + col0 + bj * HALF + n * 16);
#pragma unroll
            for (int m = 0; m < 4; ++m)
#pragma unroll
                for (int bj = 0; bj < 2; ++bj)
#pragma unroll
                    for (int n = 0; n < 2; ++n) *(f32x4*)(ob + (size_t)(ai * HALF + m * 16) * DM + col0 + bj * HALF + n * 16) = acc[ai][bj][m][n] + xv[m][bj][n];
        }
    }
};
struct EpiNull {
    static constexpr bool PERM = true, AFTER_DRAIN = false;
    static constexpr int EPI_VMEM = 0;
    __device__ __forceinline__ void operator()(f32x4 (&acc)[2][2][4][2], const Unit&, int, int, int, int) const {
#pragma unroll
        for (int ai = 0; ai < 2; ++ai)
#pragma unroll
            for (int bj = 0; bj < 2; ++bj)
#pragma unroll
                for (int m = 0; m < 4; ++m) { asm volatile("" :: "v"(acc[ai][bj][m][0]), "v"(acc[ai][bj][m][1])); }
    }
};
struct HotOrder { int c; __device__ __forceinline__ bool next(int i, Unit& u) const { if (i >= 14) return false; u.pm = (c >> 3) & 1; u.pn = c & 7; return true; } __device__ __forceinline__ void a_ready(const Unit&) const {} __device__ __forceinline__ void done(const Unit&) const {} };
struct OneUnit { Unit u; __device__ __forceinline__ bool next(int i, Unit& o) const { if (i) return false; o = u; return true; } __device__ __forceinline__ void a_ready(const Unit&) const {} __device__ __forceinline__ void done(const Unit&) const {} };
struct EpiSlab {
    static constexpr bool PERM = false, AFTER_DRAIN = false;
    static constexpr int EPI_VMEM = 0;
    float* slab;
    __device__ __forceinline__ void operator()(f32x4 (&acc)[2][2][4][2], const Unit&, int wr, int wc, int fr, int fq) const {
        float* ob = slab + (size_t)(wr * 64 + fr) * 256 + wc * 32 + 4 * fq;
#pragma unroll
        for (int ai = 0; ai < 2; ++ai)
#pragma unroll
            for (int m = 0; m < 4; ++m)
#pragma unroll
                for (int bj = 0; bj < 2; ++bj)
#pragma unroll
                    for (int n = 0; n < 2; ++n) *(f32x4*)(ob + (size_t)(ai * HALF + m * 16) * 256 + bj * HALF + n * 16) = acc[ai][bj][m][n];
    }
};
}
#define GAS __attribute__((address_space(1)))
#define LAS __attribute__((address_space(3)))
typedef unsigned short bf16;
typedef unsigned v4u __attribute__((ext_vector_type(4)));
typedef float f32x4 __attribute__((ext_vector_type(4)));
typedef short bf16x8 __attribute__((ext_vector_type(8)));
typedef GAS unsigned gu32;
typedef GAS unsigned long long gu64;
#define RLX_AGENT __ATOMIC_RELAXED, __HIP_MEMORY_SCOPE_AGENT
#define LDS_WAIT() asm volatile("s_waitcnt lgkmcnt(0)" ::: "memory")
#define VM_WAIT() asm volatile("s_waitcnt vmcnt(0)" ::: "memory")
__device__ __forceinline__ unsigned long long rt() { return __builtin_amdgcn_s_memrealtime(); }
__device__ __forceinline__ unsigned f2bf(float f) { unsigned u = __builtin_bit_cast(unsigned, f); return (u + 0x7fffu + ((u >> 16) & 1u)) >> 16; }
__device__ __forceinline__ unsigned pk2(float lo, float hi) { return f2bf(lo) | (f2bf(hi) << 16); }

#define XB_TMO      128
#define XB_XCNT(j)  (256  + 64 * (j))
#define XB_XSUB(j)  (1280 + 64 * (j))
#define XB_XGEN(j)  (2304 + 64 * (j))
#define XB_TOP      3328
#define XB_TOPGEN   3392
#define XCD_BAR_WORDS 3456
#define XB_SPIN_CAP (1u << 18)

__device__ __forceinline__ unsigned xb_ld(unsigned* p)              { return __hip_atomic_load(p, __ATOMIC_RELAXED, __HIP_MEMORY_SCOPE_AGENT); }
__device__ __forceinline__ unsigned xb_add(unsigned* p, unsigned v) { return __hip_atomic_fetch_add(p, v, __ATOMIC_RELAXED, __HIP_MEMORY_SCOPE_AGENT); }
__device__ __forceinline__ unsigned xb_xcc_id() { return (unsigned)__builtin_amdgcn_s_getreg((3 << 11) | 20) & 0xFu; }
#define XB_SPIN(cond, bar) do { unsigned _sp = 0; while (cond) { __builtin_amdgcn_s_sleep(1); \
    if ((++_sp & 255u) == 0u) { if (xb_ld(&(bar)[XB_TMO])) break; if (_sp > XB_SPIN_CAP) { atomicAdd(&(bar)[XB_TMO], 1u); break; } } } } while (0)

__device__ __forceinline__ int lane_now() { int l; asm volatile("v_mbcnt_lo_u32_b32 %0, -1, 0\n\tv_mbcnt_hi_u32_b32 %0, -1, %0" : "=&v"(l)); return l; }
struct XcdBarrier {
    unsigned w0;
    unsigned* bar; unsigned x;
    volatile LAS unsigned* st;
};

__device__ __forceinline__ XcdBarrier xcd_barrier_post(unsigned* bar, volatile LAS unsigned* st) {
    XcdBarrier b; b.bar = bar; b.x = xb_xcc_id(); b.st = st; b.w0 = __builtin_amdgcn_readfirstlane(threadIdx.x >> 6) == 0 ? 1u : 0u;
    if (threadIdx.x == 0) (void)xb_add(&bar[XB_XCNT(b.x)], 1u);
    return b;
}
__device__ __forceinline__ void xcd_barrier_complete(unsigned* bar, unsigned x, unsigned& nloc, unsigned& nx) {
    const unsigned G = gridDim.x * gridDim.y * gridDim.z;
    unsigned sum, cnt, mine, sp = 0u;
    for (;;) {
        sum = 0u; cnt = 0u; mine = 0u;
#pragma unroll
        for (unsigned j = 0; j < 16; ++j) { const unsigned c = xb_ld(&bar[XB_XCNT(j)]); sum += c; cnt += (c > 0u) ? 1u : 0u; mine = (j == x) ? c : mine; }
        if (sum == G) break;
        __builtin_amdgcn_s_sleep(1);
        if ((++sp & 255u) == 0u) { if (xb_ld(&bar[XB_TMO])) break; if (sp > XB_SPIN_CAP) { atomicAdd(&bar[XB_TMO], 1u); break; } }
    }
    nloc = mine > 0u ? mine : 1u; nx = cnt > 0u ? cnt : 1u;
}

__device__ __forceinline__ void xcd_barrier(const XcdBarrier& b) {
    asm volatile("s_waitcnt vmcnt(0)" ::: "memory");
    __syncthreads();
    if (b.w0 != 0u && lane_now() == 0) {
        unsigned* bar = b.bar;
        __builtin_amdgcn_s_waitcnt(0);
        unsigned nloc = b.st[0], nx = b.st[1];
        if (nloc == 0u) { xcd_barrier_complete(bar, b.x, nloc, nx); b.st[0] = nloc; b.st[1] = nx; }
        const unsigned old = xb_add(&bar[XB_XSUB(b.x)], 1u);
        const unsigned gen = old / nloc;
        if (old + 1u == (gen + 1u) * nloc) {
            __builtin_amdgcn_fence(__ATOMIC_RELEASE, "agent");
            asm volatile("s_waitcnt vmcnt(0)" ::: "memory");
            const unsigned og = xb_add(&bar[XB_TOP], 1u);
            const unsigned tg = og / nx;
            if (og + 1u == (tg + 1u) * nx) xb_add(&bar[XB_TOPGEN], 1u);
            else XB_SPIN(xb_ld(&bar[XB_TOPGEN]) == tg, bar);
            __builtin_amdgcn_fence(__ATOMIC_ACQUIRE, "agent");
            xb_add(&bar[XB_XGEN(b.x)], 1u);
            asm volatile("s_waitcnt vmcnt(0)" ::: "memory");
        } else {
            XB_SPIN(xb_ld(&bar[XB_XGEN(b.x)]) == gen, bar);
            __builtin_amdgcn_fence(__ATOMIC_ACQUIRE, "agent");
            asm volatile("s_waitcnt vmcnt(0)" ::: "memory");
        }
    }
    __syncthreads();
}

struct Frame {
    LAS unsigned char* lds; volatile LAS unsigned* MISC; gu32* ctl;
    int tid, lane, wave, vcu, G;
};
__device__ __forceinline__ float wave_sum(float v) {
#pragma unroll
    for (int o = 1; o < 64; o <<= 1) v += __shfl_xor(v, o);
    return v;
}
typedef float p0f4 __attribute__((ext_vector_type(4)));
struct P0Item { const float* W; size_t ldw; int k0, n0; bf16* dst; size_t ldt; const float* sc; };
__device__ __forceinline__ void p0_item_load(const P0Item& it, int lane, p0f4 (&v)[8], float (&sv)[8]) {
    const int r8 = lane >> 3, c4 = (lane & 7) * 4;
#pragma unroll
    for (int i = 0; i < 8; ++i) { v[i] = *(const p0f4*)(it.W + (size_t)(it.k0 + 8 * i + r8) * it.ldw + it.n0 + c4); sv[i] = it.sc ? it.sc[it.k0 + 8 * i + r8] : 1.0f; }
}
__device__ __forceinline__ void p0_item_store(const P0Item& it, int lane, const p0f4 (&v)[8], const float (&sv)[8], LAS float* scr) {
    const int r8 = lane >> 3, c4 = (lane & 7) * 4;
#pragma unroll
    for (int i = 0; i < 8; ++i) { LAS float* p = scr + (8 * i + r8) * 33 + c4; p[0] = v[i][0] * sv[i]; p[1] = v[i][1] * sv[i]; p[2] = v[i][2] * sv[i]; p[3] = v[i][3] * sv[i]; }
    LDS_WAIT(); asm volatile("" ::: "memory");
    const int c = lane & 7;
#pragma unroll
    for (int j = 0; j < 4; ++j) { const int n = (lane >> 3) + 8 * j; const LAS float* s = scr + (8 * c) * 33 + n;
        v4u o; o.x = pk2(s[0 * 33], s[1 * 33]); o.y = pk2(s[2 * 33], s[3 * 33]); o.z = pk2(s[4 * 33], s[5 * 33]); o.w = pk2(s[6 * 33], s[7 * 33]);
        *(GAS v4u*)(it.dst + (size_t)n * it.ldt + it.k0 + 8 * c) = o; }
    LDS_WAIT(); asm volatile("" ::: "memory");
}
__device__ __forceinline__ P0Item p0_decode(int it, const float* w_in, const float* w_out, const float* norm_w, bf16* WinT, bf16* WdtT, bf16* WoutT) {
    constexpr int NB_IN = SRC_LD / 32  , I_IN = 32 * NB_IN;
    P0Item r;
    if (it < I_IN) { const int kb = it / NB_IN, nb = it % NB_IN;
        r.W = w_in; r.ldw = SRC_LD; r.k0 = 64 * kb; r.n0 = 32 * nb; r.ldt = 2048; r.sc = norm_w;
        r.dst = nb < 160 ? WinT + (size_t)(32 * nb) * 2048 : (nb == 160 ? WdtT : WinT + (size_t)(32 * (nb - 1)) * 2048);
    } else { const int q = it - I_IN, kb = q / 64, nb = q % 64;
        r.W = w_out; r.ldw = 2048; r.k0 = 64 * kb; r.n0 = 32 * nb; r.ldt = 4096; r.sc = nullptr; r.dst = WoutT + (size_t)(32 * nb) * 4096; }
    return r;
}
__device__ __forceinline__ void p0a_weights(Frame& F, const float* w_in, const float* w_out, const float* norm_w, bf16* WinT, bf16* WdtT, bf16* WoutT) {
    LAS float* scr = (LAS float*)(F.lds + RING_OFF + F.wave * 16384);
    const int gw = F.wave * F.G + F.vcu, NGW = F.G * NWAVES;
    constexpr int NITEMS = 32 * (SRC_LD / 32) + 64 * 64;
    constexpr int NXB = MTOK / 16;
    const int nheavy = (F.G == 256) ? NXB - (NXB / F.G) * F.G : 0;
    const bool heavy = F.vcu < nheavy;
    const int lw = (F.vcu - nheavy) * NWAVES + F.wave;
    const int norph = nheavy * NWAVES * 2;
    int extra = -1;
    if (!heavy && nheavy > 0 && lw < norph) { const int kk = lw / (nheavy * NWAVES), r = lw - kk * nheavy * NWAVES, ow = r / nheavy, ov = r - ow * nheavy; extra = ow * F.G + ov + (6 + kk) * NGW; if (extra >= NITEMS) extra = -1; }
    if (gw >= NITEMS) return;
    const int nb = (NITEMS - gw + NGW - 1) / NGW;
    const int ntrip = heavy ? nb - (nb > 6 ? (nb > 7 ? 2 : 1) : 0) : nb + (extra >= 0 ? 1 : 0);
#define P0_ITEM(J) (heavy ? gw + ((J) < 6 ? (J) : (J) + 2) * NGW : ((J) < nb ? gw + (J) * NGW : extra))
    P0Item cur = p0_decode(P0_ITEM(0), w_in, w_out, norm_w, WinT, WdtT, WoutT);
    p0f4 v[8]; float sv[8];
    p0_item_load(cur, F.lane, v, sv);
#pragma unroll 1
    for (int j = 0; j < ntrip; ++j) {
        const int jn = j + 1 < ntrip ? j + 1 : j;
        P0Item nxt = p0_decode(P0_ITEM(jn), w_in, w_out, norm_w, WinT, WdtT, WoutT);
        p0f4 v2[8]; float sv2[8];
        p0_item_load(nxt, F.lane, v2, sv2);
        p0_item_store(cur, F.lane, v, sv, scr);
        cur = nxt;
#pragma unroll
        for (int i = 0; i < 8; ++i) { v[i] = v2[i]; sv[i] = sv2[i]; }
    }
#undef P0_ITEM
}
typedef float f32x4v __attribute__((ext_vector_type(4)));
__device__ __forceinline__ void p0b_rows(Frame& F, const float* __restrict__ xp, const float* __restrict__ xs, const bf16* __restrict__ WdtT, const float* __restrict__ dt_bias, bf16* __restrict__ H, float* __restrict__ rstd, float* __restrict__ dtb) {
    const int gw = F.wave * F.G + F.vcu, NGW = F.G * NWAVES, lane = F.lane, r = lane & 15, kq = lane >> 4;
    for (int blk = gw; blk < MTOK / 16; blk += NGW) {
        const int row = blk * 16 + r;
        const float* __restrict__ xr = (row < TP ? xp + (size_t)row * DM : xs + (size_t)(row - TP) * DM) + 8 * kq;
        bf16* __restrict__ hr = H + (size_t)row * DM + 8 * kq;
        const bf16* __restrict__ w0 = WdtT + (size_t)r * DM + 8 * kq; const bf16* __restrict__ w1 = w0 + (size_t)16 * DM;
        f32x4v a0 = {0.f, 0.f, 0.f, 0.f}, a1 = {0.f, 0.f, 0.f, 0.f}; float ss = 0.f;
#pragma unroll 1
        for (int s8 = 0; s8 < 8; ++s8) {
            f32x4v xu[8], xv[8]; bf16x8 b0[8], b1[8];
#pragma unroll
            for (int i = 0; i < 8; ++i) { const int s = s8 * 8 + i; xu[i] = *(const f32x4v*)(xr + 32 * s); xv[i] = *(const f32x4v*)(xr + 32 * s + 4); b0[i] = *(const bf16x8*)(w0 + 32 * s); b1[i] = *(const bf16x8*)(w1 + 32 * s); }
#pragma unroll
            for (int i = 0; i < 8; ++i) { const int s = s8 * 8 + i; const f32x4v u = xu[i], v = xv[i];
                ss += (u[0] * u[0] + u[1] * u[1]) + (u[2] * u[2] + u[3] * u[3]) + (v[0] * v[0] + v[1] * v[1]) + (v[2] * v[2] + v[3] * v[3]);
                v4u p; p.x = pg8::cvt_pk_bf16(u[0], u[1]); p.y = pg8::cvt_pk_bf16(u[2], u[3]); p.z = pg8::cvt_pk_bf16(v[0], v[1]); p.w = pg8::cvt_pk_bf16(v[2], v[3]);
                *(v4u*)(hr + 32 * s) = p;
                const bf16x8 af = __builtin_bit_cast(bf16x8, p);
                a0 = __builtin_amdgcn_mfma_f32_16x16x32_bf16(af, b0[i], a0, 0, 0, 0);
                a1 = __builtin_amdgcn_mfma_f32_16x16x32_bf16(af, b1[i], a1, 0, 0, 0); }
        }
        ss += __shfl_xor(ss, 16); ss += __shfl_xor(ss, 32);
        const float rs = __builtin_amdgcn_rsqf(ss * (1.0f / DM) + EPS);
        if (lane < 16) rstd[row] = rs;
        const float bia0 = dt_bias[r], bia1 = dt_bias[16 + r];
#pragma unroll
        for (int i = 0; i < 4; ++i) {
            const float rsi = __shfl(rs, 4 * kq + i);
            float v0 = a0[i] * rsi + bia0, v1 = a1[i] * rsi + bia1;
            v0 = v0 > 20.f ? v0 : __logf(1.0f + __expf(v0)); v1 = v1 > 20.f ? v1 : __logf(1.0f + __expf(v1));
            float* o = dtb + (size_t)(blk * 16 + 4 * kq + i) * 32;
            o[r] = v0; o[16 + r] = v1;
        }
    }
}

__device__ __forceinline__ void p0x_rows(Frame& F, const float* __restrict__ xp, const float* __restrict__ xs, const float* __restrict__ w_in, const float* __restrict__ norm_w, const float* __restrict__ dt_bias,
                                         bf16* __restrict__ H, float* __restrict__ rstd, float* __restrict__ dtb) {
    const int lane = F.lane, r = lane & 15, kq = lane >> 4, w = F.wave, tid = F.tid;
    LAS float* scr = (LAS float*)(F.lds + RING_OFF + w * 16384);
    bf16x8 b0[8], b1[8];
    {
        const int r8 = lane >> 3, c4 = (lane & 7) * 4;
#pragma unroll
        for (int q = 0; q < 4; ++q) {
            const int k0 = 256 * w + 64 * q;
            p0f4 v[8]; float sv[8];
#pragma unroll
            for (int i = 0; i < 8; ++i) { v[i] = *(const p0f4*)(w_in + (size_t)(k0 + 8 * i + r8) * SRC_LD + 5120 + c4); sv[i] = norm_w[k0 + 8 * i + r8]; }
#pragma unroll
            for (int i = 0; i < 8; ++i) { LAS float* p = scr + (8 * i + r8) * 33 + c4; p[0] = v[i][0] * sv[i]; p[1] = v[i][1] * sv[i]; p[2] = v[i][2] * sv[i]; p[3] = v[i][3] * sv[i]; }
            LDS_WAIT(); asm volatile("" ::: "memory");
#pragma unroll
            for (int t = 0; t < 2; ++t) { const LAS float* s0 = scr + (32 * t + 8 * kq) * 33 + r; const LAS float* s1 = s0 + 16;
                v4u o0, o1;
                o0.x = pk2(s0[0 * 33], s0[1 * 33]); o0.y = pk2(s0[2 * 33], s0[3 * 33]); o0.z = pk2(s0[4 * 33], s0[5 * 33]); o0.w = pk2(s0[6 * 33], s0[7 * 33]);
                o1.x = pk2(s1[0 * 33], s1[1 * 33]); o1.y = pk2(s1[2 * 33], s1[3 * 33]); o1.z = pk2(s1[4 * 33], s1[5 * 33]); o1.w = pk2(s1[6 * 33], s1[7 * 33]);
                b0[2 * q + t] = __builtin_bit_cast(bf16x8, o0); b1[2 * q + t] = __builtin_bit_cast(bf16x8, o1); }
            LDS_WAIT(); asm volatile("" ::: "memory");
        }
    }
#define P0X_RED(PAR, W) ((LAS float*)(F.lds + RING_OFF + (W) * 16384 + 8448 + (PAR) * 2304))
    const int nblk = MTOK / 16;
    int blk = F.vcu;
    f32x4v xu[8], xv[8];
    if (blk < nblk) { const int row = blk * 16 + r; const float* xr = (row < TP ? xp + (size_t)row * DM : xs + (size_t)(row - TP) * DM) + 256 * w + 8 * kq;
#pragma unroll
        for (int i = 0; i < 8; ++i) { xu[i] = *(const f32x4v*)(xr + 32 * i); xv[i] = *(const f32x4v*)(xr + 32 * i + 4); } }
    int par = 0;
#pragma unroll 1
    for (; blk < nblk; blk += F.G, par ^= 1) {
        const int row = blk * 16 + r;
        bf16* __restrict__ hr = H + (size_t)row * DM + 256 * w + 8 * kq;
        f32x4v a0 = {0.f, 0.f, 0.f, 0.f}, a1 = {0.f, 0.f, 0.f, 0.f}; float ss = 0.f;
#pragma unroll
        for (int i = 0; i < 8; ++i) { const f32x4v u = xu[i], v = xv[i];
            ss += (u[0] * u[0] + u[1] * u[1]) + (u[2] * u[2] + u[3] * u[3]) + (v[0] * v[0] + v[1] * v[1]) + (v[2] * v[2] + v[3] * v[3]);
            v4u p; p.x = pg8::cvt_pk_bf16(u[0], u[1]); p.y = pg8::cvt_pk_bf16(u[2], u[3]); p.z = pg8::cvt_pk_bf16(v[0], v[1]); p.w = pg8::cvt_pk_bf16(v[2], v[3]);
            *(v4u*)(hr + 32 * i) = p;
            const bf16x8 af = __builtin_bit_cast(bf16x8, p);
            a0 = __builtin_amdgcn_mfma_f32_16x16x32_bf16(af, b0[i], a0, 0, 0, 0);
            a1 = __builtin_amdgcn_mfma_f32_16x16x32_bf16(af, b1[i], a1, 0, 0, 0); }
        {
            const int nb = blk + F.G;
            if (nb < nblk) { const int nrow = nb * 16 + r; const float* xr = (nrow < TP ? xp + (size_t)nrow * DM : xs + (size_t)(nrow - TP) * DM) + 256 * w + 8 * kq;
#pragma unroll
                for (int i = 0; i < 8; ++i) { xu[i] = *(const f32x4v*)(xr + 32 * i); xv[i] = *(const f32x4v*)(xr + 32 * i + 4); } }
        }
        ss += __shfl_xor(ss, 16); ss += __shfl_xor(ss, 32);
        LAS float* rw = P0X_RED(par, w);
#pragma unroll
        for (int i = 0; i < 4; ++i) { rw[i * 64 + lane] = a0[i]; rw[(4 + i) * 64 + lane] = a1[i]; }
        rw[8 * 64 + lane] = ss;
        __syncthreads();
        {
            const int rho = tid >> 5, eta = tid & 31, sl = (eta & 15) + 16 * (rho >> 2), j = (eta >> 4) * 4 + (rho & 3);
            float acc = 0.f, sq = 0.f;
#pragma unroll
            for (int ww = 0; ww < 8; ++ww) { const LAS float* q = P0X_RED(par, ww); acc += q[j * 64 + sl]; sq += q[8 * 64 + rho]; }
            const float rs = __builtin_amdgcn_rsqf(sq * (1.0f / DM) + EPS);
            if (eta == 0) rstd[blk * 16 + rho] = rs;
            float v0 = acc * rs + dt_bias[eta];
            v0 = v0 > 20.f ? v0 : __logf(1.0f + __expf(v0));
            dtb[(size_t)blk * 512 + tid] = v0;
        }
    }
}
namespace ssd {
typedef _Float16 half8 __attribute__((ext_vector_type(8)));
typedef float f32x16 __attribute__((ext_vector_type(16)));
typedef float f4 __attribute__((ext_vector_type(4)));
typedef unsigned u2 __attribute__((ext_vector_type(2)));
typedef unsigned u4 __attribute__((ext_vector_type(4)));
constexpr int XT_OFF = 0, BT_OFF = 36864, BS_OFF = 55296, CS_OFF = 72704, GT_OFF = 90112, TAB_OFF = 102400, RED_OFF = 107520, TOTA_OFF = 111616, RS_OFF = 112640;
constexpr float LOG2E = 1.4426950408889634f;
#define MFMA16(a, b, c) __builtin_amdgcn_mfma_f32_32x32x16_f16((a), (b), (c), 0, 0, 0)
#define LBAR() do { asm volatile("s_waitcnt lgkmcnt(0)" ::: "memory"); __builtin_amdgcn_s_barrier(); asm volatile("" ::: "memory"); } while (0)
__device__ __forceinline__ int xt_addr(int hl, int p, int ch) { return XT_OFF + (hl * 64 + p) * 144 + (ch << 4); }
__device__ __forceinline__ int bt_addr(int n, int ch) { return BT_OFF + n * 144 + (ch << 4); }
__device__ __forceinline__ int bs_addr(int j, int ch) { return BS_OFF + j * 272 + (ch << 4); }
__device__ __forceinline__ int cs_addr(int i, int ch) { return CS_OFF + i * 272 + (ch << 4); }
__device__ __forceinline__ unsigned pkh(float a, float b) { return __builtin_bit_cast(unsigned, __builtin_amdgcn_cvt_pkrtz(a, b)); }
__device__ __forceinline__ half8 pack_step(const f32x16& x, int s) {
    u4 p; p.x = pkh(x[8 * s], x[8 * s + 1]); p.y = pkh(x[8 * s + 2], x[8 * s + 3]); p.z = pkh(x[8 * s + 4], x[8 * s + 5]); p.w = pkh(x[8 * s + 6], x[8 * s + 7]);
    return __builtin_bit_cast(half8, p);
}
__device__ __forceinline__ half8 ld2x8(const LAS unsigned char* lds, int a0, int a1) {
    const u2 lo = *(const LAS u2*)(lds + a0), hi = *(const LAS u2*)(lds + a1); u4 p; p.x = lo.x; p.y = lo.y; p.z = hi.x; p.w = hi.y; return __builtin_bit_cast(half8, p);
}
__device__ __forceinline__ f4 bf4(u2 r) { return (f4){__uint_as_float(r.x << 16), __uint_as_float(r.x & 0xffff0000u), __uint_as_float(r.y << 16), __uint_as_float(r.y & 0xffff0000u)}; }
struct Ctx {
    const unsigned short* XBC; const float* DT; unsigned short* ZQ; const float* conv_w; const float* conv_b; const float* a_log; const float* d_skip; const float* ssm_norm_w; const float* state_conv; unsigned short* YO; unsigned char* BCC;
};
template <bool FULL, bool SAMPLE>
__device__ __forceinline__ void chunk(const Frame& F, const Ctx& c, int g, int hh, int row0, int hb, int ci, f32x16 (&S)[4], float& dec2, int cmode = -1, unsigned char* cch = nullptr) {
    constexpr int nvalid = SAMPLE ? 32 : 64;
    const LAS unsigned char* ldr = F.lds; LAS unsigned char* ldw = F.lds;
    int z0; asm volatile("v_mov_b32 %0, 0" : "=v"(z0));
    const int tid = F.tid + z0, lane = F.lane + z0, w = F.wave, l31 = lane & 31, h = lane >> 5, hl = w >> 1, ph = w & 1, head = g * 8 + hh * 4 + hl;
    LAS float* tab_a = (LAS float*)(ldw + TAB_OFF + w * 640); LAS float* tab_d = tab_a + 64; LAS _Float16* tab_w = (LAS _Float16*)(tab_a + 128);
    const float alog = c.a_log[head];
    const float dtv = lane < nvalid ? c.DT[(size_t)(row0 + lane) * 32 + head] : 0.f;
    {
        const bool cached = cmode == 1;
        constexpr int BCB = FULL ? 53248 : 18432;
        if (cached) {
#pragma unroll
            for (int k = 0; k < (BCB / 1024 + 7) / 8; ++k) { const int pc = w + 8 * k;
                if (pc < BCB / 1024) __builtin_amdgcn_global_load_lds((const unsigned*)(cch + pc * 1024 + lane * 16), (LAS unsigned*)(ldw + BT_OFF + pc * 1024), 16, 0, 0); }
        }
        const int kind = cached ? (w & 1) : (w & 3), tq0 = cached ? (w >> 1) : (w >> 2);
        const int nrnd = cached ? 1 : 2;
        const bool isx = kind < 2, isb = kind == 2;
        if (FULL || kind < 3) {
            const int colbase = isx ? 512 * g + 256 * hh + 128 * kind : (isb ? 2048 + 128 * g : 2560 + 128 * g);
            const unsigned lane2 = (unsigned)lane * 2u;
            typedef float f2 __attribute__((ext_vector_type(2)));
            const float* wbase = c.conv_w + colbase;
            const f2 w0 = *(const f2*)(wbase + lane2), w1 = *(const f2*)(wbase + CONVD + lane2), w2 = *(const f2*)(wbase + 2 * CONVD + lane2), w3 = *(const f2*)(wbase + 3 * CONVD + lane2), cb = *(const f2*)(c.conv_b + colbase + lane2);
#define BF2(u) ((f2){__uint_as_float((u) << 16), __uint_as_float((u) & 0xffff0000u)})
            unsigned hraw[2][3], rv[2][16]; f2 hst[3];
#pragma unroll
            for (int rnd = 0; rnd < 2; ++rnd) if (rnd < nrnd) {
                const int tq = tq0 + 2 * rnd;
#pragma unroll
                for (int t = 0; t < 3; ++t) { const int j = 16 * tq - 3 + t;
                    const int r = SAMPLE ? row0 + (j < 0 ? 0 : (j & 31)) : (row0 + j < 0 ? 0 : row0 + j);
                    hraw[rnd][t] = *(const unsigned*)(c.XBC + (size_t)r * CONVD + colbase + lane2); }
                const unsigned short* xr = c.XBC + (size_t)(row0 + (SAMPLE ? ((16 * tq) & 31) : 16 * tq)) * CONVD + colbase;
#pragma unroll
                for (int i = 0; i < 16; ++i) rv[rnd][i] = *(const unsigned*)(xr + (size_t)i * CONVD + lane2);
            }
            if (SAMPLE) {
#pragma unroll
                for (int t = 0; t < 3; ++t) hst[t] = *(const f2*)(c.state_conv + ((size_t)hb * 3 + t) * CONVD + colbase + lane2);
            }
            const int xt_l = XT_OFF + (128 * (kind & 1) + 2 * lane) * 144, bt_l = BT_OFF + 2 * lane * 144;
            const int rm_l = (isb ? BS_OFF : CS_OFF) + 4 * lane;
#pragma unroll
            for (int rnd = 0; rnd < 2; ++rnd) if (rnd < nrnd) {
                const int tq = tq0 + 2 * rnd;
                f2 win0, win1, win2;
                if (SAMPLE) { const bool first = (tq == 0); win0 = first ? hst[0] : BF2(hraw[rnd][0]); win1 = first ? hst[1] : BF2(hraw[rnd][1]); win2 = first ? hst[2] : BF2(hraw[rnd][2]); }
                else { const bool zer = (row0 + 16 * tq) < 3;
                    win0 = zer ? (f2){0.f, 0.f} : BF2(hraw[rnd][0]); win1 = zer ? (f2){0.f, 0.f} : BF2(hraw[rnd][1]); win2 = zer ? (f2){0.f, 0.f} : BF2(hraw[rnd][2]); }
                const bool ok = !SAMPLE || tq < 2;
#pragma unroll
                for (int tgl = 0; tgl < 2; ++tgl) {
                    const int tg = 2 * tq + tgl, j0 = 8 * tg;
                    unsigned pt[2][4];
                    unsigned pr[8];
#pragma unroll
                    for (int i2 = 0; i2 < 4; ++i2) {
                        f2 oa, ob;
                        { const f2 cur = BF2(rv[rnd][8 * tgl + 2 * i2]); const f2 cv = cb + w0 * win0 + w1 * win1 + w2 * win2 + w3 * cur;
#pragma unroll
                          for (int e = 0; e < 2; ++e) oa[e] = ok ? cv[e] * __builtin_amdgcn_rcpf(1.0f + __builtin_amdgcn_exp2f(-LOG2E * cv[e])) : 0.f;
                          win0 = win1; win1 = win2; win2 = cur; }
                        { const f2 cur = BF2(rv[rnd][8 * tgl + 2 * i2 + 1]); const f2 cv = cb + w0 * win0 + w1 * win1 + w2 * win2 + w3 * cur;
#pragma unroll
                          for (int e = 0; e < 2; ++e) ob[e] = ok ? cv[e] * __builtin_amdgcn_rcpf(1.0f + __builtin_amdgcn_exp2f(-LOG2E * cv[e])) : 0.f;
                          win0 = win1; win1 = win2; win2 = cur; }
                        pt[0][i2] = pkh(oa[0], ob[0]); pt[1][i2] = pkh(oa[1], ob[1]);
                        pr[2 * i2] = pkh(oa[0], oa[1]); pr[2 * i2 + 1] = pkh(ob[0], ob[1]);
                    }
                    if (isx || isb) {
#pragma unroll
                        for (int e = 0; e < 2; ++e) { u4 pk; pk.x = pt[e][0]; pk.y = pt[e][1]; pk.z = pt[e][2]; pk.w = pt[e][3];
                            *(LAS u4*)(ldw + (isx ? xt_l : bt_l) + e * 144 + tg * 16) = pk; }
                    }
                    if (!isx && FULL) {
#pragma unroll
                        for (int i = 0; i < 8; ++i) *(LAS unsigned*)(ldw + rm_l + (j0 + i) * 272) = pr[i];
                    }
                }
            }
#undef BF2
        }
    }
    float a2_last;
    {
        const float A2 = -__expf(alog) * LOG2E;
        float a = dtv * A2;
#pragma unroll
        for (int o = 1; o < 64; o <<= 1) { const float t = __shfl_up(a, o); if (lane >= o) a += t; }
        a2_last = __shfl(a, 63);
        tab_a[lane] = a; tab_d[lane] = dtv; tab_w[lane] = (_Float16)(dtv * __builtin_amdgcn_exp2f(a2_last - a));
        dec2 += a2_last;
    }
    if (cmode == 1) asm volatile("s_waitcnt vmcnt(0)" ::: "memory");
    LBAR();
    if (cmode == 0) {
        constexpr int BCB = FULL ? 53248 : 18432;
#pragma unroll
        for (int k = 0; k < (BCB / 16 + 511) / 512; ++k) { const int pc = tid + 512 * k;
            if (pc < BCB / 16) *(u4*)(cch + pc * 16) = *(const LAS u4*)(ldr + BT_OFF + pc * 16); }
    }
    if constexpr (FULL) {
        const float Dk = c.d_skip[head];
        u2 zc[4]; f4 nwv[4];
#pragma unroll
        for (int q = 0; q < 4; ++q) nwv[q] = *(const f4*)(c.ssm_norm_w + head * 64 + 32 * ph + 8 * q + 4 * h);
#pragma unroll
        for (int q = 0; q < 4; ++q) zc[q] = *(const u2*)(c.ZQ + (size_t)(row0 + l31) * 4096 + head * 64 + 32 * ph + 8 * q + 4 * h);
        u2 zn[4];
        if (!SAMPLE) {
#pragma unroll
            for (int q = 0; q < 4; ++q) zn[q] = *(const u2*)(c.ZQ + (size_t)(row0 + 32 + l31) * 4096 + head * 64 + 32 * ph + 8 * q + 4 * h);
        }
        if (w < 4 && w != 2) {
            const int jt = w >> 1, it = w & 1; f32x16 gacc;
#pragma unroll
            for (int r = 0; r < 16; ++r) gacc[r] = 0.f;
            half8 an = *(const LAS half8*)(ldr + bs_addr(32 * jt + l31, h)), bn = *(const LAS half8*)(ldr + cs_addr(32 * it + l31, h));
#pragma unroll
            for (int s = 0; s < 8; ++s) {
                const half8 a = an, b = bn;
                if (s < 7) { an = *(const LAS half8*)(ldr + bs_addr(32 * jt + l31, 2 * (s + 1) + h)); bn = *(const LAS half8*)(ldr + cs_addr(32 * it + l31, 2 * (s + 1) + h)); }
                gacc = MFMA16(a, b, gacc);
                __builtin_amdgcn_sched_barrier(0);
            }
            LAS f4* gt = (LAS f4*)(ldw + GT_OFF + (jt + it) * 4096);
#pragma unroll
            for (int q = 0; q < 4; ++q) gt[q * 64 + lane] = (f4){gacc[4 * q], gacc[4 * q + 1], gacc[4 * q + 2], gacc[4 * q + 3]};
        }
        LBAR();
        LAS float* tota = (LAS float*)(ldw + TOTA_OFF) + ci * 64; LAS float* rsv = (LAS float*)(ldw + RS_OFF);
#pragma unroll
        for (int it = 0; it < (SAMPLE ? 1 : 2); ++it) {
            const int i = 32 * it + l31; const float a2i = tab_a[i];
            f32x16 yd, yo;
#pragma unroll
            for (int r = 0; r < 16; ++r) { yd[r] = 0.f; yo[r] = 0.f; }
            const int p = 32 * ph + l31;
#pragma unroll 1
            for (int jt = 0; jt <= it; ++jt) {
                f32x16 m;
                const half8 pa_0 = ld2x8(ldr, xt_addr(hl, p, 4 * jt) + 8 * h, xt_addr(hl, p, 4 * jt + 1) + 8 * h), pa_1 = ld2x8(ldr, xt_addr(hl, p, 4 * jt + 2) + 8 * h, xt_addr(hl, p, 4 * jt + 3) + 8 * h);
                const LAS f4* gt = (const LAS f4*)(ldr + GT_OFF + (jt + it) * 4096);
#pragma unroll
                for (int q = 0; q < 4; ++q) {
                    const f4 gv = gt[q * 64 + lane]; const int jb = 32 * jt + 8 * q + 4 * h;
                    const f4 aj = *(const LAS f4*)(tab_a + jb), dj = *(const LAS f4*)(tab_d + jb);
#pragma unroll
                    for (int e = 0; e < 4; ++e) { const float v = gv[e] * __builtin_amdgcn_exp2f(fminf(a2i - aj[e], 0.f)) * dj[e]; m[4 * q + e] = (jb + e <= i) ? v : 0.f; }
                    __builtin_amdgcn_sched_barrier(0);
                }
                yd = MFMA16(pa_0, pack_step(m, 0), yd);
                yd = MFMA16(pa_1, pack_step(m, 1), yd);
                __builtin_amdgcn_sched_barrier(0);
            }
            _Float16 xh[16];
#pragma unroll
            for (int q = 0; q < 4; ++q)
#pragma unroll
                for (int e = 0; e < 4; ++e) xh[4 * q + e] = *(const LAS _Float16*)(ldr + xt_addr(hl, 32 * ph + 8 * q + 4 * h + e, i >> 3) + 2 * (i & 7));
            {
                half8 pbn = ld2x8(ldr, cs_addr(i, 0) + 8 * h, cs_addr(i, 1) + 8 * h);
#pragma unroll
                for (int k = 0; k < 8; ++k) {
                    const half8 pb = pbn;
                    if (k < 7) pbn = ld2x8(ldr, cs_addr(i, 2 * (k + 1)) + 8 * h, cs_addr(i, 2 * (k + 1) + 1) + 8 * h);
                    yo = MFMA16(pack_step(S[k >> 1], k & 1), pb, yo);
                    __builtin_amdgcn_sched_barrier(0);
                }
            }
            const float sci = __builtin_amdgcn_exp2f(a2i);
            const unsigned short* zrow = c.ZQ + (size_t)(row0 + i) * 4096 + head * 64; unsigned short* yrow = c.YO + (size_t)(row0 + i) * 4096 + head * 64;
            float ss = 0.f;
#pragma unroll
            for (int q = 0; q < 4; ++q) {
                const int p0 = 32 * ph + 8 * q + 4 * h;
                const f4 zg = bf4(zc[q]);
#pragma unroll
                for (int e = 0; e < 4; ++e) { const float xv = (float)xh[4 * q + e];
                    float y = yd[4 * q + e] + sci * yo[4 * q + e] + Dk * xv; y *= zg[e]; yd[4 * q + e] = y; ss += y * y; }
                __builtin_amdgcn_sched_barrier(0);
            }
            ss += __shfl_xor(ss, 32);
            LAS float* red = (LAS float*)(ldw + RED_OFF + it * 2048);
            if (h == 0) red[w * 64 + i] = ss;
            LBAR();
            float r8[8];
#pragma unroll
            for (int ww = 0; ww < 8; ++ww) r8[ww] = red[ww * 64 + i];
            __builtin_amdgcn_sched_barrier(0);
            float tot = ((r8[0] + r8[1]) + (r8[2] + r8[3])) + ((r8[4] + r8[5]) + (r8[6] + r8[7]));
            float rs = 1.0f;
            if (hh == 0) { if (w == 0 && h == 0) tota[i] = tot; }
            else { tot += tota[i]; rs = __builtin_amdgcn_rsqf(tot * (1.0f / 512.0f) + EPS); if (w == 0 && h == 0) rsv[i] = rs; }
#pragma unroll
            for (int q = 0; q < 4; ++q) { const int p0 = 32 * ph + 8 * q + 4 * h; const f4 nw = nwv[q];
                u2 o; o.x = pg8::cvt_pk_bf16(yd[4 * q] * rs * nw[0], yd[4 * q + 1] * rs * nw[1]); o.y = pg8::cvt_pk_bf16(yd[4 * q + 2] * rs * nw[2], yd[4 * q + 3] * rs * nw[3]);
                *(u2*)(yrow + p0) = o; __builtin_amdgcn_sched_barrier(0); }
            if (!SAMPLE && it == 0) {
#pragma unroll
                for (int q = 0; q < 4; ++q) zc[q] = zn[q];
            }
        }
    }
    u4 fx[4]; unsigned short* fzp = c.YO + (size_t)(row0 + (tid >> 3)) * 4096 + g * 512 + (tid & 7) * 32;
    const bool dofix = FULL && hh == 1 && (tid >> 3) < nvalid;
    if (dofix) {
#pragma unroll
        for (int v = 0; v < 4; ++v) fx[v] = *(const u4*)(fzp + 8 * v);
    }
    {
        const float dk = __builtin_amdgcn_exp2f(a2_last);
#pragma unroll
        for (int t = 0; t < 4; ++t)
#pragma unroll
            for (int r = 0; r < 16; ++r) S[t][r] *= dk;
#pragma unroll 1
        for (int s = 0; s < 4; ++s) {
            const half8 w8 = *(const LAS half8*)(tab_w + 16 * s + 8 * h);
            const half8 xw = *(const LAS half8*)(ldr + xt_addr(hl, 32 * ph + l31, 2 * s + h)) * w8;
#pragma unroll
            for (int nt = 0; nt < 4; ++nt) S[nt] = MFMA16(*(const LAS half8*)(ldr + bt_addr(32 * nt + l31, 2 * s + h)), xw, S[nt]);
            __builtin_amdgcn_sched_barrier(0);
        }
    }
    LBAR();
    if (dofix) {
        const float rs = ((const LAS float*)(ldr + RS_OFF))[tid >> 3];
#pragma unroll
        for (int v = 0; v < 4; ++v) { const u4 x = fx[v]; u4 o;
            o.x = pg8::cvt_pk_bf16(__uint_as_float(x.x << 16) * rs, __uint_as_float(x.x & 0xffff0000u) * rs); o.y = pg8::cvt_pk_bf16(__uint_as_float(x.y << 16) * rs, __uint_as_float(x.y & 0xffff0000u) * rs);
            o.z = pg8::cvt_pk_bf16(__uint_as_float(x.z << 16) * rs, __uint_as_float(x.z & 0xffff0000u) * rs); o.w = pg8::cvt_pk_bf16(__uint_as_float(x.w << 16) * rs, __uint_as_float(x.w & 0xffff0000u) * rs);
            *(u4*)(fzp + 8 * v) = o; }
    }
}
__device__ __forceinline__ void state_store_native(float* dst, const f32x16 (&S)[4], int lane, int ph) {
#pragma unroll
    for (int nt = 0; nt < 4; ++nt)
#pragma unroll
        for (int q = 0; q < 4; ++q) *(f4*)(dst + ((size_t)((nt * 2 + ph) * 4 + q) * 64 + lane) * 4) = (f4){S[nt][4 * q], S[nt][4 * q + 1], S[nt][4 * q + 2], S[nt][4 * q + 3]};
}
__device__ __forceinline__ void state_load_native(const float* src, f32x16 (&S)[4], int lane, int ph) {
#pragma unroll
    for (int nt = 0; nt < 4; ++nt)
#pragma unroll
        for (int q = 0; q < 4; ++q) { const f4 v = *(const f4*)(src + ((size_t)((nt * 2 + ph) * 4 + q) * 64 + lane) * 4); S[nt][4 * q] = v[0]; S[nt][4 * q + 1] = v[1]; S[nt][4 * q + 2] = v[2]; S[nt][4 * q + 3] = v[3]; }
}
__device__ __forceinline__ void state_store_pn(float* dst, const f32x16 (&S)[4], int lane, int ph) {
    const int l31 = lane & 31, h = lane >> 5;
#pragma unroll
    for (int nt = 0; nt < 4; ++nt)
#pragma unroll
        for (int q = 0; q < 4; ++q) *(f4*)(dst + (size_t)(32 * ph + l31) * NST + 32 * nt + 8 * q + 4 * h) = (f4){S[nt][4 * q], S[nt][4 * q + 1], S[nt][4 * q + 2], S[nt][4 * q + 3]};
}
__device__ __forceinline__ void state_load_pn(const float* src, f32x16 (&S)[4], int lane, int ph) {
    const int l31 = lane & 31, h = lane >> 5;
#pragma unroll
    for (int nt = 0; nt < 4; ++nt)
#pragma unroll
        for (int q = 0; q < 4; ++q) { const f4 v = *(const f4*)(src + (size_t)(32 * ph + l31) * NST + 32 * nt + 8 * q + 4 * h); S[nt][4 * q] = v[0]; S[nt][4 * q + 1] = v[1]; S[nt][4 * q + 2] = v[2]; S[nt][4 * q + 3] = v[3]; }
}
__device__ __forceinline__ void pass1_unit(const Frame& F, const Ctx& c, int u, float* seg, float* segdec) {
    const int sg = u >> 2, g = u & 3, hl = F.wave >> 1, ph = F.wave & 1;
#pragma unroll 1
    for (int hh = 0; hh < 2; ++hh) {
        const int head = g * 8 + hh * 4 + hl;
        f32x16 S[4];
#pragma unroll
        for (int t = 0; t < 4; ++t)
#pragma unroll
            for (int r = 0; r < 16; ++r) S[t][r] = 0.f;
        float dec2 = 0.f;
#pragma unroll 1
        for (int ch = 0; ch < 4; ++ch) { const int row0 = sg * 256 + ch * 64; chunk<false, false>(F, c, g, hh, row0, 0, ch, S, dec2, hh, c.BCC + ((size_t)u * 4 + ch) * 53248); }
        state_store_native(seg + ((size_t)sg * NHS + head) * 8192, S, F.lane, ph);
        if (F.lane == 0 && ph == 0) segdec[sg * NHS + head] = __builtin_amdgcn_exp2f(dec2);
        __syncthreads();
    }
}
__device__ __forceinline__ void pass2_unit(const Frame& F, const Ctx& c, int u, const float* seg, const float* state_ssm, float* out) {
    const int g = u & 3, hl = F.wave >> 1, ph = F.wave & 1;
#pragma unroll 1
    for (int hh = 0; hh < 2; ++hh) {
        const int head = g * 8 + hh * 4 + hl;
        f32x16 S[4]; float dec2 = 0.f;
        if (u < 256) {
            const int sg = u >> 2;
            state_load_native(seg + ((size_t)sg * NHS + head) * 8192, S, F.lane, ph);
#pragma unroll 1
            for (int ch = 0; ch < 4; ++ch) { const int row0 = sg * 256 + ch * 64; chunk<true, false>(F, c, g, hh, row0, 0, ch, S, dec2, hh, c.BCC + ((size_t)u * 4 + ch) * 53248); }
            if (sg == 63) state_store_pn(out + O_PSSM + (size_t)head * PH * NST, S, F.lane, ph);
        } else {
            const int b = (u - 256) >> 2;
            state_load_pn(state_ssm + ((size_t)b * NHS + head) * PH * NST, S, F.lane, ph);
            chunk<true, true>(F, c, g, hh, TP + b * 32, b, 0, S, dec2);
            state_store_pn(out + O_SSSM + ((size_t)b * NHS + head) * PH * NST, S, F.lane, ph);
        }
        __syncthreads();
    }
}
__device__ __forceinline__ void combine(const Frame& F, float* seg, const float* segdec) {
    const int gid = blockIdx.x * 512 + F.tid;
    if (gid < 65536) {
        const int head = gid >> 11; f4 R = {0.f, 0.f, 0.f, 0.f};
        f4* p = (f4*)seg + gid;
#pragma unroll 8
        for (int s = 0; s < 64; ++s) { const f4 t = p[(size_t)s * 65536]; const float d = segdec[s * NHS + head]; p[(size_t)s * 65536] = R; R = R * d + t; }
    }
}
#undef MFMA16
#undef LBAR
}
namespace att {
using bf16x8 = __attribute__((ext_vector_type(8))) short;
using s16x4  = __attribute__((ext_vector_type(4))) short;
using f32x16 = __attribute__((ext_vector_type(16))) float;
using u32x4  = __attribute__((ext_vector_type(4))) unsigned;
constexpr int SHM_K = 17408, SHM_V = 16384, WREG = 17408;
constexpr int V_OFF = 0, K_OFF = 2 * SHM_V, TAB_OFF = 8 * WREG  , TAB_STRIDE = 1028  , LI_OFF = TAB_OFF + 16 * TAB_STRIDE  ;
#ifndef ATSEC
#define ATSEC -1
#endif
#define ATS(k) do { if (ATSEC == (k) && F.tid == 0) atst = __builtin_amdgcn_s_memrealtime(); } while (0)
#define ATE(k) do { if (ATSEC == (k) && F.tid == 0) { F.MISC[17] += (unsigned)(__builtin_amdgcn_s_memrealtime() - atst); } } while (0)
#define KSWZ(row, colB) ((row) * 272 + (colB))
#define SBAR() __builtin_amdgcn_sched_barrier(0)
__device__ __forceinline__ int crow(int r, int hi) { return (r & 3) + 8 * (r >> 2) + 4 * hi; }
__device__ __forceinline__ unsigned cvtpk(float lo, float hi) { unsigned r; asm volatile("v_cvt_pk_bf16_f32 %0, %1, %2" : "=v"(r) : "v"(lo), "v"(hi)); return r; }
__device__ __forceinline__ int v_st(int k, int c) { const int kk = (k & ~0xC) | ((k & 4) << 1) | ((k & 8) >> 1); return ((kk >> 3) * 4 + (c >> 5)) * 512 + ((kk & 7) * 32 + (c & 31)) * 2; }
__device__ __forceinline__ int v_rd_base(int lane) { return ((lane & 3) << 3) | (((lane >> 2) & 3) << 6) | (((lane >> 4) & 1) << 5) | (((lane >> 5) & 1) << 8); }
constexpr int v_rd_off(int d0, int ks, int half) { return d0 * 512 + ks * 4096 + half * 2048; }
template <int OFF> __device__ __forceinline__ s16x4 tr_read(int vb) { s16x4 r; asm volatile("ds_read_b64_tr_b16 %0, %1 offset:%2" : "=&v"(r) : "v"(vb), "i"(OFF) : "memory"); return r; }
__device__ __forceinline__ void qkt(f32x16& p0, f32x16& p1, const LAS unsigned char* Ks, const bf16x8* qr, int r32, int hi) {
#pragma unroll
    for (int r = 0; r < 16; ++r) { p0[r] = 0.f; p1[r] = 0.f; }
#pragma unroll
    for (int d0 = 0; d0 < 8; ++d0) { const int cb = (d0 * 16 + hi * 8) * 2;
        const bf16x8 b0 = *(const LAS bf16x8*)(Ks + KSWZ(r32, cb)), b1 = *(const LAS bf16x8*)(Ks + KSWZ(32 + r32, cb));
        p0 = __builtin_amdgcn_mfma_f32_32x32x16_bf16(b0, qr[d0], p0, 0, 0, 0);
        p1 = __builtin_amdgcn_mfma_f32_32x32x16_bf16(b1, qr[d0], p1, 0, 0, 0);
        if (d0 & 1) SBAR(); }
}
template <int D0> __device__ __forceinline__ void pv_one(f32x16& od, int vb, bf16x8 pa0, bf16x8 pa1, bf16x8 pa2, bf16x8 pa3) {
    const s16x4 l0 = tr_read<v_rd_off(D0, 0, 0)>(vb), h0 = tr_read<v_rd_off(D0, 0, 1)>(vb), l1 = tr_read<v_rd_off(D0, 1, 0)>(vb), h1 = tr_read<v_rd_off(D0, 1, 1)>(vb);
    const s16x4 l2 = tr_read<v_rd_off(D0, 2, 0)>(vb), h2 = tr_read<v_rd_off(D0, 2, 1)>(vb), l3 = tr_read<v_rd_off(D0, 3, 0)>(vb), h3 = tr_read<v_rd_off(D0, 3, 1)>(vb);
    asm volatile("s_waitcnt lgkmcnt(0)" ::: "memory"); SBAR();
#define PK(L, H) (bf16x8){L[0], L[1], L[2], L[3], H[0], H[1], H[2], H[3]}
    od = __builtin_amdgcn_mfma_f32_32x32x16_bf16(pa0, PK(l0, h0), od, 0, 0, 0);
    od = __builtin_amdgcn_mfma_f32_32x32x16_bf16(pa1, PK(l1, h1), od, 0, 0, 0);
    od = __builtin_amdgcn_mfma_f32_32x32x16_bf16(pa2, PK(l2, h2), od, 0, 0, 0);
    od = __builtin_amdgcn_mfma_f32_32x32x16_bf16(pa3, PK(l3, h3), od, 0, 0, 0);
#undef PK
}
__device__ __forceinline__ void pack_p(const f32x16& p0, const f32x16& p1, bf16x8& pa0, bf16x8& pa1, bf16x8& pa2, bf16x8& pa3) {
#define PK4(P, BASE, OUT) do { unsigned a0 = cvtpk(P[BASE + 0], P[BASE + 1]), a1 = cvtpk(P[BASE + 2], P[BASE + 3]);   \
    unsigned b0 = cvtpk(P[BASE + 4], P[BASE + 5]), b1 = cvtpk(P[BASE + 6], P[BASE + 7]);                              \
    auto r0 = __builtin_amdgcn_permlane32_swap(a0, b0, false, false); auto r1 = __builtin_amdgcn_permlane32_swap(a1, b1, false, false); \
    u32x4 w = {r0[0], r1[0], r0[1], r1[1]}; OUT = __builtin_bit_cast(bf16x8, w); } while (0)
    PK4(p0, 0, pa0); PK4(p0, 8, pa1); PK4(p1, 0, pa2); PK4(p1, 8, pa3);
#undef PK4
}

template <int KH, int D0> __device__ __forceinline__ void pv_half(f32x16& od, int vb, bf16x8 pa0, bf16x8 pa1) {
    const s16x4 l0 = tr_read<v_rd_off(D0, 2 * KH, 0)>(vb), h0 = tr_read<v_rd_off(D0, 2 * KH, 1)>(vb), l1 = tr_read<v_rd_off(D0, 2 * KH + 1, 0)>(vb), h1 = tr_read<v_rd_off(D0, 2 * KH + 1, 1)>(vb);
    asm volatile("s_waitcnt lgkmcnt(0)" ::: "memory"); SBAR();
    od = __builtin_amdgcn_mfma_f32_32x32x16_bf16(pa0, ((bf16x8){l0[0], l0[1], l0[2], l0[3], h0[0], h0[1], h0[2], h0[3]}), od, 0, 0, 0);
    od = __builtin_amdgcn_mfma_f32_32x32x16_bf16(pa1, ((bf16x8){l1[0], l1[1], l1[2], l1[3], h1[0], h1[1], h1[2], h1[3]}), od, 0, 0, 0);
}
template <int KH> __device__ __forceinline__ void half_tile(f32x16 (&o)[4], float& l_reg, const LAS unsigned char* Ks, int vb, const bf16x8* qr, const LAS float* tab, bool far_, float cfar, int base, int r32, int hi) {
    f32x16 p;
#pragma unroll
    for (int r = 0; r < 16; ++r) p[r] = 0.f;
#pragma unroll
    for (int d0 = 0; d0 < 8; ++d0) { const bf16x8 kf = *(const LAS bf16x8*)(Ks + KSWZ(32 * KH + r32, (d0 * 16 + hi * 8) * 2)); p = __builtin_amdgcn_mfma_f32_32x32x16_bf16(kf, qr[d0], p, 0, 0, 0); if ((d0 & 3) == 3) SBAR(); }
    float ps = 0.f;
    if (far_) {
#pragma unroll
        for (int r = 0; r < 16; ++r) { p[r] = __builtin_amdgcn_exp2f(p[r] + cfar); ps += p[r]; }
    } else {
#pragma unroll
        for (int r = 0; r < 16; ++r) { const int i0 = min(base - 32 * KH - crow(r, hi), 256); p[r] = __builtin_amdgcn_exp2f(p[r] + tab[i0]); ps += p[r]; }
    }
    l_reg += ps;
    bf16x8 pa0, pa1;
#define PK4(P, BASE, OUT) do { unsigned a0 = cvtpk(P[BASE + 0], P[BASE + 1]), a1 = cvtpk(P[BASE + 2], P[BASE + 3]);   \
    unsigned b0 = cvtpk(P[BASE + 4], P[BASE + 5]), b1 = cvtpk(P[BASE + 6], P[BASE + 7]);                              \
    auto r0 = __builtin_amdgcn_permlane32_swap(a0, b0, false, false); auto r1 = __builtin_amdgcn_permlane32_swap(a1, b1, false, false); \
    u32x4 w = {r0[0], r1[0], r0[1], r1[1]}; OUT = __builtin_bit_cast(bf16x8, w); } while (0)
    PK4(p, 0, pa0); PK4(p, 8, pa1);
#undef PK4
    pv_half<KH, 0>(o[0], vb, pa0, pa1); pv_half<KH, 1>(o[1], vb, pa0, pa1); pv_half<KH, 2>(o[2], vb, pa0, pa1); pv_half<KH, 3>(o[3], vb, pa0, pa1);
    SBAR();
}
struct Ctx { int abl; unsigned short* ZQ; unsigned short* O; const unsigned short* Kb; const unsigned short* Vb; const unsigned short* Gb; const float* rel_bias; const float* qw; const float* kw; };
__device__ __forceinline__ void load_bias_tabs(const Frame& F, const Ctx& c) {
    float mq = 0.f, mk = 0.f;
    for (int i = F.lane; i < 128; i += 64) { mq = fmaxf(mq, fabsf(c.qw[i])); mk = fmaxf(mk, fabsf(c.kw[i])); }
#pragma unroll
    for (int o = 1; o < 64; o <<= 1) { mq = fmaxf(mq, __shfl_xor(mq, o)); mk = fmaxf(mk, __shfl_xor(mk, o)); }
    for (int h = F.wave; h < NHA; h += NWAVES) {
        const float* rb = c.rel_bias + (size_t)h * 257; float v[5]; float mb = -1e30f;
#pragma unroll
        for (int t = 0; t < 5; ++t) { const int i = F.lane + 64 * t; v[t] = i < 257 ? rb[i] : -1e30f; mb = fmaxf(mb, v[t]); }
#pragma unroll
        for (int o = 1; o < 64; o <<= 1) mb = fmaxf(mb, __shfl_xor(mb, o));
        const float moff = 16.3222312f * mq * mk + mb * 1.4426950408889634f;
        LAS float* tab = (LAS float*)(F.lds + TAB_OFF + h * TAB_STRIDE);
#pragma unroll
        for (int t = 0; t < 5; ++t) { const int i = F.lane + 64 * t; if (i < 257) tab[i] = v[t] * 1.4426950408889634f - moff; }
    }
    __syncthreads();
}
template <int KH> __device__ __forceinline__ void half_tile_x(f32x16 (&o)[4], float& l_reg, const LAS unsigned char* Ks, int vb, const bf16x8* qr, const LAS float* tab, bool far_, float cfar, int base, int r32, int hi) {
    s16x4 vl[2][2], vh[2][2];
#define TRD(S, D0) vl[S][0] = tr_read<v_rd_off(D0, 2 * KH, 0)>(vb); vh[S][0] = tr_read<v_rd_off(D0, 2 * KH, 1)>(vb); vl[S][1] = tr_read<v_rd_off(D0, 2 * KH + 1, 0)>(vb); vh[S][1] = tr_read<v_rd_off(D0, 2 * KH + 1, 1)>(vb)
    TRD(0, 0); TRD(1, 1);
    f32x16 p;
#pragma unroll
    for (int r = 0; r < 16; ++r) p[r] = 0.f;
    int kb_[4];
#pragma unroll
    for (int m = 0; m < 4; ++m) kb_[m] = 256 * r32 + ((((2 * m + hi) ^ (r32 & 7))) << 4);
#pragma unroll
    for (int d0 = 0; d0 < 8; ++d0) { const bf16x8 kf = *(const LAS bf16x8*)(Ks + kb_[d0 & 3] + (d0 >> 2) * 128 + KH * 8192); p = __builtin_amdgcn_mfma_f32_32x32x16_bf16(kf, qr[d0], p, 0, 0, 0); }
    float ps = 0.f;
    if (far_) {
#pragma unroll
        for (int r = 0; r < 16; ++r) { p[r] = __builtin_amdgcn_exp2f(p[r] + cfar); ps += p[r]; }
    } else {
#pragma unroll
        for (int r = 0; r < 16; ++r) { const int i0 = min(base - 32 * KH - crow(r, hi), 256); p[r] = __builtin_amdgcn_exp2f(p[r] + tab[i0]); ps += p[r]; }
    }
    l_reg += ps;
    bf16x8 pa0, pa1;
#define PK4(P, BASE, OUT) do { unsigned a0 = cvtpk(P[BASE + 0], P[BASE + 1]), a1 = cvtpk(P[BASE + 2], P[BASE + 3]);   \
    unsigned b0 = cvtpk(P[BASE + 4], P[BASE + 5]), b1 = cvtpk(P[BASE + 6], P[BASE + 7]);                              \
    auto r0 = __builtin_amdgcn_permlane32_swap(a0, b0, false, false); auto r1 = __builtin_amdgcn_permlane32_swap(a1, b1, false, false); \
    u32x4 w = {r0[0], r1[0], r0[1], r1[1]}; OUT = __builtin_bit_cast(bf16x8, w); } while (0)
    PK4(p, 0, pa0); PK4(p, 8, pa1);
#undef PK4
#define PVS(S, D0) do { \
        o[D0] = __builtin_amdgcn_mfma_f32_32x32x16_bf16(pa0, ((bf16x8){vl[S][0][0], vl[S][0][1], vl[S][0][2], vl[S][0][3], vh[S][0][0], vh[S][0][1], vh[S][0][2], vh[S][0][3]}), o[D0], 0, 0, 0); \
        o[D0] = __builtin_amdgcn_mfma_f32_32x32x16_bf16(pa1, ((bf16x8){vl[S][1][0], vl[S][1][1], vl[S][1][2], vl[S][1][3], vh[S][1][0], vh[S][1][1], vh[S][1][2], vh[S][1][3]}), o[D0], 0, 0, 0); } while (0)
    asm volatile("s_waitcnt lgkmcnt(0)" ::: "memory"); SBAR();
    PVS(0, 0); PVS(1, 1);
    SBAR();
    TRD(0, 2); TRD(1, 3);
    asm volatile("s_waitcnt lgkmcnt(0)" ::: "memory"); SBAR();
    PVS(0, 2); PVS(1, 3);
#undef PVS
#undef TRD
    SBAR();
}
template <int OFF> __device__ __forceinline__ bf16x8 lds_rd16(int a) { bf16x8 r; asm volatile("ds_read_b128 %0, %1 offset:%2" : "=&v"(r) : "v"(a), "i"(OFF) : "memory"); return r; }
template <int N> __device__ __forceinline__ void lds_wait2(bf16x8& a, bf16x8& b) { asm volatile("s_waitcnt lgkmcnt(%2)" : "+v"(a), "+v"(b) : "n"(N) : "memory"); }
__device__ __forceinline__ void tile_qk(float& l_reg, bf16x8& pa0, bf16x8& pa1, bf16x8& pa2, bf16x8& pa3, const LAS unsigned char* Ks, const bf16x8* qr, const LAS float* tab, bool far_, float cfar, int base, int r32, int hi) {
    f32x16 p0, p1;
#pragma unroll
    for (int r = 0; r < 16; ++r) { p0[r] = 0.f; p1[r] = 0.f; }
    int kb_[4];
#pragma unroll
    for (int m = 0; m < 4; ++m) kb_[m] = 256 * r32 + ((((2 * m + hi) ^ (r32 & 7))) << 4);
    const int kA = (int)(unsigned)(size_t)Ks;
    int ka[8];
#pragma unroll
    for (int m = 0; m < 4; ++m) { ka[m] = kA + kb_[m] + ((r32 & 8) << 4); ka[4 + m] = ka[m] ^ 128; }
    bf16x8 kf[8][2];
#define KRD(D) do { kf[D][0] = lds_rd16<0>(ka[D]); kf[D][1] = lds_rd16<8192>(ka[D]); } while (0)
#define KMM(D, N) do { lds_wait2<N>(kf[D][0], kf[D][1]); p0 = __builtin_amdgcn_mfma_f32_32x32x16_bf16(kf[D][0], qr[D], p0, 0, 0, 0); p1 = __builtin_amdgcn_mfma_f32_32x32x16_bf16(kf[D][1], qr[D], p1, 0, 0, 0); } while (0)
    asm volatile("s_waitcnt lgkmcnt(0)" ::: "memory");
    KRD(0); KRD(1);
    KRD(2); KMM(0, 4); KRD(3); KMM(1, 4); KRD(4); KMM(2, 4); KRD(5); KMM(3, 4); KRD(6); KMM(4, 4); KRD(7); KMM(5, 4); KMM(6, 2); KMM(7, 0);
#undef KRD
#undef KMM
    SBAR();
    float ps0 = 0.f, ps1 = 0.f;
    if (far_) {
#pragma unroll
        for (int r = 0; r < 16; ++r) { p0[r] = __builtin_amdgcn_exp2f(p0[r] + cfar); p1[r] = __builtin_amdgcn_exp2f(p1[r] + cfar); ps0 += p0[r]; ps1 += p1[r]; }
    } else {
#pragma unroll
        for (int r = 0; r < 16; ++r) { const int kk = crow(r, hi); const int i0 = min(base - kk, 256), i1 = min(base - 32 - kk, 256);
            p0[r] = __builtin_amdgcn_exp2f(p0[r] + tab[i0]); p1[r] = __builtin_amdgcn_exp2f(p1[r] + tab[i1]); ps0 += p0[r]; ps1 += p1[r]; }
    }
    l_reg += ps0 + ps1;
    pack_p(p0, p1, pa0, pa1, pa2, pa3);
    SBAR();
}
__device__ __forceinline__ void tile_pv(f32x16 (&o)[4], int vb, bf16x8 pa0, bf16x8 pa1, bf16x8 pa2, bf16x8 pa3) {
    s16x4 vla[4], vha[4], vlb[4], vhb[4];
#define TRD(VL, VH, D0) VL[0] = tr_read<v_rd_off(D0, 0, 0)>(vb); VH[0] = tr_read<v_rd_off(D0, 0, 1)>(vb); VL[1] = tr_read<v_rd_off(D0, 1, 0)>(vb); VH[1] = tr_read<v_rd_off(D0, 1, 1)>(vb); \
                VL[2] = tr_read<v_rd_off(D0, 2, 0)>(vb); VH[2] = tr_read<v_rd_off(D0, 2, 1)>(vb); VL[3] = tr_read<v_rd_off(D0, 3, 0)>(vb); VH[3] = tr_read<v_rd_off(D0, 3, 1)>(vb)
#define PVD(VL, VH, D0) do { \
        o[D0] = __builtin_amdgcn_mfma_f32_32x32x16_bf16(pa0, ((bf16x8){VL[0][0], VL[0][1], VL[0][2], VL[0][3], VH[0][0], VH[0][1], VH[0][2], VH[0][3]}), o[D0], 0, 0, 0); \
        o[D0] = __builtin_amdgcn_mfma_f32_32x32x16_bf16(pa1, ((bf16x8){VL[1][0], VL[1][1], VL[1][2], VL[1][3], VH[1][0], VH[1][1], VH[1][2], VH[1][3]}), o[D0], 0, 0, 0); \
        o[D0] = __builtin_amdgcn_mfma_f32_32x32x16_bf16(pa2, ((bf16x8){VL[2][0], VL[2][1], VL[2][2], VL[2][3], VH[2][0], VH[2][1], VH[2][2], VH[2][3]}), o[D0], 0, 0, 0); \
        o[D0] = __builtin_amdgcn_mfma_f32_32x32x16_bf16(pa3, ((bf16x8){VL[3][0], VL[3][1], VL[3][2], VL[3][3], VH[3][0], VH[3][1], VH[3][2], VH[3][3]}), o[D0], 0, 0, 0); } while (0)
    asm volatile("s_waitcnt lgkmcnt(0)" ::: "memory");
    TRD(vla, vha, 0); TRD(vlb, vhb, 1); asm volatile("s_waitcnt lgkmcnt(8)" ::: "memory"); SBAR();
    PVD(vla, vha, 0); SBAR(); TRD(vla, vha, 2); asm volatile("s_waitcnt lgkmcnt(8)" ::: "memory"); SBAR();
    PVD(vlb, vhb, 1); SBAR(); TRD(vlb, vhb, 3); asm volatile("s_waitcnt lgkmcnt(8)" ::: "memory"); SBAR();
    PVD(vla, vha, 2); SBAR(); asm volatile("s_waitcnt lgkmcnt(0)" ::: "memory"); SBAR();
    PVD(vlb, vhb, 3);
#undef PVD
#undef TRD
    SBAR();
}
constexpr int PF_DUMP_OFF = 131072;
__device__ __forceinline__ void prompt_unit(const Frame& F, const Ctx& c, int h, int cq, const float* pfk, const float* pfv, int pfb0, int pfh0, int pfb1, int pfh1, int pft0, int pfn) {
    const LAS unsigned char* ldr = F.lds; LAS unsigned char* ldw = F.lds;
    int pz_; asm volatile("v_mov_b32 %0, 0" : "=v"(pz_));
    const int tid = F.tid + pz_, wid = F.wave, lane = F.lane + pz_, pw = wid >> 1;
    const LAS float* tab = (const LAS float*)(ldr + TAB_OFF + h * TAB_STRIDE);
    unsigned long long atst = 0; (void)atst; ATS(0); ATS(7);
    f32x16 o[4]; float l_reg = 0.f; bf16x8 qr[8];
#pragma unroll
    for (int d = 0; d < 4; ++d)
#pragma unroll
        for (int r = 0; r < 16; ++r) o[d][r] = 0.f;
    {
        const unsigned short* Qw = c.ZQ + (size_t)(cq * 256 + wid * 32 + (lane & 31)) * 4096 + 2048 + h * HD + (lane >> 5) * 8;
#pragma unroll
        for (int d0 = 0; d0 < 8; ++d0) qr[d0] = *(const bf16x8*)(Qw + d0 * 16);
#pragma unroll
        for (int d0 = 0; d0 < 8; ++d0) asm volatile("" : "+v"(qr[d0]));
    }
    asm volatile("s_waitcnt vmcnt(0)" ::: "memory");
    ATE(0);
    const int jstart = cq < 2 ? 8 - 4 * cq : 0;
    const unsigned short* Kh = c.Kb + h * HD; const unsigned short* Vh = c.Vb + h * HD;
#define DMA_TILE(j) do { const size_t t0 = (size_t)((4 * ((c.abl & 8) ? 2 : cq) - 8 + (j)) * 64) * 2048; const int sl = ((j) & 3) * 32768; \
    int dz_; asm volatile("v_mov_b32 %0, 0" : "=v"(dz_)); const int ld_ = lane + dz_; \
    _Pragma("unroll") for (int i = 0; i < 2; ++i) { const int pc = 2 * wid + i; \
        const int r = 4 * pc + (ld_ >> 4), chp = ld_ & 15; const unsigned ksrc = (unsigned)(r * 2048 + ((chp ^ (r & 15)) << 3)); \
        const int st = 2 * pc + (ld_ >> 5), kk = 8 * (st >> 2) + ((ld_ & 31) >> 2), k = (kk & ~0xC) | ((kk & 4) << 1) | ((kk & 8) >> 1), cc = 32 * (st & 3) + 8 * (ld_ & 3); \
        const unsigned vsrc = (unsigned)(k * 2048 + cc); \
        __builtin_amdgcn_global_load_lds((const unsigned*)(Kh + t0 + ksrc), (LAS unsigned*)(ldw + sl + pc * 1024), 16, 0, 0); \
        __builtin_amdgcn_global_load_lds((const unsigned*)(Vh + t0 + vsrc), (LAS unsigned*)(ldw + sl + 16384 + pc * 1024), 16, 0, 0); } } while (0)
    DMA_TILE(jstart); DMA_TILE(jstart + 1);
    bf16x8 pa0, pa1, pa2, pa3; bool pend = false; int vbp = 0; bool pfprev = false;
    const bool lag = wid >= 4;
#pragma unroll 1
    for (int j = jstart; j < 12; ++j) {
        ATS(1);
        if (j == 11) asm volatile("s_waitcnt vmcnt(0)" ::: "memory"); else if (pfprev) asm volatile("s_waitcnt vmcnt(5)" ::: "memory"); else asm volatile("s_waitcnt vmcnt(4)" ::: "memory");
        __builtin_amdgcn_s_barrier(); asm volatile("" ::: "memory");
        ATE(1); ATS(2);
        pfprev = false;
        if (j + 2 < 12) {
            const int tt = j - jstart;
            if (tt < pfn) {
                const int t = pft0 + tt, un = t >> 3, rg = (t & 7) >> 1, kv = t & 1;
                int pz2_; asm volatile("v_mov_b32 %0, 0" : "=v"(pz2_)); const int lp = lane + pz2_;
                const int pb = un ? pfb1 : pfb0, phd = un ? pfh1 : pfh0;
                const size_t off = (((size_t)pb * 512 + wid * 64 + 16 * rg + (lp >> 2)) * NHA + phd) * HD + (lp & 3) * 32;
                const float* pbase = pfk; if (kv) pbase = pfv;
                __builtin_amdgcn_global_load_lds((const unsigned*)(pbase + off), (LAS unsigned*)(ldw + PF_DUMP_OFF + wid * 256), 4, 0, 0);
                pfprev = true;
            }
            DMA_TILE(j + 2);
        }
        ATE(2);
        if (lag && pend) { if (!(c.abl & 1)) tile_pv(o, vbp, pa0, pa1, pa2, pa3); pend = false; }
        const int dl = pw + 8 - j;
        if (dl >= 0 && dl <= 8 && !(c.abl & 4)) {
            int lz_; asm volatile("v_mov_b32 %0, 0" : "=v"(lz_)); const int lz = lane + lz_, r32z = lz & 31, hiz = lz >> 5;
            const int sl = (j & 3) * 32768;
            const int vb = (int)(unsigned)(size_t)(F.lds) + sl + 16384 + v_rd_base(lz); const int base = 128 + 64 * dl + 32 * (wid & 1) + r32z;
            const float cfar = tab[256];
            ATS(3);
            if (!(c.abl & 2)) tile_qk(l_reg, pa0, pa1, pa2, pa3, ldr + sl, qr, tab, dl >= 3, cfar, base, r32z, hiz);
            ATE(3); ATS(4);
            if (lag) { pend = true; vbp = vb; } else if (!(c.abl & 1)) tile_pv(o, vb, pa0, pa1, pa2, pa3);
            ATE(4);
        }
    }
    if (lag && pend && !(c.abl & 1)) tile_pv(o, vbp, pa0, pa1, pa2, pa3);
#undef DMA_TILE
    ATS(5);
    const size_t rowbase = (size_t)(cq * 256 + wid * 32); const int rr0 = lane >> 4, cg = (lane & 15) * 8;
    u32x4 gv[8];
#pragma unroll
    for (int i = 0; i < 8; ++i) gv[i] = *(const u32x4*)(c.Gb + (rowbase + rr0 + 4 * i) * 2048 + h * HD + cg);
    __builtin_amdgcn_s_barrier(); asm volatile("" ::: "memory");
    ATE(5); ATS(6);
    const int r32 = lane & 31, hi = lane >> 5;
    { auto rr = __builtin_amdgcn_permlane32_swap(__float_as_uint(l_reg), __float_as_uint(l_reg), false, false); l_reg = __uint_as_float(rr[0]) + __uint_as_float(rr[1]); }
    LAS float* li = (LAS float*)(ldw + LI_OFF) + wid * 32;
    if (hi == 0) li[r32] = l_reg;
    asm volatile("s_waitcnt lgkmcnt(0)" ::: "memory");
    LAS float* po = (LAS float*)(ldw + wid * 16384);
#pragma unroll
    for (int r = 0; r < 16; ++r) { const int orow = crow(r, hi); const float rl = __builtin_amdgcn_rcpf(li[orow]);
#pragma unroll
        for (int d0 = 0; d0 < 4; ++d0) po[orow * 128 + d0 * 32 + r32] = o[d0][r] * rl; }
    asm volatile("s_waitcnt lgkmcnt(0)" ::: "memory");
    {
        typedef float fv4_ __attribute__((ext_vector_type(4)));
#pragma unroll
        for (int i = 0; i < 8; ++i) { const int row = rr0 + 4 * i;
            const fv4_ x = *(const LAS fv4_*)(po + row * 128 + cg), y = *(const LAS fv4_*)(po + row * 128 + cg + 4);
            u32x4 ov; ov.x = cvtpk(x[0] * __uint_as_float(gv[i].x << 16), x[1] * __uint_as_float(gv[i].x & 0xffff0000u)); ov.y = cvtpk(x[2] * __uint_as_float(gv[i].y << 16), x[3] * __uint_as_float(gv[i].y & 0xffff0000u));
            ov.z = cvtpk(y[0] * __uint_as_float(gv[i].z << 16), y[1] * __uint_as_float(gv[i].z & 0xffff0000u)); ov.w = cvtpk(y[2] * __uint_as_float(gv[i].w << 16), y[3] * __uint_as_float(gv[i].w & 0xffff0000u));
            *(u32x4*)(c.O + (rowbase + row) * 4096 + 2048 + h * HD + cg) = ov; }
    }
    ATE(6); ATE(7);
    asm volatile("s_waitcnt lgkmcnt(0)" ::: "memory"); __builtin_amdgcn_s_barrier(); asm volatile("" ::: "memory");
}
typedef float fv4 __attribute__((ext_vector_type(4)));
struct SCtx { unsigned short* ZQ; unsigned short* O; const unsigned short* Kb; const unsigned short* Vb; const unsigned short* Gb; const float* cache_k; const float* cache_v; };
__device__ __forceinline__ bf16x8 cvt8(const fv4 a, const fv4 b) { u32x4 w = {cvtpk(a.x, a.y), cvtpk(a.z, a.w), cvtpk(b.x, b.y), cvtpk(b.z, b.w)}; return __builtin_bit_cast(bf16x8, w); }
__device__ __forceinline__ void sample_unit(const Frame& F, const SCtx& c, int b, int h) {
    const LAS unsigned char* ldr = F.lds; LAS unsigned char* ldw = F.lds;
    int lz_; asm volatile("v_mov_b32 %0, 0" : "=v"(lz_));
    const int tid = F.tid, wid = F.wave, lane = F.lane + lz_, r32 = lane & 31, hi = lane >> 5, srow = lane >> 4, sch = lane & 15;
    const LAS float* tab = (const LAS float*)(ldr + TAB_OFF + h * TAB_STRIDE);
    const int kreg = wid * WREG, vreg = wid * WREG + 8704;
    const int vb = (int)(unsigned)(size_t)(F.lds + vreg) + v_rd_base(lane);
    f32x16 o[4]; float l_reg = 0.f; bf16x8 qr[8];
    fv4 ka[8][2], va[8][2];
#define LDG(DST, SRC, KB) do { const float* p_ = (SRC) + (((size_t)b * 512 + (KB) * 32 + srow) * NHA + h) * HD + sch * 8; \
        _Pragma("unroll") for (int k = 0; k < 8; ++k) { const size_t ro = (size_t)(4 * k) * (NHA * HD); DST[k][0] = *(const fv4*)(p_ + ro); DST[k][1] = *(const fv4*)(p_ + ro + 4); } } while (0)
#define STK() do { _Pragma("unroll") for (int k = 0; k < 8; ++k) *(LAS bf16x8*)(ldw + kreg + KSWZ(4 * k + srow, sch * 16)) = cvt8(ka[k][0], ka[k][1]); } while (0)
#define STV() do { _Pragma("unroll") for (int k = 0; k < 8; ++k) *(LAS bf16x8*)(ldw + vreg + v_st(4 * k + srow, sch * 8)) = cvt8(va[k][0], va[k][1]); } while (0)
#define PK4(P, BASE, OUT) do { unsigned a0 = cvtpk(P[BASE + 0], P[BASE + 1]), a1 = cvtpk(P[BASE + 2], P[BASE + 3]);   \
    unsigned b0 = cvtpk(P[BASE + 4], P[BASE + 5]), b1 = cvtpk(P[BASE + 6], P[BASE + 7]);                              \
    auto r0 = __builtin_amdgcn_permlane32_swap(a0, b0, false, false); auto r1 = __builtin_amdgcn_permlane32_swap(a1, b1, false, false); \
    u32x4 w = {r0[0], r1[0], r0[1], r1[1]}; OUT = __builtin_bit_cast(bf16x8, w); } while (0)
    bf16x8 pa0, pa1;
#define QKS(KB) do { asm volatile("s_waitcnt lgkmcnt(0)" ::: "memory"); f32x16 p0; \
        _Pragma("unroll") for (int r = 0; r < 16; ++r) p0[r] = 0.f; \
        _Pragma("unroll") for (int d0 = 0; d0 < 8; ++d0) { const bf16x8 kf = *(const LAS bf16x8*)(ldr + kreg + KSWZ(r32, (d0 * 16 + hi * 8) * 2)); p0 = __builtin_amdgcn_mfma_f32_32x32x16_bf16(kf, qr[d0], p0, 0, 0, 0); } \
        const int base = r32 + 640 - 32 * (KB);                         \
        float ps = 0.f; \
        _Pragma("unroll") for (int r = 0; r < 16; ++r) { const int i0 = min(base - crow(r, hi), 256); p0[r] = __builtin_amdgcn_exp2f(p0[r] + tab[i0]); ps += p0[r]; } \
        l_reg += ps; PK4(p0, 0, pa0); PK4(p0, 8, pa1); } while (0)
#define PVH(D0, CIN) do { const s16x4 l0 = tr_read<v_rd_off(D0, 0, 0)>(vb), h0 = tr_read<v_rd_off(D0, 0, 1)>(vb), l1 = tr_read<v_rd_off(D0, 1, 0)>(vb), h1 = tr_read<v_rd_off(D0, 1, 1)>(vb); \
    asm volatile("s_waitcnt lgkmcnt(0)" ::: "memory"); SBAR(); \
    o[D0] = __builtin_amdgcn_mfma_f32_32x32x16_bf16(pa0, ((bf16x8){l0[0], l0[1], l0[2], l0[3], h0[0], h0[1], h0[2], h0[3]}), CIN, 0, 0, 0); \
    o[D0] = __builtin_amdgcn_mfma_f32_32x32x16_bf16(pa1, ((bf16x8){l1[0], l1[1], l1[2], l1[3], h1[0], h1[1], h1[2], h1[3]}), o[D0], 0, 0, 0); } while (0)
#define PVS() do { asm volatile("s_waitcnt lgkmcnt(0)" ::: "memory"); PVH(0, o[0]); PVH(1, o[1]); PVH(2, o[2]); PVH(3, o[3]); SBAR(); } while (0)
#define PVS0() do { const f32x16 z16 = {0.f, 0.f, 0.f, 0.f, 0.f, 0.f, 0.f, 0.f, 0.f, 0.f, 0.f, 0.f, 0.f, 0.f, 0.f, 0.f}; asm volatile("s_waitcnt lgkmcnt(0)" ::: "memory"); PVH(0, z16); PVH(1, z16); PVH(2, z16); PVH(3, z16); SBAR(); } while (0)
#define LDQ() do { const unsigned short* Qw = c.ZQ + (size_t)(TP + b * 32 + r32) * 4096 + 2048 + h * HD + hi * 8; _Pragma("unroll") for (int d0 = 0; d0 < 8; ++d0) qr[d0] = *(const bf16x8*)(Qw + d0 * 16); } while (0)
    LDG(ka, c.cache_k, 2 * wid); LDG(va, c.cache_v, 2 * wid); LDQ();
    STK(); SBAR(); LDG(ka, c.cache_k, 2 * wid + 1); SBAR();
    QKS(2 * wid); SBAR();
    STV(); SBAR();
    PVS0();
    LDG(va, c.cache_v, 2 * wid + 1); SBAR();
    STK(); SBAR();
    LDQ(); SBAR();
    QKS(2 * wid + 1); SBAR();
    STV(); SBAR();
    PVS();
    if (wid == 0) {
        const unsigned short* kp = c.Kb + (size_t)(TP + b * 32 + srow) * 2048 + h * HD + sch * 8;
        const unsigned short* vp = c.Vb + (size_t)(TP + b * 32 + srow) * 2048 + h * HD + sch * 8;
        bf16x8 kn[8], vn[8];
#pragma unroll
        for (int k = 0; k < 8; ++k) kn[k] = *(const bf16x8*)(kp + (size_t)(4 * k) * 2048);
#pragma unroll
        for (int k = 0; k < 8; ++k) vn[k] = *(const bf16x8*)(vp + (size_t)(4 * k) * 2048);
#pragma unroll
        for (int k = 0; k < 8; ++k) *(LAS bf16x8*)(ldw + kreg + KSWZ(4 * k + srow, sch * 16)) = kn[k];
        SBAR();
        QKS(16); SBAR();
#pragma unroll
        for (int k = 0; k < 8; ++k) *(LAS bf16x8*)(ldw + vreg + v_st(4 * k + srow, sch * 8)) = vn[k];
        SBAR();
        PVS();
    }
#undef LDG
#undef LDQ
#undef STK
#undef STV
#undef PK4
#undef QKS
#undef PVH
#undef PVS
#undef PVS0
    { auto rr = __builtin_amdgcn_permlane32_swap(__float_as_uint(l_reg), __float_as_uint(l_reg), false, false); l_reg = __uint_as_float(rr[0]) + __uint_as_float(rr[1]); }
    LAS float* po = (LAS float*)(ldw + wid * WREG);
#pragma unroll
    for (int d0 = 0; d0 < 4; ++d0)
#pragma unroll
        for (int r = 0; r < 16; ++r) po[crow(r, hi) * 128 + d0 * 32 + r32] = o[d0][r];
    LAS float* li = (LAS float*)(ldw + LI_OFF);
    if (hi == 0) li[wid * 32 + r32] = l_reg;
    __syncthreads();
    {
        int tz_; asm volatile("v_mov_b32 %0, 0" : "=v"(tz_)); const int tz = tid + tz_, q = tz >> 4, dg = (tz & 15) * 8;
        const size_t row = (size_t)(TP + b * 32 + q);
        const u32x4 gv = *(const u32x4*)(c.Gb + row * 2048 + h * HD + dg);
        float acc[8] = {0.f, 0.f, 0.f, 0.f, 0.f, 0.f, 0.f, 0.f}; float l = 0.f;
#pragma unroll
        for (int w = 0; w < 8; ++w) { const LAS fv4* pp = (const LAS fv4*)(ldr + w * WREG + (q * 128 + dg) * 4); const fv4 x = pp[0], y = pp[1];
            acc[0] += x.x; acc[1] += x.y; acc[2] += x.z; acc[3] += x.w; acc[4] += y.x; acc[5] += y.y; acc[6] += y.z; acc[7] += y.w; l += li[w * 32 + q]; }
        const float rl = __builtin_amdgcn_rcpf(l);
        const unsigned gw[4] = {gv.x, gv.y, gv.z, gv.w}; u32x4 ov; unsigned ow[4];
#pragma unroll
        for (int e = 0; e < 4; ++e) ow[e] = cvtpk(acc[2 * e] * rl * __uint_as_float(gw[e] << 16), acc[2 * e + 1] * rl * __uint_as_float(gw[e] & 0xffff0000u));
        ov.x = ow[0]; ov.y = ow[1]; ov.z = ow[2]; ov.w = ow[3];
        *(u32x4*)(c.O + row * 4096 + 2048 + h * HD + dg) = ov;
    }
    __syncthreads();
}
#undef KSWZ
#undef SBAR
}
struct Args { const float* in[18]; float* out; unsigned char* ws; };
__global__ void __launch_bounds__(NWAVES * 64, 2) hyb_fwd(Args args) {
    extern __shared__ __attribute__((aligned(16))) unsigned char lds[];
    Frame F;
    F.lds = (LAS unsigned char*)lds; F.MISC = (volatile LAS unsigned*)(F.lds + MISC_OFF);
    F.tid = threadIdx.x; F.lane = F.tid & 63; F.wave = __builtin_amdgcn_readfirstlane(F.tid >> 6);
    F.G = gridDim.x; { const int bx = blockIdx.x; F.vcu = (F.G % 8 == 0) ? (bx % 8) * (F.G / 8) + bx / 8 : bx; }
    F.ctl = (gu32*)(args.ws + WS_CTL);
    for (int u = F.tid; u < (LDS_BYTES - LDSCTL_OFF) / 4; u += NWAVES * 64) ((LAS unsigned*)(F.lds + LDSCTL_OFF))[u] = 0u;
    __syncthreads();
    XcdBarrier bar = xcd_barrier_post((unsigned*)(F.ctl + CW_BAR), F.MISC + 8);
    unsigned char* ws = args.ws;
#define OPQ() Frame Fp = F; { Fp.lane = lane_now(); Fp.tid = F.wave * 64 + Fp.lane; }
#define RUN_W() do { OPQ(); p0a_weights(Fp, args.in[7], args.in[17], args.in[6], (bf16*)(ws + WS_WIN), (bf16*)(ws + WS_WDT), (bf16*)(ws + WS_WOUT)); } while (0)
#define RUN_X() do { OPQ(); p0x_rows(Fp, args.in[0], args.in[1], args.in[7], args.in[6], args.in[10], (bf16*)(ws + WS_H), (float*)(ws + WS_RSTD), (float*)(ws + WS_DT)); } while (0)
#define RUN_INPROJ() do { OPQ(); pg8::Gemm g{(const bf16*)(ws + WS_H), (const bf16*)(ws + WS_WIN), MTOK, NIN, DM, DM}; pg8::StaticOrder S; S.init(MTOK, NIN, F.G, (int)blockIdx.x); \
        pg8::EpiIn E{(const float*)(ws + WS_RSTD), (bf16*)(ws + WS_ZQ), (bf16*)args.out, (bf16*)(ws + WS_K), (bf16*)(ws + WS_V), (bf16*)(ws + WS_G), args.in[14], args.in[15], args.out, (PG8_LAS float*)(F.lds + EPI_P_OFF)}; \
        pg8::gemm_phase<pg8::EpiIn, pg8::StaticOrder, true, true>(F.lds + RING_OFF, g, S, E, Fp.tid); } while (0)
#define SSD_CTX() ssd::Ctx sc{(const unsigned short*)args.out, (const float*)(ws + WS_DT), (bf16*)(ws + WS_ZQ), args.in[8], args.in[9], args.in[11], args.in[12], args.in[13], args.in[2], SSD_YO, ws + WS_WIN}; \
        float* seg = (float*)(ws + WS_SEG); float* segdec = (float*)(ws + WS_SEGDEC); (void)seg; (void)segdec
#define SSD_YO (bf16*)(ws + WS_ZQ)
#define ATT_O (bf16*)(ws + WS_ZQ)
#define DRY_O ((bf16*)args.out - 2048)
#define RUN_SSD1() do { OPQ(); SSD_CTX(); for (int u = blockIdx.x; u < 256; u += F.G) ssd::pass1_unit(Fp, sc, u, seg, segdec); } while (0)
#define RUN_COMB() do { OPQ(); SSD_CTX(); if (blockIdx.x < 128 || F.G != 256) ssd::combine(Fp, seg, segdec); \
        if (F.G == 256) { if (blockIdx.x >= 128) ssd::pass2_unit(Fp, sc, 128 + blockIdx.x, seg, args.in[3], args.out); } \
        else { for (int u = 256 + blockIdx.x; u < 384; u += F.G) ssd::pass2_unit(Fp, sc, u, seg, args.in[3], args.out); } } while (0)
#define RUN_SSD2() do { OPQ(); SSD_CTX(); for (int u = blockIdx.x; u < 256; u += F.G) ssd::pass2_unit(Fp, sc, u, seg, args.in[3], args.out); } while (0)
#ifndef SDUP
#define SDUP 1
#endif
#ifndef SDUPHOT
#define SDUPHOT 0
#endif
#ifndef SPF
#define SPF 0
#endif
#ifndef SPOSN
#define SPOSN 5
#endif
#define RUN_ATT() do { OPQ(); att::Ctx ac{0, (bf16*)(ws + WS_ZQ), ATT_O, (const bf16*)(ws + WS_K), (const bf16*)(ws + WS_V), (const bf16*)(ws + WS_G), args.in[16], args.in[14], args.in[15]}; att::load_bias_tabs(Fp, ac); \
        att::SCtx sx{(bf16*)(ws + WS_ZQ), ATT_O, (const bf16*)(ws + WS_K), (const bf16*)(ws + WS_V), (const bf16*)(ws + WS_G), args.in[4], args.in[5]}; att::SCtx sxd = sx; sxd.O = DRY_O; (void)sxd; \
        const int np_ = (1024 - F.vcu + F.G - 1) / F.G, pos_ = SPF ? 1 + (int)((blockIdx.x >> 3) % 4) * (np_ - 1) / 3 : (int)((blockIdx.x >> 3) % SPOSN) * np_ / (SPOSN - 1);     \
        _Pragma("unroll 1") for (int i = 0; i <= np_; ++i) { \
            if (i == pos_) { _Pragma("unroll 1") for (int u = blockIdx.x; u < 512 * SDUP; u += F.G) { const bool dry_ = SDUP > 1 && u < 512 * (SDUP - 1); const int b = (SDUPHOT && dry_) ? 0 : (u & 511) >> 4, h = u & 15; att::sample_unit(Fp, dry_ ? sxd : sx, b, h); } } \
            if (i < np_) { const int u = F.vcu + i * F.G; const int h = u >> 6, cq = u & 63; \
                const int us0 = (int)blockIdx.x, us1 = us0 + F.G < 512 ? us0 + F.G : us0; \
                const int pft0 = (pos_ - 1 - i) * 10, pfn = (SPF && i < pos_ && us0 < 512 && pft0 < 16) ? (16 - pft0 < 10 ? 16 - pft0 : 10) : 0; \
                att::prompt_unit(Fp, ac, h, cq, args.in[4], args.in[5], us0 >> 4, us0 & 15, us1 >> 4, us1 & 15, pft0, pfn); } } } while (0)
#define RUN_OUT() do { OPQ(); pg8::Gemm g{(const bf16*)(ws + WS_ZQ), (const bf16*)(ws + WS_WOUT), MTOK, DM, 4096, 4096}; pg8::StaticOrder S; S.init(MTOK, DM, F.G, (int)blockIdx.x, F.G == 256 ? 512 : -1); \
        pg8::EpiOut E{args.in[0], args.in[1], args.out}; \
        pg8::gemm_phase<pg8::EpiOut, pg8::StaticOrder, true, true>(F.lds + RING_OFF, g, S, E, Fp.tid); \
        if (F.G == 256) { const int t = blockIdx.x >> 3, ks = blockIdx.x & 7; pg8::OneUnit S1; S.map(512 + t, S1.u); \
            pg8::Gemm g1{(const bf16*)(ws + WS_ZQ) + ks * 512, (const bf16*)(ws + WS_WOUT) + ks * 512, MTOK, DM, 512, 4096}; \
            pg8::EpiSlab E1{(float*)(ws + WS_H) + (size_t)blockIdx.x * 65536}; \
            pg8::gemm_phase<pg8::EpiSlab, pg8::OneUnit, true, true>(F.lds + RING_OFF, g1, S1, E1, Fp.tid); } } while (0)
#define RUN_OUTRED() do { OPQ(); if (F.G == 256) { pg8::StaticOrder S; S.init(MTOK, DM, F.G, 0); pg8::Unit u; const int t = blockIdx.x >> 3, part = blockIdx.x & 7; S.map(512 + t, u); \
        const float* slab = (const float*)(ws + WS_H) + (size_t)(t * 8) * 65536; const int r0 = u.pm * 256 + part * 32; \
        typedef float f4_ __attribute__((ext_vector_type(4))); \
        f4_ a[4]; \
        _Pragma("unroll") for (int i = 0; i < 4; ++i) { const int e = Fp.tid + 512 * i, rr = e >> 6, c4 = (e & 63) * 4, row = r0 + rr, col = u.pn * 256 + c4; \
            a[i] = row < TP ? *(const f4_*)(args.in[0] + (size_t)row * DM + col) : *(const f4_*)(args.in[1] + (size_t)(row - TP) * DM + col); } \
        _Pragma("unroll") for (int s = 0; s < 8; ++s) { f4_ v[4]; \
            _Pragma("unroll") for (int i = 0; i < 4; ++i) { const int e = Fp.tid + 512 * i, rr = e >> 6, c4 = (e & 63) * 4; v[i] = *(const f4_*)(slab + (size_t)s * 65536 + (part * 32 + rr) * 256 + c4); } \
            _Pragma("unroll") for (int i = 0; i < 4; ++i) a[i] += v[i]; } \
        _Pragma("unroll") for (int i = 0; i < 4; ++i) { const int e = Fp.tid + 512 * i, rr = e >> 6, c4 = (e & 63) * 4, row = r0 + rr, col = u.pn * 256 + c4; *(f4_*)(args.out + (size_t)row * DM + col) = a[i]; } } } while (0)
#define BAR() xcd_barrier(bar)
#ifndef PHASE_PROGRAM
#define PHASE_PROGRAM RUN_W(); RUN_X(); BAR(); RUN_INPROJ(); BAR(); RUN_SSD1(); BAR(); RUN_COMB(); BAR(); RUN_SSD2(); RUN_ATT(); BAR(); RUN_OUT(); BAR(); RUN_OUTRED();
#endif
    PHASE_PROGRAM
}
extern "C" void kernel_launch(void* const* d_in, const int* in_sizes, int n_in, void* d_out, int out_size, void* d_ws, size_t ws_size, hipStream_t stream) {
    static int grid = 0;
    if (grid == 0) {
        if (n_in != 18 || in_sizes[0] != TP * DM || (size_t)out_size != O_END || ws_size < WS_END) { fprintf(stderr, "kernel_launch: shape mismatch n_in %d in0 %d out %d ws %zu (need %zu)\n", n_in, n_in > 0 ? in_sizes[0] : -1, out_size, ws_size, (size_t)WS_END); grid = -1; return; }
        int dev = 0, cus = 0;
        if (hipGetDevice(&dev) != hipSuccess || hipDeviceGetAttribute(&cus, hipDeviceAttributeMultiprocessorCount, dev) != hipSuccess) { grid = -1; return; }
        if (hipFuncSetAttribute((const void*)hyb_fwd, hipFuncAttributeMaxDynamicSharedMemorySize, LDS_BYTES) != hipSuccess) { fprintf(stderr, "kernel_launch: hipFuncSetAttribute failed\n"); grid = -1; return; }
        (void)hipGetLastError();
        grid = cus;
    }
    if (grid < 0) return;
    if (hipMemsetAsync((char*)d_ws + WS_CTL, 0, CTL_ZERO_BYTES, stream) != hipSuccess) return;
    Args a{};
    for (int i = 0; i < 18; ++i) a.in[i] = (const float*)d_in[i];
    a.out = (float*)d_out; a.ws = (unsigned char*)d_ws;
    hipLaunchKernelGGL(hyb_fwd, dim3(grid), dim3(NWAVES * 64), LDS_BYTES, stream, a);
}
```

```cpp
#include <hip/hip_runtime.h>
#include <cstdio>
#include <cstdint>
constexpr int TP = 16384, TS = 1024, MTOK = TP + TS;
constexpr int DM = 2048, DSSM = 2048, DATT = 2048, CONVD = 3072, NHS = 32, NHA = 16, HD = 128, PH = 64, NST = 128;
constexpr int NIN = 13312;
constexpr int SRC_LD = 13344;
constexpr float EPS = 1e-6f;
constexpr size_t O_YP = 0, O_YS = 33554432, O_PCONV = 35651584, O_PSSM = 35660800, O_PK = 35922944, O_PV = 36971520, O_SCONV = 38020096, O_SSSM = 38315008, O_SK = 46703616, O_SV = 48800768, O_END = 50897920;
constexpr size_t MiB = 1u << 20;
constexpr size_t WS_CTL = 0, CTL_ZERO_BYTES = 32 * 1024;
constexpr size_t WS_H = 1 * MiB;
constexpr size_t WS_WIN = WS_H + 68 * MiB;
constexpr size_t WS_WDT = WS_WIN + 52 * MiB;
constexpr size_t WS_WOUT = WS_WDT + 1 * MiB;
constexpr size_t WS_ZQ = WS_WOUT + 16 * MiB;
constexpr size_t WS_K = WS_ZQ + 136 * MiB;
constexpr size_t WS_V = WS_K + 68 * MiB;
constexpr size_t WS_G = WS_V + 68 * MiB;
constexpr size_t WS_DT = WS_G + 68 * MiB;
constexpr size_t WS_RSTD = WS_DT + 3 * MiB;
constexpr size_t WS_END = WS_RSTD + 1 * MiB;
constexpr size_t WS_SEG = WS_H;
constexpr size_t WS_SEGDEC = WS_RSTD + 512 * 1024;
constexpr int CW_TMO = 0, CW_CODE = 1, CW_BAR = 4096;
constexpr int RING_OFF = 0, RING_BYTES = 131072;
constexpr int LDSCTL_OFF = 157696, MISC_OFF = LDSCTL_OFF + 320;
constexpr int EPI_P_OFF = 131072;
constexpr int LDS_BYTES = 160 * 1024;
constexpr int NWAVES = 8;
namespace pg8 {
#define PG8_LAS __attribute__((address_space(3)))
typedef unsigned short bf16_t;
typedef short bf16x8 __attribute__((ext_vector_type(8)));
typedef float f32x4 __attribute__((ext_vector_type(4)));
typedef unsigned u32x4 __attribute__((ext_vector_type(4)));
constexpr int BM = 256, BK = 64, HALF = 128, HTB = HALF * BK * 2  , STAGE_BYTES = 8 * HTB, NXCD = 8, WGM = 8;

__host__ __device__ __forceinline__ int lds_byte(int r, int c) { const int st = (r >> 4) * 2 + (c >> 5), rr = r & 15, cc = c & 31, ob = rr * 64 + cc * 2; return st * 1024 + (ob ^ (((ob >> 9) & 1) << 5)); }
__host__ __device__ __forceinline__ void stage_rc(int b, int& R, int& C) { const int st = b / 1024, sb = b % 1024, swz = sb ^ (((sb >> 9) & 1) << 5); R = (st >> 1) * 16 + swz / 64; C = (st & 1) * 32 + (swz % 64) / 2; }
__host__ __device__ __forceinline__ int perm32(int rho) { const int n = rho >> 4, i = rho & 15; return 8 * (i >> 2) + 4 * n + (i & 3); }

struct Unit { int pm, pn; };
struct Gemm { const bf16_t* A; const bf16_t* Bt; int M, N, K, ld; };

struct StaticOrder {
    int nM, nN, nwg, G, c;
    __host__ __device__ __forceinline__ void init(int M, int N, int G_, int c_, int lim_ = -1) { nM = M / BM; nN = N / BM; nwg = nM * nN; G = G_; c = c_; lim = lim_ < 0 ? nwg : lim_; }
    int lim;
    __host__ __device__ __forceinline__ bool next(int i, Unit& u) const { const long L = (long)i * G + c; if (L >= lim) return false; map((int)L, u); return true; }
    __host__ __device__ __forceinline__ void map(int L, Unit& u) const {
        int wgid = L; { const int q = nwg / NXCD, r = nwg % NXCD, xcd = wgid % NXCD, off = wgid / NXCD; wgid = (xcd < r ? xcd * (q + 1) : r * (q + 1) + (xcd - r) * q) + off; }
        const int nig = WGM * nN, gid = wgid / nig, fm = gid * WGM, gsz = (nM - fm) < WGM ? (nM - fm) : WGM;
        u.pm = fm + ((wgid % nig) % gsz); u.pn = (wgid % nig) / gsz;
    }
    __device__ __forceinline__ void a_ready(const Unit&) const {}
    __device__ __forceinline__ void done(const Unit&) const {}
};

__device__ __forceinline__ unsigned cvt_pk_bf16(float lo, float hi) { unsigned r; asm volatile("v_cvt_pk_bf16_f32 %0, %1, %2" : "=v"(r) : "v"(lo), "v"(hi)); return r; }
template <class Epi, class Sched, bool ALIGN_EPI = false, bool SP2 = false>
__device__ __forceinline__ void gemm_phase(PG8_LAS unsigned char* lds, const Gemm g, const Sched& S, const Epi& E, const int tid) {
    const int wid = __builtin_amdgcn_readfirstlane(tid >> 6), lane = tid & 63, wr = wid >> 2, wc = wid & 3, fr = lane & 15, fq = lane >> 4;
    const int K = g.ld, nt = g.K / BK;
    unsigned voffA[2], voffB[2];
#pragma unroll
    for (int i = 0; i < 2; ++i) { int R, C; stage_rc(tid * 16 + i * 8192, R, C); const int Rb = Epi::PERM ? ((R & ~31) + perm32(R & 31)) : R;
        voffA[i] = (unsigned)(R * K + C) * 2u; voffB[i] = (unsigned)(Rb * K + C) * 2u; }
    const size_t kstep = (size_t)(BK * 2);
    const size_t hstep = (size_t)HALF * K * 2;
    const size_t tstep = 2 * hstep;
    const unsigned ldsw = (unsigned)wid * 1024u;
    const int aoff = lds_byte(wr * 64 + fr, fq * 8), boff = lds_byte(wc * 32 + fr, fq * 8);
#define PG8_SA(b, h) (((b) * 2 + (h)) * HTB)
#define PG8_SB(b, h) ((4 + (b) * 2 + (h)) * HTB)
#define PG8_STAGE(bufoff, gbase, voff) do { _Pragma("unroll") for (int _i = 0; _i < 2; ++_i) \
        __builtin_amdgcn_global_load_lds((const unsigned*)((const char*)(gbase) + (voff)[_i]), (PG8_LAS unsigned*)(lds + (bufoff) + ldsw + _i * 8192), 16, 0, 0); } while (0)
#define PG8_LDA(dst, b, h) do { _Pragma("unroll") for (int m = 0; m < 4; ++m) _Pragma("unroll") for (int k = 0; k < 2; ++k) dst[m][k] = *(const PG8_LAS bf16x8*)(lds + PG8_SA(b, h) + aoff + m * 2048 + k * 1024); } while (0)
#define PG8_LDB(dst, b, h) do { _Pragma("unroll") for (int n = 0; n < 2; ++n) _Pragma("unroll") for (int k = 0; k < 2; ++k) dst[n][k] = *(const PG8_LAS bf16x8*)(lds + PG8_SB(b, h) + boff + n * 2048 + k * 1024); } while (0)
#define PG8_MMA(ai, bj, At, Bt) do { __builtin_amdgcn_s_setprio(1); _Pragma("unroll") for (int m = 0; m < 4; ++m) _Pragma("unroll") for (int n = 0; n < 2; ++n) _Pragma("unroll") for (int k = 0; k < 2; ++k) \
        acc[ai][bj][m][n] = __builtin_amdgcn_mfma_f32_16x16x32_bf16(Bt[n][k], At[m][k], acc[ai][bj][m][n], 0, 0, 0); __builtin_amdgcn_s_setprio(0); } while (0)
#define PG8_WAIT_V(n) asm volatile("s_waitcnt vmcnt(" #n ")" ::: "memory")
#define PG8_WAIT_L(n) asm volatile("s_waitcnt lgkmcnt(" #n ")" ::: "memory")
#define PG8_BAR __builtin_amdgcn_s_barrier()
#define PG8_SCHED __builtin_amdgcn_sched_barrier(0)
    Unit cur, nxt; int ui = 0;
    if (!S.next(0, cur)) return;
    f32x4 acc[2][2][4][2];
#pragma unroll
    for (int a = 0; a < 2; ++a)
#pragma unroll
        for (int b = 0; b < 2; ++b)
#pragma unroll
            for (int m = 0; m < 4; ++m)
#pragma unroll
                for (int n = 0; n < 2; ++n) acc[a][b][m][n] = (f32x4){0.f, 0.f, 0.f, 0.f};
    bf16x8 At[4][2], B0[2][2], B1[2][2];
    const char* cA = (const char*)g.A + (size_t)cur.pm * tstep; const char* cB = (const char*)g.Bt + (size_t)cur.pn * tstep;
    S.a_ready(cur);
    if constexpr (SP2) {
        PG8_STAGE(PG8_SB(0, 0), cB, voffB); PG8_STAGE(PG8_SB(0, 1), cB + hstep, voffB); PG8_STAGE(PG8_SA(0, 0), cA, voffA); PG8_STAGE(PG8_SA(0, 1), cA + hstep, voffA);
        if (wr == 1) PG8_BAR;
        PG8_WAIT_V(2); PG8_BAR;
        PG8_STAGE(PG8_SB(1, 0), cB + kstep, voffB); PG8_STAGE(PG8_SA(1, 0), cA + kstep, voffA); PG8_STAGE(PG8_SB(1, 1), cB + hstep + kstep, voffB);
        PG8_WAIT_V(6); PG8_BAR;
    } else {
        PG8_STAGE(PG8_SB(0, 0), cB, voffB); PG8_STAGE(PG8_SA(0, 0), cA, voffA); PG8_STAGE(PG8_SB(0, 1), cB + hstep, voffB); PG8_STAGE(PG8_SA(0, 1), cA + hstep, voffA);
        if (wr == 1) PG8_BAR;
        PG8_WAIT_V(4); PG8_BAR;
        PG8_STAGE(PG8_SB(1, 0), cB + kstep, voffB); PG8_STAGE(PG8_SA(1, 0), cA + kstep, voffA); PG8_STAGE(PG8_SB(1, 1), cB + hstep + kstep, voffB);
        PG8_WAIT_V(6); PG8_BAR;
    }
    int fresh = 0;
    for (;;) {
        const bool has_next = S.next(ui + 1, nxt);
        const char* nA = has_next ? (const char*)g.A + (size_t)nxt.pm * tstep : cA; const char* nB = has_next ? (const char*)g.Bt + (size_t)nxt.pn * tstep : cB;
        for (int t = 0; t < nt; t += 2) {
            const bool last = (t == nt - 2);
            const char* a1 = cA + (size_t)(t + 1) * kstep;
            const char* a2 = last ? nA : cA + (size_t)(t + 2) * kstep; const char* b2 = last ? nB : cB + (size_t)(t + 2) * kstep;
            const char* a3 = a2 + kstep; const char* b3 = b2 + kstep;
            if (last && has_next) S.a_ready(nxt);
            if constexpr (SP2) {
            const bool relax = Epi::EPI_VMEM > 0 && __builtin_amdgcn_readfirstlane(fresh) != 0;
            PG8_LDB(B0, 0, 0); PG8_LDB(B1, 0, 1); PG8_SCHED; PG8_LDA(At, 0, 0); PG8_STAGE(PG8_SA(1, 1), a1 + hstep, voffA);
            if (relax) { asm volatile("s_waitcnt vmcnt(%0)" :: "n"(8 + Epi::EPI_VMEM) : "memory"); } else { PG8_WAIT_V(8); }
            PG8_WAIT_L(0); PG8_BAR; PG8_MMA(0, 0, At, B0); PG8_MMA(0, 1, At, B1); PG8_BAR; PG8_SCHED;
            PG8_LDA(At, 0, 1); PG8_STAGE(PG8_SB(0, 0), b2, voffB); PG8_STAGE(PG8_SB(0, 1), b2 + hstep, voffB); PG8_STAGE(PG8_SA(0, 0), a2, voffA);
            if (relax) { asm volatile("s_waitcnt vmcnt(%0)" :: "n"(8 + Epi::EPI_VMEM) : "memory"); } else { PG8_WAIT_V(8); }
            PG8_WAIT_L(0); PG8_BAR; PG8_MMA(1, 0, At, B0); PG8_MMA(1, 1, At, B1); PG8_BAR; PG8_SCHED;
            PG8_LDB(B0, 1, 0); PG8_LDB(B1, 1, 1); PG8_SCHED; PG8_LDA(At, 1, 0); PG8_STAGE(PG8_SA(0, 1), a2 + hstep, voffA);
            PG8_WAIT_V(8); PG8_WAIT_L(0); PG8_BAR; PG8_MMA(0, 0, At, B0); PG8_MMA(0, 1, At, B1); PG8_BAR; PG8_SCHED;
            PG8_LDA(At, 1, 1); PG8_STAGE(PG8_SB(1, 0), b3, voffB); PG8_STAGE(PG8_SB(1, 1), b3 + hstep, voffB); PG8_STAGE(PG8_SA(1, 0), a3, voffA);
            PG8_WAIT_V(8); PG8_WAIT_L(0); PG8_BAR; PG8_MMA(1, 0, At, B0); PG8_MMA(1, 1, At, B1); PG8_BAR; PG8_SCHED;
            fresh = 0;
            } else {
            PG8_LDB(B0, 0, 0); PG8_SCHED; PG8_LDA(At, 0, 0); PG8_STAGE(PG8_SA(1, 1), a1 + hstep, voffA);
            PG8_WAIT_L(8); PG8_BAR; PG8_WAIT_L(0); PG8_MMA(0, 0, At, B0); PG8_BAR; PG8_SCHED;
            PG8_LDB(B1, 0, 1); PG8_STAGE(PG8_SB(0, 0), b2, voffB);
            PG8_BAR; PG8_WAIT_L(0); PG8_MMA(0, 1, At, B1); PG8_BAR;
            PG8_LDA(At, 0, 1); PG8_STAGE(PG8_SA(0, 0), a2, voffA);
            PG8_BAR; PG8_WAIT_L(0); PG8_MMA(1, 0, At, B0); PG8_BAR; PG8_SCHED;
            PG8_STAGE(PG8_SB(0, 1), b2 + hstep, voffB);
            PG8_WAIT_V(6); PG8_BAR; PG8_MMA(1, 1, At, B1); PG8_BAR;
            PG8_LDB(B0, 1, 0); PG8_SCHED; PG8_LDA(At, 1, 0); PG8_STAGE(PG8_SA(0, 1), a2 + hstep, voffA);
            PG8_WAIT_L(8); PG8_BAR; PG8_WAIT_L(0); PG8_MMA(0, 0, At, B0); PG8_BAR; PG8_SCHED;
            PG8_LDB(B1, 1, 1); PG8_STAGE(PG8_SB(1, 0), b3, voffB);
            PG8_BAR; PG8_WAIT_L(0); PG8_MMA(0, 1, At, B1); PG8_BAR;
            PG8_LDA(At, 1, 1); PG8_STAGE(PG8_SA(1, 0), a3, voffA);
            PG8_BAR; PG8_WAIT_L(0); PG8_MMA(1, 0, At, B0); PG8_BAR; PG8_SCHED;
            PG8_STAGE(PG8_SB(1, 1), b3 + hstep, voffB);
            PG8_WAIT_V(6); PG8_BAR; PG8_MMA(1, 1, At, B1); PG8_BAR;
            }
        }
        if constexpr (ALIGN_EPI) { if (wr == 0) PG8_BAR; }
        if constexpr (!Epi::AFTER_DRAIN) { int fr_ = fr, fq_ = fq; asm volatile("" : "+v"(fr_), "+v"(fq_));
            E(acc, cur, wr, wc, fr_, fq_); S.done(cur); }
        if (!has_next) break;
#pragma unroll
        for (int a = 0; a < 2; ++a)
#pragma unroll
            for (int b = 0; b < 2; ++b)
#pragma unroll
                for (int m = 0; m < 4; ++m)
#pragma unroll
                    for (int n = 0; n < 2; ++n) acc[a][b][m][n] = (f32x4){0.f, 0.f, 0.f, 0.f};
        cur = nxt; cA = nA; cB = nB; ++ui; fresh = 1;
        if constexpr (ALIGN_EPI) { if (wr == 1) PG8_BAR; }
    }
    PG8_WAIT_V(0);
    if constexpr (!ALIGN_EPI) { if (wr == 0) PG8_BAR; }
    PG8_BAR;
    if constexpr (Epi::AFTER_DRAIN) { E.fused(acc, cur, wr, wc, fr, fq, lds, wid, lane); S.done(cur); }
#undef PG8_SA
#undef PG8_SB
#undef PG8_STAGE
#undef PG8_LDA
#undef PG8_LDB
#undef PG8_MMA
#undef PG8_WAIT_V
#undef PG8_WAIT_L
#undef PG8_BAR
#undef PG8_SCHED
}
}

#ifndef PG8_SP2
#define PG8_SP2 true
#endif
#ifndef PG8_ALIGN
#define PG8_ALIGN true
#endif
namespace pg8 {
__device__ __forceinline__ float silu_f(float v) { return v * __builtin_amdgcn_rcpf(1.0f + __builtin_amdgcn_exp2f(-1.4426950408889634f * v)); }
__device__ __forceinline__ u32x4 pack8(const f32x4& a, const f32x4& b) { u32x4 w; w.x = cvt_pk_bf16(a[0], a[1]); w.y = cvt_pk_bf16(a[2], a[3]); w.z = cvt_pk_bf16(b[0], b[1]); w.w = cvt_pk_bf16(b[2], b[3]); return w; }
struct EpiIn {
    static constexpr bool PERM = true, AFTER_DRAIN = false;
    static constexpr int EPI_VMEM = 16;
    const float* rstd; bf16_t* ZQ; bf16_t* XBC; bf16_t* Kb; bf16_t* Vb; bf16_t* Gb; const float* qw; const float* kw; float* out; PG8_LAS float* P;
    __device__ __forceinline__ void operator()(f32x4 (&acc)[2][2][4][2], const Unit& u, int wr, int wc, int fr, int fq) const {
        const int pn = u.pn, rbase = u.pm * BM + wr * 64 + fr, lc = wc * 32 + 8 * fq;
#pragma unroll
        for (int ai = 0; ai < 2; ++ai)
#pragma unroll
            for (int m = 0; m < 4; ++m) { const float rs = rstd[rbase + ai * HALF + m * 16];
#pragma unroll
                for (int bj = 0; bj < 2; ++bj) { acc[ai][bj][m][0] = acc[ai][bj][m][0] * rs; acc[ai][bj][m][1] = acc[ai][bj][m][1] * rs; } }
        if (pn < 8 || pn >= 44) {
            bf16_t* base = pn < 8 ? ZQ + pn * BM + lc : Gb + (pn - 44) * BM + lc; const int ld = pn < 8 ? 4096 : 2048;
#pragma unroll
            for (int ai = 0; ai < 2; ++ai)
#pragma unroll
                for (int m = 0; m < 4; ++m) { bf16_t* rowp = base + (size_t)(rbase + ai * HALF + m * 16) * ld;
#pragma unroll
                    for (int bj = 0; bj < 2; ++bj) { f32x4 a = acc[ai][bj][m][0], b = acc[ai][bj][m][1];
#pragma unroll
                        for (int e = 0; e < 4; ++e) { a[e] = silu_f(a[e]); b[e] = silu_f(b[e]); }
                        *(u32x4*)(rowp + bj * HALF) = pack8(a, b); } }
        } else if (pn < 20) {
            const int cx = (pn - 8) * BM + lc;
#pragma unroll
            for (int ai = 0; ai < 2; ++ai)
#pragma unroll
                for (int m = 0; m < 4; ++m) { const int row = rbase + ai * HALF + m * 16; bf16_t* rowp = XBC + (size_t)row * CONVD + cx;
#pragma unroll
                    for (int bj = 0; bj < 2; ++bj) *(u32x4*)(rowp + bj * HALF) = pack8(acc[ai][bj][m][0], acc[ai][bj][m][1]);
                    if ((m & 1) && fr >= 13 && row >= TP - 3) {
                        float* o = row < TP ? out + O_PCONV + (size_t)(row - (TP - 3)) * CONVD + cx
                                            : out + O_SCONV + (size_t)(((row - TP) >> 5) * 3 + ((row & 31) - 29)) * CONVD + cx;
#pragma unroll
                        for (int bj = 0; bj < 2; ++bj) { *(f32x4*)(o + bj * HALF) = acc[ai][bj][m][0]; *(f32x4*)(o + bj * HALF + 4) = acc[ai][bj][m][1]; } } }
        } else if (pn < 36) {
            const bool isq = pn < 28;
#pragma unroll
            for (int ai = 0; ai < 2; ++ai)
#pragma unroll
                for (int m = 0; m < 4; ++m)
#pragma unroll
                    for (int bj = 0; bj < 2; ++bj) { const f32x4 a = acc[ai][bj][m][0], b = acc[ai][bj][m][1];
                        float s = (a[0] * a[0] + a[1] * a[1]) + (a[2] * a[2] + a[3] * a[3]) + (b[0] * b[0] + b[1] * b[1]) + (b[2] * b[2] + b[3] * b[3]);
                        s += __shfl_xor(s, 16); s += __shfl_xor(s, 32);
                        if (fq == 0) P[((ai * HALF + wr * 64 + m * 16 + fr) * 2 + bj) * 4 + wc] = s; }
            const float* nw = isq ? qw : kw; const f32x4 w0 = *(const f32x4*)(nw + lc), w1 = *(const f32x4*)(nw + lc + 4);
            asm volatile("s_waitcnt lgkmcnt(0)" ::: "memory"); __builtin_amdgcn_s_barrier(); asm volatile("" ::: "memory");
            const float extra = isq ? 0.1275174313f : 1.0f;
            bf16_t* base = isq ? ZQ + 2048 + (pn - 20) * BM + lc : Kb + (pn - 28) * BM + lc; const int ld = isq ? 4096 : 2048;
            const int ck = (pn - 28) * BM + lc;
#pragma unroll
            for (int ai = 0; ai < 2; ++ai)
#pragma unroll
                for (int m = 0; m < 4; ++m) { const int row = rbase + ai * HALF + m * 16; bf16_t* rowp = base + (size_t)row * ld;
#pragma unroll
                    for (int bj = 0; bj < 2; ++bj) { const f32x4 p4 = *(const PG8_LAS f32x4*)(P + ((ai * HALF + wr * 64 + m * 16 + fr) * 2 + bj) * 4);
                        const float sc = __builtin_amdgcn_rsqf(((p4[0] + p4[1]) + (p4[2] + p4[3])) * (1.0f / 128.0f) + EPS) * extra;
                        const f32x4 a = acc[ai][bj][m][0] * sc * w0, b = acc[ai][bj][m][1] * sc * w1;
                        *(u32x4*)(rowp + bj * HALF) = pack8(a, b);
                        if (!isq && row >= TP - 512) { float* o = (row < TP ? out + O_PK + (size_t)(row - (TP - 512)) * 2048 : out + O_SK + (size_t)(row - TP) * 2048) + ck + bj * HALF;
                            *(f32x4*)o = a; *(f32x4*)(o + 4) = b; } } }
        } else {
            const int cv = (pn - 36) * BM + lc;
#pragma unroll
            for (int ai = 0; ai < 2; ++ai)
#pragma unroll
                for (int m = 0; m < 4; ++m) { const int row = rbase + ai * HALF + m * 16; bf16_t* rowp = Vb + (size_t)row * 2048 + cv;
#pragma unroll
                    for (int bj = 0; bj < 2; ++bj) { *(u32x4*)(rowp + bj * HALF) = pack8(acc[ai][bj][m][0], acc[ai][bj][m][1]);
                        if (row >= TP - 512) { float* o = (row < TP ? out + O_PV + (size_t)(row - (TP - 512)) * 2048 : out + O_SV + (size_t)(row - TP) * 2048) + cv + bj * HALF;
                            *(f32x4*)o = acc[ai][bj][m][0]; *(f32x4*)(o + 4) = acc[ai][bj][m][1]; } } }
        }
    }
};
struct EpiOut {
    static constexpr bool PERM = false, AFTER_DRAIN = false;
    static constexpr int EPI_VMEM = 0;
    const float* xp; const float* xs; float* out;
    __device__ __forceinline__ void operator()(f32x4 (&acc)[2][2][4][2], const Unit& u, int wr, int wc, int fr, int fq) const {
        const int row0 = u.pm * BM + wr * 64 + fr, col0 = u.pn * BM + wc * 32 + 4 * fq;
        const float* xb = u.pm < TP / BM ? xp + (size_t)row0 * DM : xs + (size_t)(row0 - TP) * DM;
        float* ob = out + (size_t)row0 * DM;
#pragma unroll
        for (int ai = 0; ai < 2; ++ai) {
            f32x4 xv[4][2][2];
#pragma unroll
            for (int m = 0; m < 4; ++m)
#pragma unroll
                for (int bj = 0; bj < 2; ++bj)
#pragma unroll
                    for (int n = 0; n < 2; ++n) xv[m][bj][n] = *(const f32x4*)(xb + (size_t)(ai * HALF + m * 16) * DM + col0 + bj * HALF + n * 16);
#pragma unroll
            for (int m = 0; m < 4; ++m)
#pragma unroll
                for (int bj = 0; bj < 2; ++bj)
#pragma unroll
                    for (int n = 0; n < 2; ++n) *(f32x4*)(ob + (size_t)(ai * HALF + m * 16) * DM + col0 + bj * HALF + n * 16) = acc[ai][bj][m][n] + xv[m][bj][n];
        }
    }
};
struct EpiNull {
    static constexpr bool PERM = true, AFTER_DRAIN = false;
    static constexpr int EPI_VMEM = 0;
    __device__ __forceinline__ void operator()(f32x4 (&acc)[2][2][4][2], const Unit&, int, int, int, int) const {
#pragma unroll
        for (int ai = 0; ai < 2; ++ai)
#pragma unroll
            for (int bj = 0; bj < 2; ++bj)
#pragma unroll
                for (int m = 0; m < 4; ++m) { asm volatile("" :: "v"(acc[ai][bj][m][0]), "v"(acc[ai][bj][m][1])); }
    }
};
struct HotOrder { int c; __device__ __forceinline__ bool next(int i, Unit& u) const { if (i >= 14) return false; u.pm = (c >> 3) & 1; u.pn = c & 7; return true; } __device__ __forceinline__ void a_ready(const Unit&) const {} __device__ __forceinline__ void done(const Unit&) const {} };
struct OneUnit { Unit u; __device__ __forceinline__ bool next(int i, Unit& o) const { if (i) return false; o = u; return true; } __device__ __forceinline__ void a_ready(const Unit&) const {} __device__ __forceinline__ void done(const Unit&) const {} };
struct EpiSlab {
    static constexpr bool PERM = false, AFTER_DRAIN = false;
    static constexpr int EPI_VMEM = 0;
    float* slab;
    __device__ __forceinline__ void operator()(f32x4 (&acc)[2][2][4][2], const Unit&, int wr, int wc, int fr, int fq) const {
        float* ob = slab + (size_t)(wr * 64 + fr) * 256 + wc * 32 + 4 * fq;
#pragma unroll
        for (int ai = 0; ai < 2; ++ai)
#pragma unroll
            for (int m = 0; m < 4; ++m)
#pragma unroll
                for (int bj = 0; bj < 2; ++bj)
#pragma unroll
                    for (int n = 0; n < 2; ++n) *(f32x4*)(ob + (size_t)(ai * HALF + m * 16) * 256 + bj * HALF + n * 16) = acc[ai][bj][m][n];
    }
};
}
#define GAS __attribute__((address_space(1)))
#define LAS __attribute__((address_space(3)))
typedef unsigned short bf16;
typedef unsigned v4u __attribute__((ext_vector_type(4)));
typedef float f32x4 __attribute__((ext_vector_type(4)));
typedef short bf16x8 __attribute__((ext_vector_type(8)));
typedef GAS unsigned gu32;
typedef GAS unsigned long long gu64;
#define RLX_AGENT __ATOMIC_RELAXED, __HIP_MEMORY_SCOPE_AGENT
#define LDS_WAIT() asm volatile("s_waitcnt lgkmcnt(0)" ::: "memory")
#define VM_WAIT() asm volatile("s_waitcnt vmcnt(0)" ::: "memory")
__device__ __forceinline__ unsigned long long rt() { return __builtin_amdgcn_s_memrealtime(); }
__device__ __forceinline__ unsigned f2bf(float f) { unsigned u = __builtin_bit_cast(unsigned, f); return (u + 0x7fffu + ((u >> 16) & 1u)) >> 16; }
__device__ __forceinline__ unsigned pk2(float lo, float hi) { return f2bf(lo) | (f2bf(hi) << 16); }

#define XB_TMO      128
#define XB_XCNT(j)  (256  + 64 * (j))
#define XB_XSUB(j)  (1280 + 64 * (j))
#define XB_XGEN(j)  (2304 + 64 * (j))
#define XB_TOP      3328
#define XB_TOPGEN   3392
#define XCD_BAR_WORDS 3456
#define XB_SPIN_CAP (1u << 18)

__device__ __forceinline__ unsigned xb_ld(unsigned* p)              { return __hip_atomic_load(p, __ATOMIC_RELAXED, __HIP_MEMORY_SCOPE_AGENT); }
__device__ __forceinline__ unsigned xb_add(unsigned* p, unsigned v) { return __hip_atomic_fetch_add(p, v, __ATOMIC_RELAXED, __HIP_MEMORY_SCOPE_AGENT); }
__device__ __forceinline__ unsigned xb_xcc_id() { return (unsigned)__builtin_amdgcn_s_getreg((3 << 11) | 20) & 0xFu; }
#define XB_SPIN(cond, bar) do { unsigned _sp = 0; while (cond) { __builtin_amdgcn_s_sleep(1); \
    if ((++_sp & 255u) == 0u) { if (xb_ld(&(bar)[XB_TMO])) break; if (_sp > XB_SPIN_CAP) { atomicAdd(&(bar)[XB_TMO], 1u); break; } } } } while (0)

__device__ __forceinline__ int lane_now() { int l; asm volatile("v_mbcnt_lo_u32_b32 %0, -1, 0\n\tv_mbcnt_hi_u32_b32 %0, -1, %0" : "=&v"(l)); return l; }
struct XcdBarrier {
    unsigned w0;
    unsigned* bar; unsigned x;
    volatile LAS unsigned* st;
};

__device__ __forceinline__ XcdBarrier xcd_barrier_post(unsigned* bar, volatile LAS unsigned* st) {
    XcdBarrier b; b.bar = bar; b.x = xb_xcc_id(); b.st = st; b.w0 = __builtin_amdgcn_readfirstlane(threadIdx.x >> 6) == 0 ? 1u : 0u;
    if (threadIdx.x == 0) (void)xb_add(&bar[XB_XCNT(b.x)], 1u);
    return b;
}
__device__ __forceinline__ void xcd_barrier_complete(unsigned* bar, unsigned x, unsigned& nloc, unsigned& nx) {
    const unsigned G = gridDim.x * gridDim.y * gridDim.z;
    unsigned sum, cnt, mine, sp = 0u;
    for (;;) {
        sum = 0u; cnt = 0u; mine = 0u;
#pragma unroll
        for (unsigned j = 0; j < 16; ++j) { const unsigned c = xb_ld(&bar[XB_XCNT(j)]); sum += c; cnt += (c > 0u) ? 1u : 0u; mine = (j == x) ? c : mine; }
        if (sum == G) break;
        __builtin_amdgcn_s_sleep(1);
        if ((++sp & 255u) == 0u) { if (xb_ld(&bar[XB_TMO])) break; if (sp > XB_SPIN_CAP) { atomicAdd(&bar[XB_TMO], 1u); break; } }
    }
    nloc = mine > 0u ? mine : 1u; nx = cnt > 0u ? cnt : 1u;
}

__device__ __forceinline__ void xcd_barrier(const XcdBarrier& b) {
    asm volatile("s_waitcnt vmcnt(0)" ::: "memory");
    __syncthreads();
    if (b.w0 != 0u && lane_now() == 0) {
        unsigned* bar = b.bar;
        __builtin_amdgcn_s_waitcnt(0);
        unsigned nloc = b.st[0], nx = b.st[1];
        if (nloc == 0u) { xcd_barrier_complete(bar, b.x, nloc, nx); b.st[0] = nloc; b.st[1] = nx; }
        const unsigned old = xb_add(&bar[XB_XSUB(b.x)], 1u);
        const unsigned gen = old / nloc;
        if (old + 1u == (gen + 1u) * nloc) {
            __builtin_amdgcn_fence(__ATOMIC_RELEASE, "agent");
            asm volatile("s_waitcnt vmcnt(0)" ::: "memory");
            const unsigned og = xb_add(&bar[XB_TOP], 1u);
            const unsigned tg = og / nx;
            if (og + 1u == (tg + 1u) * nx) xb_add(&bar[XB_TOPGEN], 1u);
            else XB_SPIN(xb_ld(&bar[XB_TOPGEN]) == tg, bar);
            __builtin_amdgcn_fence(__ATOMIC_ACQUIRE, "agent");
            xb_add(&bar[XB_XGEN(b.x)], 1u);
            asm volatile("s_waitcnt vmcnt(0)" ::: "memory");
        } else {
            XB_SPIN(xb_ld(&bar[XB_XGEN(b.x)]) == gen, bar);
            __builtin_amdgcn_fence(__ATOMIC_ACQUIRE, "agent");
            asm volatile("s_waitcnt vmcnt(0)" ::: "memory");
        }
    }
    __syncthreads();
}

struct Frame {
    LAS unsigned char* lds; volatile LAS unsigned* MISC; gu32* ctl;
    int tid, lane, wave, vcu, G;
};
__device__ __forceinline__ float wave_sum(float v) {
#pragma unroll
    for (int o = 1; o < 64; o <<= 1) v += __shfl_xor(v, o);
    return v;
}
typedef float p0f4 __attribute__((ext_vector_type(4)));
struct P0Item { const float* W; size_t ldw; int k0, n0; bf16* dst; size_t ldt; const float* sc; };
__device__ __forceinline__ void p0_item_load(const P0Item& it, int lane, p0f4 (&v)[8], float (&sv)[8]) {
    const int r8 = lane >> 3, c4 = (lane & 7) * 4;
#pragma unroll
    for (int i = 0; i < 8; ++i) { v[i] = *(const p0f4*)(it.W + (size_t)(it.k0 + 8 * i + r8) * it.ldw + it.n0 + c4); sv[i] = it.sc ? it.sc[it.k0 + 8 * i + r8] : 1.0f; }
}
__device__ __forceinline__ void p0_item_store(const P0Item& it, int lane, const p0f4 (&v)[8], const float (&sv)[8], LAS float* scr) {
    const int r8 = lane >> 3, c4 = (lane & 7) * 4;
#pragma unroll
    for (int i = 0; i < 8; ++i) { LAS float* p = scr + (8 * i + r8) * 33 + c4; p[0] = v[i][0] * sv[i]; p[1] = v[i][1] * sv[i]; p[2] = v[i][2] * sv[i]; p[3] = v[i][3] * sv[i]; }
    LDS_WAIT(); asm volatile("" ::: "memory");
    const int c = lane & 7;
#pragma unroll
    for (int j = 0; j < 4; ++j) { const int n = (lane >> 3) + 8 * j; const LAS float* s = scr + (8 * c) * 33 + n;
        v4u o; o.x = pk2(s[0 * 33], s[1 * 33]); o.y = pk2(s[2 * 33], s[3 * 33]); o.z = pk2(s[4 * 33], s[5 * 33]); o.w = pk2(s[6 * 33], s[7 * 33]);
        *(GAS v4u*)(it.dst + (size_t)n * it.ldt + it.k0 + 8 * c) = o; }
    LDS_WAIT(); asm volatile("" ::: "memory");
}
__device__ __forceinline__ P0Item p0_decode(int it, const float* w_in, const float* w_out, const float* norm_w, bf16* WinT, bf16* WdtT, bf16* WoutT) {
    constexpr int NB_IN = SRC_LD / 32  , I_IN = 32 * NB_IN;
    P0Item r;
    if (it < I_IN) { const int kb = it / NB_IN, nb = it % NB_IN;
        r.W = w_in; r.ldw = SRC_LD; r.k0 = 64 * kb; r.n0 = 32 * nb; r.ldt = 2048; r.sc = norm_w;
        r.dst = nb < 160 ? WinT + (size_t)(32 * nb) * 2048 : (nb == 160 ? WdtT : WinT + (size_t)(32 * (nb - 1)) * 2048);
    } else { const int q = it - I_IN, kb = q / 64, nb = q % 64;
        r.W = w_out; r.ldw = 2048; r.k0 = 64 * kb; r.n0 = 32 * nb; r.ldt = 4096; r.sc = nullptr; r.dst = WoutT + (size_t)(32 * nb) * 4096; }
    return r;
}
__device__ __forceinline__ void p0a_weights(Frame& F, const float* w_in, const float* w_out, const float* norm_w, bf16* WinT, bf16* WdtT, bf16* WoutT) {
    LAS float* scr = (LAS float*)(F.lds + RING_OFF + F.wave * 16384);
    const int gw = F.wave * F.G + F.vcu, NGW = F.G * NWAVES;
    constexpr int NITEMS = 32 * (SRC_LD / 32) + 64 * 64;
    constexpr int NXB = MTOK / 16;
    const int nheavy = (F.G == 256) ? NXB - (NXB / F.G) * F.G : 0;
    const bool heavy = F.vcu < nheavy;
    const int lw = (F.vcu - nheavy) * NWAVES + F.wave;
    const int norph = nheavy * NWAVES * 2;
    int extra = -1;
    if (!heavy && nheavy > 0 && lw < norph) { const int kk = lw / (nheavy * NWAVES), r = lw - kk * nheavy * NWAVES, ow = r / nheavy, ov = r - ow * nheavy; extra = ow * F.G + ov + (6 + kk) * NGW; if (extra >= NITEMS) extra = -1; }
    if (gw >= NITEMS) return;
    const int nb = (NITEMS - gw + NGW - 1) / NGW;
    const int ntrip = heavy ? nb - (nb > 6 ? (nb > 7 ? 2 : 1) : 0) : nb + (extra >= 0 ? 1 : 0);
#define P0_ITEM(J) (heavy ? gw + ((J) < 6 ? (J) : (J) + 2) * NGW : ((J) < nb ? gw + (J) * NGW : extra))
    P0Item cur = p0_decode(P0_ITEM(0), w_in, w_out, norm_w, WinT, WdtT, WoutT);
    p0f4 v[8]; float sv[8];
    p0_item_load(cur, F.lane, v, sv);
#pragma unroll 1
    for (int j = 0; j < ntrip; ++j) {
        const int jn = j + 1 < ntrip ? j + 1 : j;
        P0Item nxt = p0_decode(P0_ITEM(jn), w_in, w_out, norm_w, WinT, WdtT, WoutT);
        p0f4 v2[8]; float sv2[8];
        p0_item_load(nxt, F.lane, v2, sv2);
        p0_item_store(cur, F.lane, v, sv, scr);
        cur = nxt;
#pragma unroll
        for (int i = 0; i < 8; ++i) { v[i] = v2[i]; sv[i] = sv2[i]; }
    }
#undef P0_ITEM
}
typedef float f32x4v __attribute__((ext_vector_type(4)));
__device__ __forceinline__ void p0b_rows(Frame& F, const float* __restrict__ xp, const float* __restrict__ xs, const bf16* __restrict__ WdtT, const float* __restrict__ dt_bias, bf16* __restrict__ H, float* __restrict__ rstd, float* __restrict__ dtb) {
    const int gw = F.wave * F.G + F.vcu, NGW = F.G * NWAVES, lane = F.lane, r = lane & 15, kq = lane >> 4;
    for (int blk = gw; blk < MTOK / 16; blk += NGW) {
        const int row = blk * 16 + r;
        const float* __restrict__ xr = (row < TP ? xp + (size_t)row * DM : xs + (size_t)(row - TP) * DM) + 8 * kq;
        bf16* __restrict__ hr = H + (size_t)row * DM + 8 * kq;
        const bf16* __restrict__ w0 = WdtT + (size_t)r * DM + 8 * kq; const bf16* __restrict__ w1 = w0 + (size_t)16 * DM;
        f32x4v a0 = {0.f, 0.f, 0.f, 0.f}, a1 = {0.f, 0.f, 0.f, 0.f}; float ss = 0.f;
#pragma unroll 1
        for (int s8 = 0; s8 < 8; ++s8) {
            f32x4v xu[8], xv[8]; bf16x8 b0[8], b1[8];
#pragma unroll
            for (int i = 0; i < 8; ++i) { const int s = s8 * 8 + i; xu[i] = *(const f32x4v*)(xr + 32 * s); xv[i] = *(const f32x4v*)(xr + 32 * s + 4); b0[i] = *(const bf16x8*)(w0 + 32 * s); b1[i] = *(const bf16x8*)(w1 + 32 * s); }
#pragma unroll
            for (int i = 0; i < 8; ++i) { const int s = s8 * 8 + i; const f32x4v u = xu[i], v = xv[i];
                ss += (u[0] * u[0] + u[1] * u[1]) + (u[2] * u[2] + u[3] * u[3]) + (v[0] * v[0] + v[1] * v[1]) + (v[2] * v[2] + v[3] * v[3]);
                v4u p; p.x = pg8::cvt_pk_bf16(u[0], u[1]); p.y = pg8::cvt_pk_bf16(u[2], u[3]); p.z = pg8::cvt_pk_bf16(v[0], v[1]); p.w = pg8::cvt_pk_bf16(v[2], v[3]);
                *(v4u*)(hr + 32 * s) = p;
                const bf16x8 af = __builtin_bit_cast(bf16x8, p);
                a0 = __builtin_amdgcn_mfma_f32_16x16x32_bf16(af, b0[i], a0, 0, 0, 0);
                a1 = __builtin_amdgcn_mfma_f32_16x16x32_bf16(af, b1[i], a1, 0, 0, 0); }
        }
        ss += __shfl_xor(ss, 16); ss += __shfl_xor(ss, 32);
        const float rs = __builtin_amdgcn_rsqf(ss * (1.0f / DM) + EPS);
        if (lane < 16) rstd[row] = rs;
        const float bia0 = dt_bias[r], bia1 = dt_bias[16 + r];
#pragma unroll
        for (int i = 0; i < 4; ++i) {
            const float rsi = __shfl(rs, 4 * kq + i);
            float v0 = a0[i] * rsi + bia0, v1 = a1[i] * rsi + bia1;
            v0 = v0 > 20.f ? v0 : __logf(1.0f + __expf(v0)); v1 = v1 > 20.f ? v1 : __logf(1.0f + __expf(v1));
            float* o = dtb + (size_t)(blk * 16 + 4 * kq + i) * 32;
            o[r] = v0; o[16 + r] = v1;
        }
    }
}

__device__ __forceinline__ void p0x_rows(Frame& F, const float* __restrict__ xp, const float* __restrict__ xs, const float* __restrict__ w_in, const float* __restrict__ norm_w, const float* __restrict__ dt_bias,
                                         bf16* __restrict__ H, float* __restrict__ rstd, float* __restrict__ dtb) {
    const int lane = F.lane, r = lane & 15, kq = lane >> 4, w = F.wave, tid = F.tid;
    LAS float* scr = (LAS float*)(F.lds + RING_OFF + w * 16384);
    bf16x8 b0[8], b1[8];
    {
        const int r8 = lane >> 3, c4 = (lane & 7) * 4;
#pragma unroll
        for (int q = 0; q < 4; ++q) {
            const int k0 = 256 * w + 64 * q;
            p0f4 v[8]; float sv[8];
#pragma unroll
            for (int i = 0; i < 8; ++i) { v[i] = *(const p0f4*)(w_in + (size_t)(k0 + 8 * i + r8) * SRC_LD + 5120 + c4); sv[i] = norm_w[k0 + 8 * i + r8]; }
#pragma unroll
            for (int i = 0; i < 8; ++i) { LAS float* p = scr + (8 * i + r8) * 33 + c4; p[0] = v[i][0] * sv[i]; p[1] = v[i][1] * sv[i]; p[2] = v[i][2] * sv[i]; p[3] = v[i][3] * sv[i]; }
            LDS_WAIT(); asm volatile("" ::: "memory");
#pragma unroll
            for (int t = 0; t < 2; ++t) { const LAS float* s0 = scr + (32 * t + 8 * kq) * 33 + r; const LAS float* s1 = s0 + 16;
                v4u o0, o1;
                o0.x = pk2(s0[0 * 33], s0[1 * 33]); o0.y = pk2(s0[2 * 33], s0[3 * 33]); o0.z = pk2(s0[4 * 33], s0[5 * 33]); o0.w = pk2(s0[6 * 33], s0[7 * 33]);
                o1.x = pk2(s1[0 * 33], s1[1 * 33]); o1.y = pk2(s1[2 * 33], s1[3 * 33]); o1.z = pk2(s1[4 * 33], s1[5 * 33]); o1.w = pk2(s1[6 * 33], s1[7 * 33]);
                b0[2 * q + t] = __builtin_bit_cast(bf16x8, o0); b1[2 * q + t] = __builtin_bit_cast(bf16x8, o1); }
            LDS_WAIT(); asm volatile("" ::: "memory");
        }
    }
#define P0X_RED(PAR, W) ((LAS float*)(F.lds + RING_OFF + (W) * 16384 + 8448 + (PAR) * 2304))
    const int nblk = MTOK / 16;
    int blk = F.vcu;
    f32x4v xu[8], xv[8];
    if (blk < nblk) { const int row = blk * 16 + r; const float* xr = (row < TP ? xp + (size_t)row * DM : xs + (size_t)(row - TP) * DM) + 256 * w + 8 * kq;
#pragma unroll
        for (int i = 0; i < 8; ++i) { xu[i] = *(const f32x4v*)(xr + 32 * i); xv[i] = *(const f32x4v*)(xr + 32 * i + 4); } }
    int par = 0;
#pragma unroll 1
    for (; blk < nblk; blk += F.G, par ^= 1) {
        const int row = blk * 16 + r;
        bf16* __restrict__ hr = H + (size_t)row * DM + 256 * w + 8 * kq;
        f32x4v a0 = {0.f, 0.f, 0.f, 0.f}, a1 = {0.f, 0.f, 0.f, 0.f}; float ss = 0.f;
#pragma unroll
        for (int i = 0; i < 8; ++i) { const f32x4v u = xu[i], v = xv[i];
            ss += (u[0] * u[0] + u[1] * u[1]) + (u[2] * u[2] + u[3] * u[3]) + (v[0] * v[0] + v[1] * v[1]) + (v[2] * v[2] + v[3] * v[3]);
            v4u p; p.x = pg8::cvt_pk_bf16(u[0], u[1]); p.y = pg8::cvt_pk_bf16(u[2], u[3]); p.z = pg8::cvt_pk_bf16(v[0], v[1]); p.w = pg8::cvt_pk_bf16(v[2], v[3]);
            *(v4u*)(hr + 32 * i) = p;
            const bf16x8 af = __builtin_bit_cast(bf16x8, p);
            a0 = __builtin_amdgcn_mfma_f32_16x16x32_bf16(af, b0[i], a0, 0, 0, 0);
            a1 = __builtin_amdgcn_mfma_f32_16x16x32_bf16(af, b1[i], a1, 0, 0, 0); }
        {
            const int nb = blk + F.G;
            if (nb < nblk) { const int nrow = nb * 16 + r; const float* xr = (nrow < TP ? xp + (size_t)nrow * DM : xs + (size_t)(nrow - TP) * DM) + 256 * w + 8 * kq;
#pragma unroll
                for (int i = 0; i < 8; ++i) { xu[i] = *(const f32x4v*)(xr + 32 * i); xv[i] = *(const f32x4v*)(xr + 32 * i + 4); } }
        }
        ss += __shfl_xor(ss, 16); ss += __shfl_xor(ss, 32);
        LAS float* rw = P0X_RED(par, w);
#pragma unroll
        for (int i = 0; i < 4; ++i) { rw[i * 64 + lane] = a0[i]; rw[(4 + i) * 64 + lane] = a1[i]; }
        rw[8 * 64 + lane] = ss;
        __syncthreads();
        {
            const int rho = tid >> 5, eta = tid & 31, sl = (eta & 15) + 16 * (rho >> 2), j = (eta >> 4) * 4 + (rho & 3);
            float acc = 0.f, sq = 0.f;
#pragma unroll
            for (int ww = 0; ww < 8; ++ww) { const LAS float* q = P0X_RED(par, ww); acc += q[j * 64 + sl]; sq += q[8 * 64 + rho]; }
            const float rs = __builtin_amdgcn_rsqf(sq * (1.0f / DM) + EPS);
            if (eta == 0) rstd[blk * 16 + rho] = rs;
            float v0 = acc * rs + dt_bias[eta];
            v0 = v0 > 20.f ? v0 : __logf(1.0f + __expf(v0));
            dtb[(size_t)blk * 512 + tid] = v0;
        }
    }
}
namespace ssd {
typedef _Float16 half8 __attribute__((ext_vector_type(8)));
typedef float f32x16 __attribute__((ext_vector_type(16)));
typedef float f4 __attribute__((ext_vector_type(4)));
typedef unsigned u2 __attribute__((ext_vector_type(2)));
typedef unsigned u4 __attribute__((ext_vector_type(4)));
constexpr int XT_OFF = 0, BT_OFF = 36864, BS_OFF = 55296, CS_OFF = 72704, GT_OFF = 90112, TAB_OFF = 102400, RED_OFF = 107520, TOTA_OFF = 111616, RS_OFF = 112640;
constexpr float LOG2E = 1.4426950408889634f;
#define MFMA16(a, b, c) __builtin_amdgcn_mfma_f32_32x32x16_f16((a), (b), (c), 0, 0, 0)
#define LBAR() do { asm volatile("s_waitcnt lgkmcnt(0)" ::: "memory"); __builtin_amdgcn_s_barrier(); asm volatile("" ::: "memory"); } while (0)
__device__ __forceinline__ int xt_addr(int hl, int p, int ch) { return XT_OFF + (hl * 64 + p) * 144 + (ch << 4); }
__device__ __forceinline__ int bt_addr(int n, int ch) { return BT_OFF + n * 144 + (ch << 4); }
__device__ __forceinline__ int bs_addr(int j, int ch) { return BS_OFF + j * 272 + (ch << 4); }
__device__ __forceinline__ int cs_addr(int i, int ch) { return CS_OFF + i * 272 + (ch << 4); }
__device__ __forceinline__ unsigned pkh(float a, float b) { return __builtin_bit_cast(unsigned, __builtin_amdgcn_cvt_pkrtz(a, b)); }
__device__ __forceinline__ half8 pack_step(const f32x16& x, int s) {
    u4 p; p.x = pkh(x[8 * s], x[8 * s + 1]); p.y = pkh(x[8 * s + 2], x[8 * s + 3]); p.z = pkh(x[8 * s + 4], x[8 * s + 5]); p.w = pkh(x[8 * s + 6], x[8 * s + 7]);
    return __builtin_bit_cast(half8, p);
}
__device__ __forceinline__ half8 ld2x8(const LAS unsigned char* lds, int a0, int a1) {
    const u2 lo = *(const LAS u2*)(lds + a0), hi = *(const LAS u2*)(lds + a1); u4 p; p.x = lo.x; p.y = lo.y; p.z = hi.x; p.w = hi.y; return __builtin_bit_cast(half8, p);
}
__device__ __forceinline__ f4 bf4(u2 r) { return (f4){__uint_as_float(r.x << 16), __uint_as_float(r.x & 0xffff0000u), __uint_as_float(r.y << 16), __uint_as_float(r.y & 0xffff0000u)}; }
struct Ctx {
    const unsigned short* XBC; const float* DT; unsigned short* ZQ; const float* conv_w; const float* conv_b; const float* a_log; const float* d_skip; const float* ssm_norm_w; const float* state_conv; unsigned short* YO; unsigned char* BCC;
};
template <bool FULL, bool SAMPLE>
__device__ __forceinline__ void chunk(const Frame& F, const Ctx& c, int g, int hh, int row0, int hb, int ci, f32x16 (&S)[4], float& dec2, int cmode = -1, unsigned char* cch = nullptr) {
    constexpr int nvalid = SAMPLE ? 32 : 64;
    const LAS unsigned char* ldr = F.lds; LAS unsigned char* ldw = F.lds;
    int z0; asm volatile("v_mov_b32 %0, 0" : "=v"(z0));
    const int tid = F.tid + z0, lane = F.lane + z0, w = F.wave, l31 = lane & 31, h = lane >> 5, hl = w >> 1, ph = w & 1, head = g * 8 + hh * 4 + hl;
    LAS float* tab_a = (LAS float*)(ldw + TAB_OFF + w * 640); LAS float* tab_d = tab_a + 64; LAS _Float16* tab_w = (LAS _Float16*)(tab_a + 128);
    const float alog = c.a_log[head];
    const float dtv = lane < nvalid ? c.DT[(size_t)(row0 + lane) * 32 + head] : 0.f;
    {
        const bool cached = cmode == 1;
        constexpr int BCB = FULL ? 53248 : 18432;
        if (cached) {
#pragma unroll
            for (int k = 0; k < (BCB / 1024 + 7) / 8; ++k) { const int pc = w + 8 * k;
                if (pc < BCB / 1024) __builtin_amdgcn_global_load_lds((const unsigned*)(cch + pc * 1024 + lane * 16), (LAS unsigned*)(ldw + BT_OFF + pc * 1024), 16, 0, 0); }
        }
        const int kind = cached ? (w & 1) : (w & 3), tq0 = cached ? (w >> 1) : (w >> 2);
        const int nrnd = cached ? 1 : 2;
        const bool isx = kind < 2, isb = kind == 2;
        if (FULL || kind < 3) {
            const int colbase = isx ? 512 * g + 256 * hh + 128 * kind : (isb ? 2048 + 128 * g : 2560 + 128 * g);
            const unsigned lane2 = (unsigned)lane * 2u;
            typedef float f2 __attribute__((ext_vector_type(2)));
            const float* wbase = c.conv_w + colbase;
            const f2 w0 = *(const f2*)(wbase + lane2), w1 = *(const f2*)(wbase + CONVD + lane2), w2 = *(const f2*)(wbase + 2 * CONVD + lane2), w3 = *(const f2*)(wbase + 3 * CONVD + lane2), cb = *(const f2*)(c.conv_b + colbase + lane2);
#define BF2(u) ((f2){__uint_as_float((u) << 16), __uint_as_float((u) & 0xffff0000u)})
            unsigned hraw[2][3], rv[2][16]; f2 hst[3];
#pragma unroll
            for (int rnd = 0; rnd < 2; ++rnd) if (rnd < nrnd) {
                const int tq = tq0 + 2 * rnd;
#pragma unroll
                for (int t = 0; t < 3; ++t) { const int j = 16 * tq - 3 + t;
                    const int r = SAMPLE ? row0 + (j < 0 ? 0 : (j & 31)) : (row0 + j < 0 ? 0 : row0 + j);
                    hraw[rnd][t] = *(const unsigned*)(c.XBC + (size_t)r * CONVD + colbase + lane2); }
                const unsigned short* xr = c.XBC + (size_t)(row0 + (SAMPLE ? ((16 * tq) & 31) : 16 * tq)) * CONVD + colbase;
#pragma unroll
                for (int i = 0; i < 16; ++i) rv[rnd][i] = *(const unsigned*)(xr + (size_t)i * CONVD + lane2);
            }
            if (SAMPLE) {
#pragma unroll
                for (int t = 0; t < 3; ++t) hst[t] = *(const f2*)(c.state_conv + ((size_t)hb * 3 + t) * CONVD + colbase + lane2);
            }
            const int xt_l = XT_OFF + (128 * (kind & 1) + 2 * lane) * 144, bt_l = BT_OFF + 2 * lane * 144;
            const int rm_l = (isb ? BS_OFF : CS_OFF) + 4 * lane;
#pragma unroll
            for (int rnd = 0; rnd < 2; ++rnd) if (rnd < nrnd) {
                const int tq = tq0 + 2 * rnd;
                f2 win0, win1, win2;
                if (SAMPLE) { const bool first = (tq == 0); win0 = first ? hst[0] : BF2(hraw[rnd][0]); win1 = first ? hst[1] : BF2(hraw[rnd][1]); win2 = first ? hst[2] : BF2(hraw[rnd][2]); }
                else { const bool zer = (row0 + 16 * tq) < 3;
                    win0 = zer ? (f2){0.f, 0.f} : BF2(hraw[rnd][0]); win1 = zer ? (f2){0.f, 0.f} : BF2(hraw[rnd][1]); win2 = zer ? (f2){0.f, 0.f} : BF2(hraw[rnd][2]); }
                const bool ok = !SAMPLE || tq < 2;
#pragma unroll
                for (int tgl = 0; tgl < 2; ++tgl) {
                    const int tg = 2 * tq + tgl, j0 = 8 * tg;
                    unsigned pt[2][4];
                    unsigned pr[8];
#pragma unroll
                    for (int i2 = 0; i2 < 4; ++i2) {
                        f2 oa, ob;
                        { const f2 cur = BF2(rv[rnd][8 * tgl + 2 * i2]); const f2 cv = cb + w0 * win0 + w1 * win1 + w2 * win2 + w3 * cur;
#pragma unroll
                          for (int e = 0; e < 2; ++e) oa[e] = ok ? cv[e] * __builtin_amdgcn_rcpf(1.0f + __builtin_amdgcn_exp2f(-LOG2E * cv[e])) : 0.f;
                          win0 = win1; win1 = win2; win2 = cur; }
                        { const f2 cur = BF2(rv[rnd][8 * tgl + 2 * i2 + 1]); const f2 cv = cb + w0 * win0 + w1 * win1 + w2 * win2 + w3 * cur;
#pragma unroll
                          for (int e = 0; e < 2; ++e) ob[e] = ok ? cv[e] * __builtin_amdgcn_rcpf(1.0f + __builtin_amdgcn_exp2f(-LOG2E * cv[e])) : 0.f;
                          win0 = win1; win1 = win2; win2 = cur; }
                        pt[0][i2] = pkh(oa[0], ob[0]); pt[1][i2] = pkh(oa[1], ob[1]);
                        pr[2 * i2] = pkh(oa[0], oa[1]); pr[2 * i2 + 1] = pkh(ob[0], ob[1]);
                    }
                    if (isx || isb) {
#pragma unroll
                        for (int e = 0; e < 2; ++e) { u4 pk; pk.x = pt[e][0]; pk.y = pt[e][1]; pk.z = pt[e][2]; pk.w = pt[e][3];
                            *(LAS u4*)(ldw + (isx ? xt_l : bt_l) + e * 144 + tg * 16) = pk; }
                    }
                    if (!isx && FULL) {
#pragma unroll
                        for (int i = 0; i < 8; ++i) *(LAS unsigned*)(ldw + rm_l + (j0 + i) * 272) = pr[i];
                    }
                }
            }
#undef BF2
        }
    }
    float a2_last;
    {
        const float A2 = -__expf(alog) * LOG2E;
        float a = dtv * A2;
#pragma unroll
        for (int o = 1; o < 64; o <<= 1) { const float t = __shfl_up(a, o); if (lane >= o) a += t; }
        a2_last = __shfl(a, 63);
        tab_a[lane] = a; tab_d[lane] = dtv; tab_w[lane] = (_Float16)(dtv * __builtin_amdgcn_exp2f(a2_last - a));
        dec2 += a2_last;
    }
    if (cmode == 1) asm volatile("s_waitcnt vmcnt(0)" ::: "memory");
    LBAR();
    if (cmode == 0) {
        constexpr int BCB = FULL ? 53248 : 18432;
#pragma unroll
        for (int k = 0; k < (BCB / 16 + 511) / 512; ++k) { const int pc = tid + 512 * k;
            if (pc < BCB / 16) *(u4*)(cch + pc * 16) = *(const LAS u4*)(ldr + BT_OFF + pc * 16); }
    }
    if constexpr (FULL) {
        const float Dk = c.d_skip[head];
        u2 zc[4]; f4 nwv[4];
#pragma unroll
        for (int q = 0; q < 4; ++q) nwv[q] = *(const f4*)(c.ssm_norm_w + head * 64 + 32 * ph + 8 * q + 4 * h);
#pragma unroll
        for (int q = 0; q < 4; ++q) zc[q] = *(const u2*)(c.ZQ + (size_t)(row0 + l31) * 4096 + head * 64 + 32 * ph + 8 * q + 4 * h);
        u2 zn[4];
        if (!SAMPLE) {
#pragma unroll
            for (int q = 0; q < 4; ++q) zn[q] = *(const u2*)(c.ZQ + (size_t)(row0 + 32 + l31) * 4096 + head * 64 + 32 * ph + 8 * q + 4 * h);
        }
        if (w < 4 && w != 2) {
            const int jt = w >> 1, it = w & 1; f32x16 gacc;
#pragma unroll
            for (int r = 0; r < 16; ++r) gacc[r] = 0.f;
#pragma unroll
            for (int s = 0; s < 8; ++s) {
                const half8 a = *(const LAS half8*)(ldr + bs_addr(32 * jt + l31, 2 * s + h)), b = *(const LAS half8*)(ldr + cs_addr(32 * it + l31, 2 * s + h));
                gacc = MFMA16(a, b, gacc);
            }
            LAS f4* gt = (LAS f4*)(ldw + GT_OFF + (jt + it) * 4096);
#pragma unroll
            for (int q = 0; q < 4; ++q) gt[q * 64 + lane] = (f4){gacc[4 * q], gacc[4 * q + 1], gacc[4 * q + 2], gacc[4 * q + 3]};
        }
        LBAR();
        LAS float* tota = (LAS float*)(ldw + TOTA_OFF) + ci * 64; LAS float* rsv = (LAS float*)(ldw + RS_OFF);
#pragma unroll
        for (int it = 0; it < (SAMPLE ? 1 : 2); ++it) {
            const int i = 32 * it + l31; const float a2i = tab_a[i];
            f32x16 yd, yo;
#pragma unroll
            for (int r = 0; r < 16; ++r) { yd[r] = 0.f; yo[r] = 0.f; }
            const int p = 32 * ph + l31;
#pragma unroll 1
            for (int jt = 0; jt <= it; ++jt) {
                f32x16 m;
                const LAS f4* gt = (const LAS f4*)(ldr + GT_OFF + (jt + it) * 4096);
#pragma unroll
                for (int q = 0; q < 4; ++q) {
                    const f4 gv = gt[q * 64 + lane]; const int jb = 32 * jt + 8 * q + 4 * h;
                    const f4 aj = *(const LAS f4*)(tab_a + jb), dj = *(const LAS f4*)(tab_d + jb);
#pragma unroll
                    for (int e = 0; e < 4; ++e) { const float v = gv[e] * __builtin_amdgcn_exp2f(fminf(a2i - aj[e], 0.f)) * dj[e]; m[4 * q + e] = (jb + e <= i) ? v : 0.f; }
                    __builtin_amdgcn_sched_barrier(0);
                }
#pragma unroll
                for (int s = 0; s < 2; ++s) {
                    const half8 pa = ld2x8(ldr, xt_addr(hl, p, 4 * jt + 2 * s) + 8 * h, xt_addr(hl, p, 4 * jt + 2 * s + 1) + 8 * h);
                    yd = MFMA16(pa, pack_step(m, s), yd);
                    __builtin_amdgcn_sched_barrier(0);
                }
            }
#pragma unroll
            for (int nt = 0; nt < 4; ++nt)
#pragma unroll
                for (int s = 0; s < 2; ++s) {
                    const half8 pb = ld2x8(ldr, cs_addr(i, 4 * nt + 2 * s) + 8 * h, cs_addr(i, 4 * nt + 2 * s + 1) + 8 * h);
                    yo = MFMA16(pack_step(S[nt], s), pb, yo);
                    __builtin_amdgcn_sched_barrier(0);
                }
            const float sci = __builtin_amdgcn_exp2f(a2i);
            const unsigned short* zrow = c.ZQ + (size_t)(row0 + i) * 4096 + head * 64; unsigned short* yrow = c.YO + (size_t)(row0 + i) * 4096 + head * 64;
            float ss = 0.f;
#pragma unroll
            for (int q = 0; q < 4; ++q) {
                const int p0 = 32 * ph + 8 * q + 4 * h;
                const f4 zg = bf4(zc[q]);
#pragma unroll
                for (int e = 0; e < 4; ++e) { const int pp = p0 + e;
                    const float xv = (float)*(const LAS _Float16*)(ldr + xt_addr(hl, pp, i >> 3) + 2 * (i & 7));
                    float y = yd[4 * q + e] + sci * yo[4 * q + e] + Dk * xv; y *= zg[e]; yd[4 * q + e] = y; ss += y * y; }
                __builtin_amdgcn_sched_barrier(0);
            }
            ss += __shfl_xor(ss, 32);
            LAS float* red = (LAS float*)(ldw + RED_OFF + it * 2048);
            if (h == 0) red[w * 64 + i] = ss;
            LBAR();
            float tot = 0.f;
#pragma unroll
            for (int ww = 0; ww < 8; ++ww) tot += red[ww * 64 + i];
            float rs = 1.0f;
            if (hh == 0) { if (w == 0 && h == 0) tota[i] = tot; }
            else { tot += tota[i]; rs = __builtin_amdgcn_rsqf(tot * (1.0f / 512.0f) + EPS); if (w == 0 && h == 0) rsv[i] = rs; }
#pragma unroll
            for (int q = 0; q < 4; ++q) { const int p0 = 32 * ph + 8 * q + 4 * h; const f4 nw = nwv[q];
                u2 o; o.x = pg8::cvt_pk_bf16(yd[4 * q] * rs * nw[0], yd[4 * q + 1] * rs * nw[1]); o.y = pg8::cvt_pk_bf16(yd[4 * q + 2] * rs * nw[2], yd[4 * q + 3] * rs * nw[3]);
                *(u2*)(yrow + p0) = o; __builtin_amdgcn_sched_barrier(0); }
            if (!SAMPLE && it == 0) {
#pragma unroll
                for (int q = 0; q < 4; ++q) zc[q] = zn[q];
            }
        }
    }
    u4 fx[4]; unsigned short* fzp = c.YO + (size_t)(row0 + (tid >> 3)) * 4096 + g * 512 + (tid & 7) * 32;
    const bool dofix = FULL && hh == 1 && (tid >> 3) < nvalid;
    if (dofix) {
#pragma unroll
        for (int v = 0; v < 4; ++v) fx[v] = *(const u4*)(fzp + 8 * v);
    }
    {
        const float dk = __builtin_amdgcn_exp2f(a2_last);
#pragma unroll
        for (int t = 0; t < 4; ++t)
#pragma unroll
            for (int r = 0; r < 16; ++r) S[t][r] *= dk;
#pragma unroll 1
        for (int s = 0; s < 4; ++s) {
            const half8 w8 = *(const LAS half8*)(tab_w + 16 * s + 8 * h);
            const half8 xw = *(const LAS half8*)(ldr + xt_addr(hl, 32 * ph + l31, 2 * s + h)) * w8;
#pragma unroll
            for (int nt = 0; nt < 4; ++nt) S[nt] = MFMA16(*(const LAS half8*)(ldr + bt_addr(32 * nt + l31, 2 * s + h)), xw, S[nt]);
            __builtin_amdgcn_sched_barrier(0);
        }
    }
    LBAR();
    if (dofix) {
        const float rs = ((const LAS float*)(ldr + RS_OFF))[tid >> 3];
#pragma unroll
        for (int v = 0; v < 4; ++v) { const u4 x = fx[v]; u4 o;
            o.x = pg8::cvt_pk_bf16(__uint_as_float(x.x << 16) * rs, __uint_as_float(x.x & 0xffff0000u) * rs); o.y = pg8::cvt_pk_bf16(__uint_as_float(x.y << 16) * rs, __uint_as_float(x.y & 0xffff0000u) * rs);
            o.z = pg8::cvt_pk_bf16(__uint_as_float(x.z << 16) * rs, __uint_as_float(x.z & 0xffff0000u) * rs); o.w = pg8::cvt_pk_bf16(__uint_as_float(x.w << 16) * rs, __uint_as_float(x.w & 0xffff0000u) * rs);
            *(u4*)(fzp + 8 * v) = o; }
    }
}
__device__ __forceinline__ void state_store_native(float* dst, const f32x16 (&S)[4], int lane, int ph) {
#pragma unroll
    for (int nt = 0; nt < 4; ++nt)
#pragma unroll
        for (int q = 0; q < 4; ++q) *(f4*)(dst + ((size_t)((nt * 2 + ph) * 4 + q) * 64 + lane) * 4) = (f4){S[nt][4 * q], S[nt][4 * q + 1], S[nt][4 * q + 2], S[nt][4 * q + 3]};
}
__device__ __forceinline__ void state_load_native(const float* src, f32x16 (&S)[4], int lane, int ph) {
#pragma unroll
    for (int nt = 0; nt < 4; ++nt)
#pragma unroll
        for (int q = 0; q < 4; ++q) { const f4 v = *(const f4*)(src + ((size_t)((nt * 2 + ph) * 4 + q) * 64 + lane) * 4); S[nt][4 * q] = v[0]; S[nt][4 * q + 1] = v[1]; S[nt][4 * q + 2] = v[2]; S[nt][4 * q + 3] = v[3]; }
}
__device__ __forceinline__ void state_store_pn(float* dst, const f32x16 (&S)[4], int lane, int ph) {
    const int l31 = lane & 31, h = lane >> 5;
#pragma unroll
    for (int nt = 0; nt < 4; ++nt)
#pragma unroll
        for (int q = 0; q < 4; ++q) *(f4*)(dst + (size_t)(32 * ph + l31) * NST + 32 * nt + 8 * q + 4 * h) = (f4){S[nt][4 * q], S[nt][4 * q + 1], S[nt][4 * q + 2], S[nt][4 * q + 3]};
}
__device__ __forceinline__ void state_load_pn(const float* src, f32x16 (&S)[4], int lane, int ph) {
    const int l31 = lane & 31, h = lane >> 5;
#pragma unroll
    for (int nt = 0; nt < 4; ++nt)
#pragma unroll
        for (int q = 0; q < 4; ++q) { const f4 v = *(const f4*)(src + (size_t)(32 * ph + l31) * NST + 32 * nt + 8 * q + 4 * h); S[nt][4 * q] = v[0]; S[nt][4 * q + 1] = v[1]; S[nt][4 * q + 2] = v[2]; S[nt][4 * q + 3] = v[3]; }
}
__device__ __forceinline__ void pass1_unit(const Frame& F, const Ctx& c, int u, float* seg, float* segdec) {
    const int sg = u >> 2, g = u & 3, hl = F.wave >> 1, ph = F.wave & 1;
#pragma unroll 1
    for (int hh = 0; hh < 2; ++hh) {
        const int head = g * 8 + hh * 4 + hl;
        f32x16 S[4];
#pragma unroll
        for (int t = 0; t < 4; ++t)
#pragma unroll
            for (int r = 0; r < 16; ++r) S[t][r] = 0.f;
        float dec2 = 0.f;
#pragma unroll 1
        for (int ch = 0; ch < 4; ++ch) { const int row0 = sg * 256 + ch * 64; chunk<false, false>(F, c, g, hh, row0, 0, ch, S, dec2, hh, c.BCC + ((size_t)u * 4 + ch) * 53248); }
        state_store_native(seg + ((size_t)sg * NHS + head) * 8192, S, F.lane, ph);
        if (F.lane == 0 && ph == 0) segdec[sg * NHS + head] = __builtin_amdgcn_exp2f(dec2);
        __syncthreads();
    }
}
__device__ __forceinline__ void pass2_unit(const Frame& F, const Ctx& c, int u, const float* seg, const float* state_ssm, float* out) {
    const int g = u & 3, hl = F.wave >> 1, ph = F.wave & 1;
#pragma unroll 1
    for (int hh = 0; hh < 2; ++hh) {
        const int head = g * 8 + hh * 4 + hl;
        f32x16 S[4]; float dec2 = 0.f;
        if (u < 256) {
            const int sg = u >> 2;
            state_load_native(seg + ((size_t)sg * NHS + head) * 8192, S, F.lane, ph);
#pragma unroll 1
            for (int ch = 0; ch < 4; ++ch) { const int row0 = sg * 256 + ch * 64; chunk<true, false>(F, c, g, hh, row0, 0, ch, S, dec2, hh, c.BCC + ((size_t)u * 4 + ch) * 53248); }
            if (sg == 63) state_store_pn(out + O_PSSM + (size_t)head * PH * NST, S, F.lane, ph);
        } else {
            const int b = (u - 256) >> 2;
            state_load_pn(state_ssm + ((size_t)b * NHS + head) * PH * NST, S, F.lane, ph);
            chunk<true, true>(F, c, g, hh, TP + b * 32, b, 0, S, dec2);
            state_store_pn(out + O_SSSM + ((size_t)b * NHS + head) * PH * NST, S, F.lane, ph);
        }
        __syncthreads();
    }
}
__device__ __forceinline__ void combine(const Frame& F, float* seg, const float* segdec) {
    const int gid = blockIdx.x * 512 + F.tid;
    if (gid < 65536) {
        const int head = gid >> 11; f4 R = {0.f, 0.f, 0.f, 0.f};
        f4* p = (f4*)seg + gid;
#pragma unroll 8
        for (int s = 0; s < 64; ++s) { const f4 t = p[(size_t)s * 65536]; const float d = segdec[s * NHS + head]; p[(size_t)s * 65536] = R; R = R * d + t; }
    }
}
#undef MFMA16
#undef LBAR
}
namespace att {
using bf16x8 = __attribute__((ext_vector_type(8))) short;
using s16x4  = __attribute__((ext_vector_type(4))) short;
using f32x16 = __attribute__((ext_vector_type(16))) float;
using u32x4  = __attribute__((ext_vector_type(4))) unsigned;
constexpr int SHM_K = 17408, SHM_V = 16384, WREG = 17408;
constexpr int V_OFF = 0, K_OFF = 2 * SHM_V, TAB_OFF = 8 * WREG  , TAB_STRIDE = 1028  , LI_OFF = TAB_OFF + 16 * TAB_STRIDE  ;
#ifndef ATSEC
#define ATSEC -1
#endif
#define ATS(k) do { if (ATSEC == (k) && F.tid == 0) atst = __builtin_amdgcn_s_memrealtime(); } while (0)
#define ATE(k) do { if (ATSEC == (k) && F.tid == 0) { F.MISC[17] += (unsigned)(__builtin_amdgcn_s_memrealtime() - atst); } } while (0)
#define KSWZ(row, colB) ((row) * 272 + (colB))
#define SBAR() __builtin_amdgcn_sched_barrier(0)
__device__ __forceinline__ int crow(int r, int hi) { return (r & 3) + 8 * (r >> 2) + 4 * hi; }
__device__ __forceinline__ unsigned cvtpk(float lo, float hi) { unsigned r; asm volatile("v_cvt_pk_bf16_f32 %0, %1, %2" : "=v"(r) : "v"(lo), "v"(hi)); return r; }
__device__ __forceinline__ int v_st(int k, int c) { const int kk = (k & ~0xC) | ((k & 4) << 1) | ((k & 8) >> 1); return ((kk >> 3) * 4 + (c >> 5)) * 512 + ((kk & 7) * 32 + (c & 31)) * 2; }
__device__ __forceinline__ int v_rd_base(int lane) { return ((lane & 3) << 3) | (((lane >> 2) & 3) << 6) | (((lane >> 4) & 1) << 5) | (((lane >> 5) & 1) << 8); }
constexpr int v_rd_off(int d0, int ks, int half) { return d0 * 512 + ks * 4096 + half * 2048; }
template <int OFF> __device__ __forceinline__ s16x4 tr_read(int vb) { s16x4 r; asm volatile("ds_read_b64_tr_b16 %0, %1 offset:%2" : "=&v"(r) : "v"(vb), "i"(OFF) : "memory"); return r; }
__device__ __forceinline__ void qkt(f32x16& p0, f32x16& p1, const LAS unsigned char* Ks, const bf16x8* qr, int r32, int hi) {
#pragma unroll
    for (int r = 0; r < 16; ++r) { p0[r] = 0.f; p1[r] = 0.f; }
#pragma unroll
    for (int d0 = 0; d0 < 8; ++d0) { const int cb = (d0 * 16 + hi * 8) * 2;
        const bf16x8 b0 = *(const LAS bf16x8*)(Ks + KSWZ(r32, cb)), b1 = *(const LAS bf16x8*)(Ks + KSWZ(32 + r32, cb));
        p0 = __builtin_amdgcn_mfma_f32_32x32x16_bf16(b0, qr[d0], p0, 0, 0, 0);
        p1 = __builtin_amdgcn_mfma_f32_32x32x16_bf16(b1, qr[d0], p1, 0, 0, 0);
        if (d0 & 1) SBAR(); }
}
template <int D0> __device__ __forceinline__ void pv_one(f32x16& od, int vb, bf16x8 pa0, bf16x8 pa1, bf16x8 pa2, bf16x8 pa3) {
    const s16x4 l0 = tr_read<v_rd_off(D0, 0, 0)>(vb), h0 = tr_read<v_rd_off(D0, 0, 1)>(vb), l1 = tr_read<v_rd_off(D0, 1, 0)>(vb), h1 = tr_read<v_rd_off(D0, 1, 1)>(vb);
    const s16x4 l2 = tr_read<v_rd_off(D0, 2, 0)>(vb), h2 = tr_read<v_rd_off(D0, 2, 1)>(vb), l3 = tr_read<v_rd_off(D0, 3, 0)>(vb), h3 = tr_read<v_rd_off(D0, 3, 1)>(vb);
    asm volatile("s_waitcnt lgkmcnt(0)" ::: "memory"); SBAR();
#define PK(L, H) (bf16x8){L[0], L[1], L[2], L[3], H[0], H[1], H[2], H[3]}
    od = __builtin_amdgcn_mfma_f32_32x32x16_bf16(pa0, PK(l0, h0), od, 0, 0, 0);
    od = __builtin_amdgcn_mfma_f32_32x32x16_bf16(pa1, PK(l1, h1), od, 0, 0, 0);
    od = __builtin_amdgcn_mfma_f32_32x32x16_bf16(pa2, PK(l2, h2), od, 0, 0, 0);
    od = __builtin_amdgcn_mfma_f32_32x32x16_bf16(pa3, PK(l3, h3), od, 0, 0, 0);
#undef PK
}
__device__ __forceinline__ void pack_p(const f32x16& p0, const f32x16& p1, bf16x8& pa0, bf16x8& pa1, bf16x8& pa2, bf16x8& pa3) {
#define PK4(P, BASE, OUT) do { unsigned a0 = cvtpk(P[BASE + 0], P[BASE + 1]), a1 = cvtpk(P[BASE + 2], P[BASE + 3]);   \
    unsigned b0 = cvtpk(P[BASE + 4], P[BASE + 5]), b1 = cvtpk(P[BASE + 6], P[BASE + 7]);                              \
    auto r0 = __builtin_amdgcn_permlane32_swap(a0, b0, false, false); auto r1 = __builtin_amdgcn_permlane32_swap(a1, b1, false, false); \
    u32x4 w = {r0[0], r1[0], r0[1], r1[1]}; OUT = __builtin_bit_cast(bf16x8, w); } while (0)
    PK4(p0, 0, pa0); PK4(p0, 8, pa1); PK4(p1, 0, pa2); PK4(p1, 8, pa3);
#undef PK4
}

template <int KH, int D0> __device__ __forceinline__ void pv_half(f32x16& od, int vb, bf16x8 pa0, bf16x8 pa1) {
    const s16x4 l0 = tr_read<v_rd_off(D0, 2 * KH, 0)>(vb), h0 = tr_read<v_rd_off(D0, 2 * KH, 1)>(vb), l1 = tr_read<v_rd_off(D0, 2 * KH + 1, 0)>(vb), h1 = tr_read<v_rd_off(D0, 2 * KH + 1, 1)>(vb);
    asm volatile("s_waitcnt lgkmcnt(0)" ::: "memory"); SBAR();
    od = __builtin_amdgcn_mfma_f32_32x32x16_bf16(pa0, ((bf16x8){l0[0], l0[1], l0[2], l0[3], h0[0], h0[1], h0[2], h0[3]}), od, 0, 0, 0);
    od = __builtin_amdgcn_mfma_f32_32x32x16_bf16(pa1, ((bf16x8){l1[0], l1[1], l1[2], l1[3], h1[0], h1[1], h1[2], h1[3]}), od, 0, 0, 0);
}
template <int KH> __device__ __forceinline__ void half_tile(f32x16 (&o)[4], float& l_reg, const LAS unsigned char* Ks, int vb, const bf16x8* qr, const LAS float* tab, bool far_, float cfar, int base, int r32, int hi) {
    f32x16 p;
#pragma unroll
    for (int r = 0; r < 16; ++r) p[r] = 0.f;
#pragma unroll
    for (int d0 = 0; d0 < 8; ++d0) { const bf16x8 kf = *(const LAS bf16x8*)(Ks + KSWZ(32 * KH + r32, (d0 * 16 + hi * 8) * 2)); p = __builtin_amdgcn_mfma_f32_32x32x16_bf16(kf, qr[d0], p, 0, 0, 0); if ((d0 & 3) == 3) SBAR(); }
    float ps = 0.f;
    if (far_) {
#pragma unroll
        for (int r = 0; r < 16; ++r) { p[r] = __builtin_amdgcn_exp2f(p[r] + cfar); ps += p[r]; }
    } else {
#pragma unroll
        for (int r = 0; r < 16; ++r) { const int i0 = min(base - 32 * KH - crow(r, hi), 256); p[r] = __builtin_amdgcn_exp2f(p[r] + tab[i0]); ps += p[r]; }
    }
    l_reg += ps;
    bf16x8 pa0, pa1;
#define PK4(P, BASE, OUT) do { unsigned a0 = cvtpk(P[BASE + 0], P[BASE + 1]), a1 = cvtpk(P[BASE + 2], P[BASE + 3]);   \
    unsigned b0 = cvtpk(P[BASE + 4], P[BASE + 5]), b1 = cvtpk(P[BASE + 6], P[BASE + 7]);                              \
    auto r0 = __builtin_amdgcn_permlane32_swap(a0, b0, false, false); auto r1 = __builtin_amdgcn_permlane32_swap(a1, b1, false, false); \
    u32x4 w = {r0[0], r1[0], r0[1], r1[1]}; OUT = __builtin_bit_cast(bf16x8, w); } while (0)
    PK4(p, 0, pa0); PK4(p, 8, pa1);
#undef PK4
    pv_half<KH, 0>(o[0], vb, pa0, pa1); pv_half<KH, 1>(o[1], vb, pa0, pa1); pv_half<KH, 2>(o[2], vb, pa0, pa1); pv_half<KH, 3>(o[3], vb, pa0, pa1);
    SBAR();
}
struct Ctx { int abl; unsigned short* ZQ; unsigned short* O; const unsigned short* Kb; const unsigned short* Vb; const unsigned short* Gb; const float* rel_bias; const float* qw; const float* kw; };
__device__ __forceinline__ void load_bias_tabs(const Frame& F, const Ctx& c) {
    float mq = 0.f, mk = 0.f;
    for (int i = F.lane; i < 128; i += 64) { mq = fmaxf(mq, fabsf(c.qw[i])); mk = fmaxf(mk, fabsf(c.kw[i])); }
#pragma unroll
    for (int o = 1; o < 64; o <<= 1) { mq = fmaxf(mq, __shfl_xor(mq, o)); mk = fmaxf(mk, __shfl_xor(mk, o)); }
    for (int h = F.wave; h < NHA; h += NWAVES) {
        const float* rb = c.rel_bias + (size_t)h * 257; float v[5]; float mb = -1e30f;
#pragma unroll
        for (int t = 0; t < 5; ++t) { const int i = F.lane + 64 * t; v[t] = i < 257 ? rb[i] : -1e30f; mb = fmaxf(mb, v[t]); }
#pragma unroll
        for (int o = 1; o < 64; o <<= 1) mb = fmaxf(mb, __shfl_xor(mb, o));
        const float moff = 16.3222312f * mq * mk + mb * 1.4426950408889634f;
        LAS float* tab = (LAS float*)(F.lds + TAB_OFF + h * TAB_STRIDE);
#pragma unroll
        for (int t = 0; t < 5; ++t) { const int i = F.lane + 64 * t; if (i < 257) tab[i] = v[t] * 1.4426950408889634f - moff; }
    }
    __syncthreads();
}
template <int KH> __device__ __forceinline__ void half_tile_x(f32x16 (&o)[4], float& l_reg, const LAS unsigned char* Ks, int vb, const bf16x8* qr, const LAS float* tab, bool far_, float cfar, int base, int r32, int hi) {
    s16x4 vl[2][2], vh[2][2];
#define TRD(S, D0) vl[S][0] = tr_read<v_rd_off(D0, 2 * KH, 0)>(vb); vh[S][0] = tr_read<v_rd_off(D0, 2 * KH, 1)>(vb); vl[S][1] = tr_read<v_rd_off(D0, 2 * KH + 1, 0)>(vb); vh[S][1] = tr_read<v_rd_off(D0, 2 * KH + 1, 1)>(vb)
    TRD(0, 0); TRD(1, 1);
    f32x16 p;
#pragma unroll
    for (int r = 0; r < 16; ++r) p[r] = 0.f;
    int kb_[4];
#pragma unroll
    for (int m = 0; m < 4; ++m) kb_[m] = 256 * r32 + ((((2 * m + hi) ^ (r32 & 7))) << 4);
#pragma unroll
    for (int d0 = 0; d0 < 8; ++d0) { const bf16x8 kf = *(const LAS bf16x8*)(Ks + kb_[d0 & 3] + (d0 >> 2) * 128 + KH * 8192); p = __builtin_amdgcn_mfma_f32_32x32x16_bf16(kf, qr[d0], p, 0, 0, 0); }
    float ps = 0.f;
    if (far_) {
#pragma unroll
        for (int r = 0; r < 16; ++r) { p[r] = __builtin_amdgcn_exp2f(p[r] + cfar); ps += p[r]; }
    } else {
#pragma unroll
        for (int r = 0; r < 16; ++r) { const int i0 = min(base - 32 * KH - crow(r, hi), 256); p[r] = __builtin_amdgcn_exp2f(p[r] + tab[i0]); ps += p[r]; }
    }
    l_reg += ps;
    bf16x8 pa0, pa1;
#define PK4(P, BASE, OUT) do { unsigned a0 = cvtpk(P[BASE + 0], P[BASE + 1]), a1 = cvtpk(P[BASE + 2], P[BASE + 3]);   \
    unsigned b0 = cvtpk(P[BASE + 4], P[BASE + 5]), b1 = cvtpk(P[BASE + 6], P[BASE + 7]);                              \
    auto r0 = __builtin_amdgcn_permlane32_swap(a0, b0, false, false); auto r1 = __builtin_amdgcn_permlane32_swap(a1, b1, false, false); \
    u32x4 w = {r0[0], r1[0], r0[1], r1[1]}; OUT = __builtin_bit_cast(bf16x8, w); } while (0)
    PK4(p, 0, pa0); PK4(p, 8, pa1);
#undef PK4
#define PVS(S, D0) do { \
        o[D0] = __builtin_amdgcn_mfma_f32_32x32x16_bf16(pa0, ((bf16x8){vl[S][0][0], vl[S][0][1], vl[S][0][2], vl[S][0][3], vh[S][0][0], vh[S][0][1], vh[S][0][2], vh[S][0][3]}), o[D0], 0, 0, 0); \
        o[D0] = __builtin_amdgcn_mfma_f32_32x32x16_bf16(pa1, ((bf16x8){vl[S][1][0], vl[S][1][1], vl[S][1][2], vl[S][1][3], vh[S][1][0], vh[S][1][1], vh[S][1][2], vh[S][1][3]}), o[D0], 0, 0, 0); } while (0)
    asm volatile("s_waitcnt lgkmcnt(0)" ::: "memory"); SBAR();
    PVS(0, 0); PVS(1, 1);
    SBAR();
    TRD(0, 2); TRD(1, 3);
    asm volatile("s_waitcnt lgkmcnt(0)" ::: "memory"); SBAR();
    PVS(0, 2); PVS(1, 3);
#undef PVS
#undef TRD
    SBAR();
}
template <int OFF> __device__ __forceinline__ bf16x8 lds_rd16(int a) { bf16x8 r; asm volatile("ds_read_b128 %0, %1 offset:%2" : "=&v"(r) : "v"(a), "i"(OFF) : "memory"); return r; }
template <int N> __device__ __forceinline__ void lds_wait2(bf16x8& a, bf16x8& b) { asm volatile("s_waitcnt lgkmcnt(%2)" : "+v"(a), "+v"(b) : "n"(N) : "memory"); }
__device__ __forceinline__ void tile_qk(float& l_reg, bf16x8& pa0, bf16x8& pa1, bf16x8& pa2, bf16x8& pa3, const LAS unsigned char* Ks, const bf16x8* qr, const LAS float* tab, bool far_, float cfar, int base, int r32, int hi) {
    f32x16 p0, p1;
#pragma unroll
    for (int r = 0; r < 16; ++r) { p0[r] = 0.f; p1[r] = 0.f; }
    int kb_[4];
#pragma unroll
    for (int m = 0; m < 4; ++m) kb_[m] = 256 * r32 + ((((2 * m + hi) ^ (r32 & 7))) << 4);
    const int kA = (int)(unsigned)(size_t)Ks;
    int ka[8];
#pragma unroll
    for (int m = 0; m < 4; ++m) { ka[m] = kA + kb_[m] + ((r32 & 8) << 4); ka[4 + m] = ka[m] ^ 128; }
    bf16x8 kf[8][2];
#define KRD(D) do { kf[D][0] = lds_rd16<0>(ka[D]); kf[D][1] = lds_rd16<8192>(ka[D]); } while (0)
#define KMM(D, N) do { lds_wait2<N>(kf[D][0], kf[D][1]); p0 = __builtin_amdgcn_mfma_f32_32x32x16_bf16(kf[D][0], qr[D], p0, 0, 0, 0); p1 = __builtin_amdgcn_mfma_f32_32x32x16_bf16(kf[D][1], qr[D], p1, 0, 0, 0); } while (0)
    asm volatile("s_waitcnt lgkmcnt(0)" ::: "memory");
    KRD(0); KRD(1);
    KRD(2); KMM(0, 4); KRD(3); KMM(1, 4); KRD(4); KMM(2, 4); KRD(5); KMM(3, 4); KRD(6); KMM(4, 4); KRD(7); KMM(5, 4); KMM(6, 2); KMM(7, 0);
#undef KRD
#undef KMM
    SBAR();
    float ps0 = 0.f, ps1 = 0.f;
    if (far_) {
#pragma unroll
        for (int r = 0; r < 16; ++r) { p0[r] = __builtin_amdgcn_exp2f(p0[r] + cfar); p1[r] = __builtin_amdgcn_exp2f(p1[r] + cfar); ps0 += p0[r]; ps1 += p1[r]; }
    } else {
#pragma unroll
        for (int r = 0; r < 16; ++r) { const int kk = crow(r, hi); const int i0 = min(base - kk, 256), i1 = min(base - 32 - kk, 256);
            p0[r] = __builtin_amdgcn_exp2f(p0[r] + tab[i0]); p1[r] = __builtin_amdgcn_exp2f(p1[r] + tab[i1]); ps0 += p0[r]; ps1 += p1[r]; }
    }
    l_reg += ps0 + ps1;
    pack_p(p0, p1, pa0, pa1, pa2, pa3);
    SBAR();
}
__device__ __forceinline__ void tile_pv(f32x16 (&o)[4], int vb, bf16x8 pa0, bf16x8 pa1, bf16x8 pa2, bf16x8 pa3) {
    s16x4 vla[4], vha[4], vlb[4], vhb[4];
#define TRD(VL, VH, D0) VL[0] = tr_read<v_rd_off(D0, 0, 0)>(vb); VH[0] = tr_read<v_rd_off(D0, 0, 1)>(vb); VL[1] = tr_read<v_rd_off(D0, 1, 0)>(vb); VH[1] = tr_read<v_rd_off(D0, 1, 1)>(vb); \
                VL[2] = tr_read<v_rd_off(D0, 2, 0)>(vb); VH[2] = tr_read<v_rd_off(D0, 2, 1)>(vb); VL[3] = tr_read<v_rd_off(D0, 3, 0)>(vb); VH[3] = tr_read<v_rd_off(D0, 3, 1)>(vb)
#define PVD(VL, VH, D0) do { \
        o[D0] = __builtin_amdgcn_mfma_f32_32x32x16_bf16(pa0, ((bf16x8){VL[0][0], VL[0][1], VL[0][2], VL[0][3], VH[0][0], VH[0][1], VH[0][2], VH[0][3]}), o[D0], 0, 0, 0); \
        o[D0] = __builtin_amdgcn_mfma_f32_32x32x16_bf16(pa1, ((bf16x8){VL[1][0], VL[1][1], VL[1][2], VL[1][3], VH[1][0], VH[1][1], VH[1][2], VH[1][3]}), o[D0], 0, 0, 0); \
        o[D0] = __builtin_amdgcn_mfma_f32_32x32x16_bf16(pa2, ((bf16x8){VL[2][0], VL[2][1], VL[2][2], VL[2][3], VH[2][0], VH[2][1], VH[2][2], VH[2][3]}), o[D0], 0, 0, 0); \
        o[D0] = __builtin_amdgcn_mfma_f32_32x32x16_bf16(pa3, ((bf16x8){VL[3][0], VL[3][1], VL[3][2], VL[3][3], VH[3][0], VH[3][1], VH[3][2], VH[3][3]}), o[D0], 0, 0, 0); } while (0)
    asm volatile("s_waitcnt lgkmcnt(0)" ::: "memory");
    TRD(vla, vha, 0); TRD(vlb, vhb, 1); asm volatile("s_waitcnt lgkmcnt(8)" ::: "memory"); SBAR();
    PVD(vla, vha, 0); SBAR(); TRD(vla, vha, 2); asm volatile("s_waitcnt lgkmcnt(8)" ::: "memory"); SBAR();
    PVD(vlb, vhb, 1); SBAR(); TRD(vlb, vhb, 3); asm volatile("s_waitcnt lgkmcnt(8)" ::: "memory"); SBAR();
    PVD(vla, vha, 2); SBAR(); asm volatile("s_waitcnt lgkmcnt(0)" ::: "memory"); SBAR();
    PVD(vlb, vhb, 3);
#undef PVD
#undef TRD
    SBAR();
}
constexpr int PF_DUMP_OFF = 131072;
__device__ __forceinline__ void prompt_unit(const Frame& F, const Ctx& c, int h, int cq, const float* pfk, const float* pfv, int pfb0, int pfh0, int pfb1, int pfh1, int pft0, int pfn) {
    const LAS unsigned char* ldr = F.lds; LAS unsigned char* ldw = F.lds;
    int pz_; asm volatile("v_mov_b32 %0, 0" : "=v"(pz_));
    const int wid = F.wave, lane = lane_now() + pz_, tid = wid * 64 + lane, pw = wid >> 1;
    const LAS float* tab = (const LAS float*)(ldr + TAB_OFF + h * TAB_STRIDE);
    unsigned long long atst = 0; (void)atst; ATS(0); ATS(7);
    f32x16 o[4]; float l_reg = 0.f; bf16x8 qr[8];
#pragma unroll
    for (int d = 0; d < 4; ++d)
#pragma unroll
        for (int r = 0; r < 16; ++r) o[d][r] = 0.f;
    {
        const unsigned short* Qw = c.ZQ + (size_t)(cq * 256 + wid * 32 + (lane & 31)) * 4096 + 2048 + h * HD + (lane >> 5) * 8;
#pragma unroll
        for (int d0 = 0; d0 < 8; ++d0) qr[d0] = *(const bf16x8*)(Qw + d0 * 16);
#pragma unroll
        for (int d0 = 0; d0 < 8; ++d0) asm volatile("" : "+v"(qr[d0]));
    }
    asm volatile("s_waitcnt vmcnt(0)" ::: "memory");
    ATE(0);
    const int jstart = cq < 2 ? 8 - 4 * cq : 0;
    const unsigned short* Kh = c.Kb + h * HD; const unsigned short* Vh = c.Vb + h * HD;
#define DMA_TILE(j) do { const size_t t0 = (size_t)((4 * ((c.abl & 8) ? 2 : cq) - 8 + (j)) * 64) * 2048; const int sl = ((j) & 3) * 32768; \
    int dz_; asm volatile("v_mov_b32 %0, 0" : "=v"(dz_)); const int ld_ = lane + dz_; \
    _Pragma("unroll") for (int i = 0; i < 2; ++i) { const int pc = 2 * wid + i; \
        const int r = 4 * pc + (ld_ >> 4), chp = ld_ & 15; const unsigned ksrc = (unsigned)(r * 2048 + ((chp ^ (r & 15)) << 3)); \
        const int st = 2 * pc + (ld_ >> 5), kk = 8 * (st >> 2) + ((ld_ & 31) >> 2), k = (kk & ~0xC) | ((kk & 4) << 1) | ((kk & 8) >> 1), cc = 32 * (st & 3) + 8 * (ld_ & 3); \
        const unsigned vsrc = (unsigned)(k * 2048 + cc); \
        __builtin_amdgcn_global_load_lds((const unsigned*)(Kh + t0 + ksrc), (LAS unsigned*)(ldw + sl + pc * 1024), 16, 0, 0); \
        __builtin_amdgcn_global_load_lds((const unsigned*)(Vh + t0 + vsrc), (LAS unsigned*)(ldw + sl + 16384 + pc * 1024), 16, 0, 0); } } while (0)
    DMA_TILE(jstart); DMA_TILE(jstart + 1);
    bf16x8 pa0, pa1, pa2, pa3; bool pend = false; int vbp = 0; bool pfprev = false;
    const bool lag = wid >= 4;
#pragma unroll 1
    for (int j = jstart; j < 12; ++j) {
        ATS(1);
        if (j == 11) asm volatile("s_waitcnt vmcnt(0)" ::: "memory"); else if (pfprev) asm volatile("s_waitcnt vmcnt(5)" ::: "memory"); else asm volatile("s_waitcnt vmcnt(4)" ::: "memory");
        __builtin_amdgcn_s_barrier(); asm volatile("" ::: "memory");
        ATE(1); ATS(2);
        pfprev = false;
        if (j + 2 < 12) {
            const int tt = j - jstart;
            if (tt < pfn) {
                const int t = pft0 + tt, un = t >> 3, rg = (t & 7) >> 1, kv = t & 1;
                int pz2_; asm volatile("v_mov_b32 %0, 0" : "=v"(pz2_)); const int lp = lane + pz2_;
                const int pb = un ? pfb1 : pfb0, phd = un ? pfh1 : pfh0;
                const size_t off = (((size_t)pb * 512 + wid * 64 + 16 * rg + (lp >> 2)) * NHA + phd) * HD + (lp & 3) * 32;
                const float* pbase = pfk; if (kv) pbase = pfv;
                __builtin_amdgcn_global_load_lds((const unsigned*)(pbase + off), (LAS unsigned*)(ldw + PF_DUMP_OFF + wid * 256), 4, 0, 0);
                pfprev = true;
            }
            DMA_TILE(j + 2);
        }
        ATE(2);
        if (lag && pend) { if (!(c.abl & 1)) tile_pv(o, vbp, pa0, pa1, pa2, pa3); pend = false; }
        const int dl = pw + 8 - j;
        if (dl >= 0 && dl <= 8 && !(c.abl & 4)) {
            int lz_; asm volatile("v_mov_b32 %0, 0" : "=v"(lz_)); const int lz = lane + lz_, r32z = lz & 31, hiz = lz >> 5;
            const int sl = (j & 3) * 32768;
            const int vb = (int)(unsigned)(size_t)(F.lds) + sl + 16384 + v_rd_base(lz); const int base = 128 + 64 * dl + 32 * (wid & 1) + r32z;
            const float cfar = tab[256];
            ATS(3);
            if (!(c.abl & 2)) tile_qk(l_reg, pa0, pa1, pa2, pa3, ldr + sl, qr, tab, dl >= 3, cfar, base, r32z, hiz);
            ATE(3); ATS(4);
            if (lag) { pend = true; vbp = vb; } else if (!(c.abl & 1)) tile_pv(o, vb, pa0, pa1, pa2, pa3);
            ATE(4);
        }
    }
    if (lag && pend && !(c.abl & 1)) tile_pv(o, vbp, pa0, pa1, pa2, pa3);
#undef DMA_TILE
    ATS(5);
    const size_t rowbase = (size_t)(cq * 256 + wid * 32); const int rr0 = lane >> 4, cg = (lane & 15) * 8;
    u32x4 gv[8];
#pragma unroll
    for (int i = 0; i < 8; ++i) gv[i] = *(const u32x4*)(c.Gb + (rowbase + rr0 + 4 * i) * 2048 + h * HD + cg);
    __builtin_amdgcn_s_barrier(); asm volatile("" ::: "memory");
    ATE(5); ATS(6);
    const int r32 = lane & 31, hi = lane >> 5;
    { auto rr = __builtin_amdgcn_permlane32_swap(__float_as_uint(l_reg), __float_as_uint(l_reg), false, false); l_reg = __uint_as_float(rr[0]) + __uint_as_float(rr[1]); }
    LAS float* li = (LAS float*)(ldw + LI_OFF) + wid * 32;
    if (hi == 0) li[r32] = l_reg;
    asm volatile("s_waitcnt lgkmcnt(0)" ::: "memory");
    LAS float* po = (LAS float*)(ldw + wid * 16384);
#pragma unroll
    for (int r = 0; r < 16; ++r) { const int orow = crow(r, hi); const float rl = __builtin_amdgcn_rcpf(li[orow]);
#pragma unroll
        for (int d0 = 0; d0 < 4; ++d0) po[orow * 128 + d0 * 32 + r32] = o[d0][r] * rl; }
    asm volatile("s_waitcnt lgkmcnt(0)" ::: "memory");
    {
        typedef float fv4_ __attribute__((ext_vector_type(4)));
#pragma unroll
        for (int i = 0; i < 8; ++i) { const int row = rr0 + 4 * i;
            const fv4_ x = *(const LAS fv4_*)(po + row * 128 + cg), y = *(const LAS fv4_*)(po + row * 128 + cg + 4);
            u32x4 ov; ov.x = cvtpk(x[0] * __uint_as_float(gv[i].x << 16), x[1] * __uint_as_float(gv[i].x & 0xffff0000u)); ov.y = cvtpk(x[2] * __uint_as_float(gv[i].y << 16), x[3] * __uint_as_float(gv[i].y & 0xffff0000u));
            ov.z = cvtpk(y[0] * __uint_as_float(gv[i].z << 16), y[1] * __uint_as_float(gv[i].z & 0xffff0000u)); ov.w = cvtpk(y[2] * __uint_as_float(gv[i].w << 16), y[3] * __uint_as_float(gv[i].w & 0xffff0000u));
            *(u32x4*)(c.O + (rowbase + row) * 4096 + 2048 + h * HD + cg) = ov; }
    }
    ATE(6); ATE(7);
    asm volatile("s_waitcnt lgkmcnt(0)" ::: "memory"); __builtin_amdgcn_s_barrier(); asm volatile("" ::: "memory");
}
typedef float fv4 __attribute__((ext_vector_type(4)));
struct SCtx { unsigned short* ZQ; unsigned short* O; const unsigned short* Kb; const unsigned short* Vb; const unsigned short* Gb; const float* cache_k; const float* cache_v; };
__device__ __forceinline__ bf16x8 cvt8(const fv4 a, const fv4 b) { u32x4 w = {cvtpk(a.x, a.y), cvtpk(a.z, a.w), cvtpk(b.x, b.y), cvtpk(b.z, b.w)}; return __builtin_bit_cast(bf16x8, w); }
__device__ __forceinline__ void sample_unit(const Frame& F, const SCtx& c, int b, int h) {
    const LAS unsigned char* ldr = F.lds; LAS unsigned char* ldw = F.lds;
    int lz_; asm volatile("v_mov_b32 %0, 0" : "=v"(lz_));
    const int wid = F.wave, lane = lane_now() + lz_, tid = wid * 64 + lane, r32 = lane & 31, hi = lane >> 5, srow = lane >> 4, sch = lane & 15;
    const LAS float* tab = (const LAS float*)(ldr + TAB_OFF + h * TAB_STRIDE);
    const int kreg = wid * WREG, vreg = wid * WREG + 8704;
    const int vb = (int)(unsigned)(size_t)(F.lds + vreg) + v_rd_base(lane);
    f32x16 o[4]; float l_reg = 0.f; bf16x8 qr[8];
    fv4 ka[8][2], va[8][2];
#define LDG(DST, SRC, KB) do { const float* p_ = (SRC) + (((size_t)b * 512 + (KB) * 32 + srow) * NHA + h) * HD + sch * 8; \
        _Pragma("unroll") for (int k = 0; k < 8; ++k) { const size_t ro = (size_t)(4 * k) * (NHA * HD); DST[k][0] = *(const fv4*)(p_ + ro); DST[k][1] = *(const fv4*)(p_ + ro + 4); } } while (0)
#define STK() do { _Pragma("unroll") for (int k = 0; k < 8; ++k) *(LAS bf16x8*)(ldw + kreg + KSWZ(4 * k + srow, sch * 16)) = cvt8(ka[k][0], ka[k][1]); } while (0)
#define STV() do { _Pragma("unroll") for (int k = 0; k < 8; ++k) *(LAS bf16x8*)(ldw + vreg + v_st(4 * k + srow, sch * 8)) = cvt8(va[k][0], va[k][1]); } while (0)
#define PK4(P, BASE, OUT) do { unsigned a0 = cvtpk(P[BASE + 0], P[BASE + 1]), a1 = cvtpk(P[BASE + 2], P[BASE + 3]);   \
    unsigned b0 = cvtpk(P[BASE + 4], P[BASE + 5]), b1 = cvtpk(P[BASE + 6], P[BASE + 7]);                              \
    auto r0 = __builtin_amdgcn_permlane32_swap(a0, b0, false, false); auto r1 = __builtin_amdgcn_permlane32_swap(a1, b1, false, false); \
    u32x4 w = {r0[0], r1[0], r0[1], r1[1]}; OUT = __builtin_bit_cast(bf16x8, w); } while (0)
    bf16x8 pa0, pa1;
    const int kfa = (int)(unsigned)(size_t)(F.lds) + kreg + r32 * 272 + hi * 16;
#define KW(D, N) asm volatile("s_waitcnt lgkmcnt(%1)" : "+v"(kq[D]) : "n"(N) : "memory")
#define QKS(KB) do { asm volatile("s_waitcnt lgkmcnt(0)" ::: "memory"); f32x16 p0; \
        const int base = r32 + 640 - 32 * (KB);                         \
        _Pragma("unroll") for (int r = 0; r < 16; ++r) p0[r] = 0.f; \
        bf16x8 kq[8]; \
        kq[0] = lds_rd16<0>(kfa); kq[1] = lds_rd16<32>(kfa); kq[2] = lds_rd16<64>(kfa); \
        kq[3] = lds_rd16<96>(kfa);  KW(0, 3); p0 = __builtin_amdgcn_mfma_f32_32x32x16_bf16(kq[0], qr[0], p0, 0, 0, 0); \
        kq[4] = lds_rd16<128>(kfa); KW(1, 3); p0 = __builtin_amdgcn_mfma_f32_32x32x16_bf16(kq[1], qr[1], p0, 0, 0, 0); \
        kq[5] = lds_rd16<160>(kfa); KW(2, 3); p0 = __builtin_amdgcn_mfma_f32_32x32x16_bf16(kq[2], qr[2], p0, 0, 0, 0); \
        kq[6] = lds_rd16<192>(kfa); KW(3, 3); p0 = __builtin_amdgcn_mfma_f32_32x32x16_bf16(kq[3], qr[3], p0, 0, 0, 0); \
        kq[7] = lds_rd16<224>(kfa); KW(4, 3); p0 = __builtin_amdgcn_mfma_f32_32x32x16_bf16(kq[4], qr[4], p0, 0, 0, 0); \
        KW(5, 2); p0 = __builtin_amdgcn_mfma_f32_32x32x16_bf16(kq[5], qr[5], p0, 0, 0, 0); \
        KW(6, 1); p0 = __builtin_amdgcn_mfma_f32_32x32x16_bf16(kq[6], qr[6], p0, 0, 0, 0); \
        KW(7, 0); p0 = __builtin_amdgcn_mfma_f32_32x32x16_bf16(kq[7], qr[7], p0, 0, 0, 0); \
        SBAR(); \
        float tv[16];                                                   \
        _Pragma("unroll") for (int r = 0; r < 16; ++r) tv[r] = tab[min(base - crow(r, hi), 256)]; \
        SBAR(); \
        float ps = 0.f; \
        _Pragma("unroll") for (int r = 0; r < 16; ++r) { p0[r] = __builtin_amdgcn_exp2f(p0[r] + tv[r]); ps += p0[r]; } \
        l_reg += ps; PK4(p0, 0, pa0); PK4(p0, 8, pa1); } while (0)
#define TR4(L0, H0, L1, H1, D0) L0 = tr_read<v_rd_off(D0, 0, 0)>(vb); H0 = tr_read<v_rd_off(D0, 0, 1)>(vb); L1 = tr_read<v_rd_off(D0, 1, 0)>(vb); H1 = tr_read<v_rd_off(D0, 1, 1)>(vb)
#define PV2(L0, H0, L1, H1, D0, CIN) do { \
    o[D0] = __builtin_amdgcn_mfma_f32_32x32x16_bf16(pa0, ((bf16x8){L0[0], L0[1], L0[2], L0[3], H0[0], H0[1], H0[2], H0[3]}), CIN, 0, 0, 0); \
    o[D0] = __builtin_amdgcn_mfma_f32_32x32x16_bf16(pa1, ((bf16x8){L1[0], L1[1], L1[2], L1[3], H1[0], H1[1], H1[2], H1[3]}), o[D0], 0, 0, 0); } while (0)
#define PVSEQ(C0, C1, C2, C3) do { s16x4 al0, ah0, al1, ah1, bl0, bh0, bl1, bh1; asm volatile("s_waitcnt lgkmcnt(0)" ::: "memory"); \
    TR4(al0, ah0, al1, ah1, 0); TR4(bl0, bh0, bl1, bh1, 1); asm volatile("s_waitcnt lgkmcnt(4)" ::: "memory"); SBAR(); \
    PV2(al0, ah0, al1, ah1, 0, C0); SBAR(); TR4(al0, ah0, al1, ah1, 2); asm volatile("s_waitcnt lgkmcnt(4)" ::: "memory"); SBAR(); \
    PV2(bl0, bh0, bl1, bh1, 1, C1); SBAR(); TR4(bl0, bh0, bl1, bh1, 3); asm volatile("s_waitcnt lgkmcnt(4)" ::: "memory"); SBAR(); \
    PV2(al0, ah0, al1, ah1, 2, C2); SBAR(); asm volatile("s_waitcnt lgkmcnt(0)" ::: "memory"); SBAR(); \
    PV2(bl0, bh0, bl1, bh1, 3, C3); SBAR(); } while (0)
#define PVS() PVSEQ(o[0], o[1], o[2], o[3])
#define PVS0() do { const f32x16 z16 = {0.f, 0.f, 0.f, 0.f, 0.f, 0.f, 0.f, 0.f, 0.f, 0.f, 0.f, 0.f, 0.f, 0.f, 0.f, 0.f}; PVSEQ(z16, z16, z16, z16); } while (0)
#define LDQ() do { const unsigned short* Qw = c.ZQ + (size_t)(TP + b * 32 + r32) * 4096 + 2048 + h * HD + hi * 8; _Pragma("unroll") for (int d0 = 0; d0 < 8; ++d0) qr[d0] = *(const bf16x8*)(Qw + d0 * 16); } while (0)
    LDG(ka, c.cache_k, 2 * wid); LDG(va, c.cache_v, 2 * wid); LDQ();
    STK(); SBAR(); LDG(ka, c.cache_k, 2 * wid + 1); SBAR();
    QKS(2 * wid); SBAR();
    STV(); SBAR();
    PVS0();
    LDG(va, c.cache_v, 2 * wid + 1); SBAR();
    STK(); SBAR();
    LDQ(); SBAR();
    QKS(2 * wid + 1); SBAR();
    STV(); SBAR();
    PVS();
    if (wid == 0) {
        const unsigned short* kp = c.Kb + (size_t)(TP + b * 32 + srow) * 2048 + h * HD + sch * 8;
        const unsigned short* vp = c.Vb + (size_t)(TP + b * 32 + srow) * 2048 + h * HD + sch * 8;
        bf16x8 kn[8], vn[8];
#pragma unroll
        for (int k = 0; k < 8; ++k) kn[k] = *(const bf16x8*)(kp + (size_t)(4 * k) * 2048);
#pragma unroll
        for (int k = 0; k < 8; ++k) vn[k] = *(const bf16x8*)(vp + (size_t)(4 * k) * 2048);
#pragma unroll
        for (int k = 0; k < 8; ++k) *(LAS bf16x8*)(ldw + kreg + KSWZ(4 * k + srow, sch * 16)) = kn[k];
        SBAR();
        QKS(16); SBAR();
#pragma unroll
        for (int k = 0; k < 8; ++k) *(LAS bf16x8*)(ldw + vreg + v_st(4 * k + srow, sch * 8)) = vn[k];
        SBAR();
        PVS();
    }
#undef LDG
#undef LDQ
#undef STK
#undef STV
#undef PK4
#undef QKS
#undef KW
#undef TR4
#undef PV2
#undef PVSEQ
#undef PVS
#undef PVS0
    { auto rr = __builtin_amdgcn_permlane32_swap(__float_as_uint(l_reg), __float_as_uint(l_reg), false, false); l_reg = __uint_as_float(rr[0]) + __uint_as_float(rr[1]); }
    LAS float* po = (LAS float*)(ldw + wid * WREG);
#pragma unroll
    for (int d0 = 0; d0 < 4; ++d0)
#pragma unroll
        for (int r = 0; r < 16; ++r) po[crow(r, hi) * 128 + d0 * 32 + r32] = o[d0][r];
    LAS float* li = (LAS float*)(ldw + LI_OFF);
    if (hi == 0) li[wid * 32 + r32] = l_reg;
    __syncthreads();
    {
        int tz_; asm volatile("v_mov_b32 %0, 0" : "=v"(tz_)); const int tz = tid + tz_, q = tz >> 4, dg = (tz & 15) * 8;
        const size_t row = (size_t)(TP + b * 32 + q);
        const u32x4 gv = *(const u32x4*)(c.Gb + row * 2048 + h * HD + dg);
        float acc[8] = {0.f, 0.f, 0.f, 0.f, 0.f, 0.f, 0.f, 0.f}; float l = 0.f;
#pragma unroll
        for (int w = 0; w < 8; ++w) { const LAS fv4* pp = (const LAS fv4*)(ldr + w * WREG + (q * 128 + dg) * 4); const fv4 x = pp[0], y = pp[1];
            acc[0] += x.x; acc[1] += x.y; acc[2] += x.z; acc[3] += x.w; acc[4] += y.x; acc[5] += y.y; acc[6] += y.z; acc[7] += y.w; l += li[w * 32 + q]; }
        const float rl = __builtin_amdgcn_rcpf(l);
        const unsigned gw[4] = {gv.x, gv.y, gv.z, gv.w}; u32x4 ov; unsigned ow[4];
#pragma unroll
        for (int e = 0; e < 4; ++e) ow[e] = cvtpk(acc[2 * e] * rl * __uint_as_float(gw[e] << 16), acc[2 * e + 1] * rl * __uint_as_float(gw[e] & 0xffff0000u));
        ov.x = ow[0]; ov.y = ow[1]; ov.z = ow[2]; ov.w = ow[3];
        *(u32x4*)(c.O + row * 4096 + 2048 + h * HD + dg) = ov;
    }
    __syncthreads();
}
#undef KSWZ
#undef SBAR
}
struct Args { const float* in[18]; float* out; unsigned char* ws; };
__global__ void __launch_bounds__(NWAVES * 64, 2) hyb_fwd(Args args) {
    extern __shared__ __attribute__((aligned(16))) unsigned char lds[];
    Frame F;
    F.lds = (LAS unsigned char*)lds; F.MISC = (volatile LAS unsigned*)(F.lds + MISC_OFF);
    F.tid = threadIdx.x; F.lane = F.tid & 63; F.wave = __builtin_amdgcn_readfirstlane(F.tid >> 6);
    F.G = gridDim.x; { const int bx = blockIdx.x; F.vcu = (F.G % 8 == 0) ? (bx % 8) * (F.G / 8) + bx / 8 : bx; }
    F.ctl = (gu32*)(args.ws + WS_CTL);
    for (int u = F.tid; u < (LDS_BYTES - LDSCTL_OFF) / 4; u += NWAVES * 64) ((LAS unsigned*)(F.lds + LDSCTL_OFF))[u] = 0u;
    __syncthreads();
    XcdBarrier bar = xcd_barrier_post((unsigned*)(F.ctl + CW_BAR), F.MISC + 8);
    unsigned char* ws = args.ws;
#define OPQ() Frame Fp = F; { Fp.lane = lane_now(); Fp.tid = F.wave * 64 + Fp.lane; }
#define RUN_W() do { OPQ(); p0a_weights(Fp, args.in[7], args.in[17], args.in[6], (bf16*)(ws + WS_WIN), (bf16*)(ws + WS_WDT), (bf16*)(ws + WS_WOUT)); } while (0)
#define RUN_X() do { OPQ(); p0x_rows(Fp, args.in[0], args.in[1], args.in[7], args.in[6], args.in[10], (bf16*)(ws + WS_H), (float*)(ws + WS_RSTD), (float*)(ws + WS_DT)); } while (0)
#define RUN_INPROJ() do { OPQ(); pg8::Gemm g{(const bf16*)(ws + WS_H), (const bf16*)(ws + WS_WIN), MTOK, NIN, DM, DM}; pg8::StaticOrder S; S.init(MTOK, NIN, F.G, (int)blockIdx.x); \
        pg8::EpiIn E{(const float*)(ws + WS_RSTD), (bf16*)(ws + WS_ZQ), (bf16*)args.out, (bf16*)(ws + WS_K), (bf16*)(ws + WS_V), (bf16*)(ws + WS_G), args.in[14], args.in[15], args.out, (PG8_LAS float*)(F.lds + EPI_P_OFF)}; \
        pg8::gemm_phase<pg8::EpiIn, pg8::StaticOrder, true, true>(F.lds + RING_OFF, g, S, E, Fp.tid); } while (0)
#define SSD_CTX() ssd::Ctx sc{(const unsigned short*)args.out, (const float*)(ws + WS_DT), (bf16*)(ws + WS_ZQ), args.in[8], args.in[9], args.in[11], args.in[12], args.in[13], args.in[2], SSD_YO, ws + WS_WIN}; \
        float* seg = (float*)(ws + WS_SEG); float* segdec = (float*)(ws + WS_SEGDEC); (void)seg; (void)segdec
#define SSD_YO (bf16*)(ws + WS_ZQ)
#define ATT_O (bf16*)(ws + WS_ZQ)
#define DRY_O ((bf16*)args.out - 2048)
#define RUN_SSD1() do { OPQ(); SSD_CTX(); for (int u = blockIdx.x; u < 256; u += F.G) ssd::pass1_unit(Fp, sc, u, seg, segdec); } while (0)
#define RUN_COMB() do { OPQ(); SSD_CTX(); if (blockIdx.x < 128 || F.G != 256) ssd::combine(Fp, seg, segdec); \
        if (F.G == 256) { if (blockIdx.x >= 128) ssd::pass2_unit(Fp, sc, 128 + blockIdx.x, seg, args.in[3], args.out); } \
        else { for (int u = 256 + blockIdx.x; u < 384; u += F.G) ssd::pass2_unit(Fp, sc, u, seg, args.in[3], args.out); } } while (0)
#define RUN_SSD2() do { OPQ(); SSD_CTX(); for (int u = blockIdx.x; u < 256; u += F.G) ssd::pass2_unit(Fp, sc, u, seg, args.in[3], args.out); } while (0)
#ifndef SDUP
#define SDUP 1
#endif
#ifndef SDUPHOT
#define SDUPHOT 0
#endif
#ifndef SPF
#define SPF 0
#endif
#ifndef SPOSN
#define SPOSN 5
#endif
#define RUN_ATT() do { OPQ(); att::Ctx ac{0, (bf16*)(ws + WS_ZQ), ATT_O, (const bf16*)(ws + WS_K), (const bf16*)(ws + WS_V), (const bf16*)(ws + WS_G), args.in[16], args.in[14], args.in[15]}; att::load_bias_tabs(Fp, ac); \
        att::SCtx sx{(bf16*)(ws + WS_ZQ), ATT_O, (const bf16*)(ws + WS_K), (const bf16*)(ws + WS_V), (const bf16*)(ws + WS_G), args.in[4], args.in[5]}; att::SCtx sxd = sx; sxd.O = DRY_O; (void)sxd; \
        const int np_ = (1024 - F.vcu + F.G - 1) / F.G, pos_ = SPF ? 1 + (int)((blockIdx.x >> 3) % 4) * (np_ - 1) / 3 : (int)((blockIdx.x >> 3) % SPOSN) * np_ / (SPOSN - 1);     \
        _Pragma("unroll 1") for (int i = 0; i <= np_; ++i) { \
            if (i == pos_) { _Pragma("unroll 1") for (int u = blockIdx.x; u < 512 * SDUP; u += F.G) { const bool dry_ = SDUP > 1 && u < 512 * (SDUP - 1); const int b = (SDUPHOT && dry_) ? 0 : (u & 511) >> 4, h = u & 15; att::sample_unit(Fp, dry_ ? sxd : sx, b, h); } } \
            if (i < np_) { const int u = F.vcu + i * F.G; const int h = u >> 6, cq = u & 63; \
                const int us0 = (int)blockIdx.x, us1 = us0 + F.G < 512 ? us0 + F.G : us0; \
                const int pft0 = (pos_ - 1 - i) * 10, pfn = (SPF && i < pos_ && us0 < 512 && pft0 < 16) ? (16 - pft0 < 10 ? 16 - pft0 : 10) : 0; \
                att::prompt_unit(Fp, ac, h, cq, args.in[4], args.in[5], us0 >> 4, us0 & 15, us1 >> 4, us1 & 15, pft0, pfn); } } } while (0)
#define RUN_OUT() do { OPQ(); pg8::Gemm g{(const bf16*)(ws + WS_ZQ), (const bf16*)(ws + WS_WOUT), MTOK, DM, 4096, 4096}; pg8::StaticOrder S; S.init(MTOK, DM, F.G, (int)blockIdx.x, F.G == 256 ? 512 : -1); \
        pg8::EpiOut E{args.in[0], args.in[1], args.out}; \
        pg8::gemm_phase<pg8::EpiOut, pg8::StaticOrder, true, true>(F.lds + RING_OFF, g, S, E, Fp.tid); \
        if (F.G == 256) { const int t = blockIdx.x >> 3, ks = blockIdx.x & 7; pg8::OneUnit S1; S.map(512 + t, S1.u); \
            pg8::Gemm g1{(const bf16*)(ws + WS_ZQ) + ks * 512, (const bf16*)(ws + WS_WOUT) + ks * 512, MTOK, DM, 512, 4096}; \
            pg8::EpiSlab E1{(float*)(ws + WS_H) + (size_t)blockIdx.x * 65536}; \
            pg8::gemm_phase<pg8::EpiSlab, pg8::OneUnit, true, true>(F.lds + RING_OFF, g1, S1, E1, Fp.tid); } } while (0)
#define RUN_OUTRED() do { OPQ(); if (F.G == 256) { pg8::StaticOrder S; S.init(MTOK, DM, F.G, 0); pg8::Unit u; const int t = blockIdx.x >> 3, part = blockIdx.x & 7; S.map(512 + t, u); \
        const float* slab = (const float*)(ws + WS_H) + (size_t)(t * 8) * 65536; const int r0 = u.pm * 256 + part * 32; \
        typedef float f4_ __attribute__((ext_vector_type(4))); \
        f4_ a[4]; \
        _Pragma("unroll") for (int i = 0; i < 4; ++i) { const int e = Fp.tid + 512 * i, rr = e >> 6, c4 = (e & 63) * 4, row = r0 + rr, col = u.pn * 256 + c4; \
            a[i] = row < TP ? *(const f4_*)(args.in[0] + (size_t)row * DM + col) : *(const f4_*)(args.in[1] + (size_t)(row - TP) * DM + col); } \
        _Pragma("unroll") for (int s = 0; s < 8; ++s) { f4_ v[4]; \
            _Pragma("unroll") for (int i = 0; i < 4; ++i) { const int e = Fp.tid + 512 * i, rr = e >> 6, c4 = (e & 63) * 4; v[i] = *(const f4_*)(slab + (size_t)s * 65536 + (part * 32 + rr) * 256 + c4); } \
            _Pragma("unroll") for (int i = 0; i < 4; ++i) a[i] += v[i]; } \
        _Pragma("unroll") for (int i = 0; i < 4; ++i) { const int e = Fp.tid + 512 * i, rr = e >> 6, c4 = (e & 63) * 4, row = r0 + rr, col = u.pn * 256 + c4; *(f4_*)(args.out + (size_t)row * DM + col) = a[i]; } } } while (0)
#define BAR() xcd_barrier(bar)
#ifndef PHASE_PROGRAM
#define PHASE_PROGRAM RUN_W(); RUN_X(); BAR(); RUN_INPROJ(); BAR(); RUN_SSD1(); BAR(); RUN_COMB(); BAR(); RUN_SSD2(); RUN_ATT(); BAR(); RUN_OUT(); BAR(); RUN_OUTRED();
#endif
    PHASE_PROGRAM
}
extern "C" void kernel_launch(void* const* d_in, const int* in_sizes, int n_in, void* d_out, int out_size, void* d_ws, size_t ws_size, hipStream_t stream) {
    static int grid = 0;
    if (grid == 0) {
        if (n_in != 18 || in_sizes[0] != TP * DM || (size_t)out_size != O_END || ws_size < WS_END) { fprintf(stderr, "kernel_launch: shape mismatch n_in %d in0 %d out %d ws %zu (need %zu)\n", n_in, n_in > 0 ? in_sizes[0] : -1, out_size, ws_size, (size_t)WS_END); grid = -1; return; }
        int dev = 0, cus = 0;
        if (hipGetDevice(&dev) != hipSuccess || hipDeviceGetAttribute(&cus, hipDeviceAttributeMultiprocessorCount, dev) != hipSuccess) { grid = -1; return; }
        if (hipFuncSetAttribute((const void*)hyb_fwd, hipFuncAttributeMaxDynamicSharedMemorySize, LDS_BYTES) != hipSuccess) { fprintf(stderr, "kernel_launch: hipFuncSetAttribute failed\n"); grid = -1; return; }
        (void)hipGetLastError();
        grid = cus;
    }
    if (grid < 0) return;
    if (hipMemsetAsync((char*)d_ws + WS_CTL, 0, CTL_ZERO_BYTES, stream) != hipSuccess) return;
    Args a{};
    for (int i = 0; i < 18; ++i) a.in[i] = (const float*)d_in[i];
    a.out = (float*)d_out; a.ws = (unsigned char*)d_ws;
    hipLaunchKernelGGL(hyb_fwd, dim3(grid), dim3(NWAVES * 64), LDS_BYTES, stream, a);
}
```

```cpp
#include <hip/hip_runtime.h>
#include <cstdio>
#include <cstdint>
constexpr int TP = 16384, TS = 1024, MTOK = TP + TS;
constexpr int XLD = 4096;
constexpr int DM = 2048, DSSM = 2048, DATT = 2048, CONVD = 3072, NHS = 32, NHA = 16, HD = 128, PH = 64, NST = 128;
constexpr int NIN = 13312;
constexpr int SRC_LD = 13344;
constexpr float EPS = 1e-6f;
constexpr size_t O_YP = 0, O_YS = 33554432, O_PCONV = 35651584, O_PSSM = 35660800, O_PK = 35922944, O_PV = 36971520, O_SCONV = 38020096, O_SSSM = 38315008, O_SK = 46703616, O_SV = 48800768, O_END = 50897920;
constexpr size_t MiB = 1u << 20;
constexpr size_t WS_CTL = 0, CTL_ZERO_BYTES = 32 * 1024;
constexpr size_t WS_H = 1 * MiB;
constexpr size_t WS_WIN = WS_H + 68 * MiB;
constexpr size_t WS_WDT = WS_WIN + 52 * MiB;
constexpr size_t WS_WOUT = WS_WDT + 1 * MiB;
constexpr size_t WS_ZQ = WS_WOUT + 16 * MiB;
constexpr size_t WS_K = WS_ZQ + 136 * MiB;
constexpr size_t WS_V = WS_K + 68 * MiB;
constexpr size_t WS_G = WS_V + 68 * MiB;
constexpr size_t WS_DT = WS_G + 68 * MiB;
constexpr size_t WS_RSTD = WS_DT + 3 * MiB;
constexpr size_t WS_END = WS_RSTD + 1 * MiB;
constexpr size_t WS_SEG = WS_H;
constexpr size_t WS_SEGDEC = WS_RSTD + 512 * 1024;
constexpr int CW_TMO = 0, CW_CODE = 1, CW_BAR = 4096;
constexpr int RING_OFF = 0, RING_BYTES = 131072;
constexpr int LDSCTL_OFF = 157696, MISC_OFF = LDSCTL_OFF + 320;
constexpr int EPI_P_OFF = 131072;
constexpr int LDS_BYTES = 160 * 1024;
constexpr int NWAVES = 8;
namespace pg8 {
#define PG8_LAS __attribute__((address_space(3)))
typedef unsigned short bf16_t;
typedef short bf16x8 __attribute__((ext_vector_type(8)));
typedef float f32x4 __attribute__((ext_vector_type(4)));
typedef unsigned u32x4 __attribute__((ext_vector_type(4)));
constexpr int BM = 256, BK = 64, HALF = 128, HTB = HALF * BK * 2  , STAGE_BYTES = 8 * HTB, NXCD = 8, WGM = 4;

__host__ __device__ __forceinline__ int lds_byte(int r, int c) { const int st = (r >> 4) * 2 + (c >> 5), rr = r & 15, cc = c & 31, ob = rr * 64 + cc * 2; return st * 1024 + (ob ^ (((ob >> 9) & 1) << 5)); }
__host__ __device__ __forceinline__ void stage_rc(int b, int& R, int& C) { const int st = b / 1024, sb = b % 1024, swz = sb ^ (((sb >> 9) & 1) << 5); R = (st >> 1) * 16 + swz / 64; C = (st & 1) * 32 + (swz % 64) / 2; }
__host__ __device__ __forceinline__ int perm32(int rho) { const int n = rho >> 4, i = rho & 15; return 8 * (i >> 2) + 4 * n + (i & 3); }

struct Unit { int pm, pn; };
struct Gemm { const bf16_t* A; const bf16_t* Bt; int M, N, K, ld; };

struct StaticOrder {
    int nM, nN, nwg, G, c;
    __host__ __device__ __forceinline__ void init(int M, int N, int G_, int c_, int lim_ = -1) { nM = M / BM; nN = N / BM; nwg = nM * nN; G = G_; c = c_; lim = lim_ < 0 ? nwg : lim_; }
    int lim;
    __host__ __device__ __forceinline__ bool next(int i, Unit& u) const { const long L = (long)i * G + c; if (L >= lim) return false; map((int)L, u); return true; }
    __host__ __device__ __forceinline__ void map(int L, Unit& u) const {
        int wgid = L; { const int q = nwg / NXCD, r = nwg % NXCD, xcd = wgid % NXCD, off = wgid / NXCD; wgid = (xcd < r ? xcd * (q + 1) : r * (q + 1) + (xcd - r) * q) + off; }
        const int nig = WGM * nN, gid = wgid / nig, fm = gid * WGM, gsz = (nM - fm) < WGM ? (nM - fm) : WGM;
        u.pm = fm + ((wgid % nig) % gsz); u.pn = (wgid % nig) / gsz;
        if (nN == 52) u.pn = u.pn < 16 ? u.pn : (u.pn < 48 ? u.pn + 4 : u.pn - 32);
    }
    __device__ __forceinline__ void a_ready(const Unit&) const {}
    __device__ __forceinline__ void done(const Unit&) const {}
};

__device__ __forceinline__ unsigned cvt_pk_bf16(float lo, float hi) { unsigned r; asm volatile("v_cvt_pk_bf16_f32 %0, %1, %2" : "=v"(r) : "v"(lo), "v"(hi)); return r; }
template <class Epi, class Sched, bool ALIGN_EPI = false, bool SP2 = false>
__device__ __forceinline__ void gemm_phase(PG8_LAS unsigned char* lds, const Gemm g, const Sched& S, const Epi& E, const int tid) {
    const int wid = __builtin_amdgcn_readfirstlane(tid >> 6), lane = tid & 63, wr = wid >> 2, wc = wid & 3, fr = lane & 15, fq = lane >> 4;
    const int K = g.ld, nt = g.K / BK;
    unsigned voffA[2], voffB[2];
#pragma unroll
    for (int i = 0; i < 2; ++i) { int R, C; stage_rc(tid * 16 + i * 8192, R, C); const int Rb = Epi::PERM ? ((R & ~31) + perm32(R & 31)) : R;
        voffA[i] = (unsigned)(R * K + C) * 2u; voffB[i] = (unsigned)(Rb * K + C) * 2u; }
    const size_t kstep = (size_t)(BK * 2);
    const size_t hstep = (size_t)HALF * K * 2;
    const size_t tstep = 2 * hstep;
    const unsigned ldsw = (unsigned)wid * 1024u;
    const int aoff = lds_byte(wr * 64 + fr, fq * 8), boff = lds_byte(wc * 32 + fr, fq * 8);
#define PG8_SA(b, h) (((b) * 2 + (h)) * HTB)
#define PG8_SB(b, h) ((4 + (b) * 2 + (h)) * HTB)
#define PG8_STAGE(bufoff, gbase, voff) do { _Pragma("unroll") for (int _i = 0; _i < 2; ++_i) \
        __builtin_amdgcn_global_load_lds((const unsigned*)((const char*)(gbase) + (voff)[_i]), (PG8_LAS unsigned*)(lds + (bufoff) + ldsw + _i * 8192), 16, 0, 0); } while (0)
#define PG8_LDA(dst, b, h) do { _Pragma("unroll") for (int m = 0; m < 4; ++m) _Pragma("unroll") for (int k = 0; k < 2; ++k) dst[m][k] = *(const PG8_LAS bf16x8*)(lds + PG8_SA(b, h) + aoff + m * 2048 + k * 1024); } while (0)
#define PG8_LDB(dst, b, h) do { _Pragma("unroll") for (int n = 0; n < 2; ++n) _Pragma("unroll") for (int k = 0; k < 2; ++k) dst[n][k] = *(const PG8_LAS bf16x8*)(lds + PG8_SB(b, h) + boff + n * 2048 + k * 1024); } while (0)
#define PG8_MMA(ai, bj, At, Bt) do { __builtin_amdgcn_s_setprio(1); _Pragma("unroll") for (int m = 0; m < 4; ++m) _Pragma("unroll") for (int n = 0; n < 2; ++n) _Pragma("unroll") for (int k = 0; k < 2; ++k) \
        acc[ai][bj][m][n] = __builtin_amdgcn_mfma_f32_16x16x32_bf16(Bt[n][k], At[m][k], acc[ai][bj][m][n], 0, 0, 0); __builtin_amdgcn_s_setprio(0); } while (0)
#define PG8_WAIT_V(n) asm volatile("s_waitcnt vmcnt(" #n ")" ::: "memory")
#define PG8_WAIT_L(n) asm volatile("s_waitcnt lgkmcnt(" #n ")" ::: "memory")
#define PG8_BAR __builtin_amdgcn_s_barrier()
#define PG8_SCHED __builtin_amdgcn_sched_barrier(0)
    Unit cur, nxt; int ui = 0;
    if (!S.next(0, cur)) return;
    f32x4 acc[2][2][4][2];
#pragma unroll
    for (int a = 0; a < 2; ++a)
#pragma unroll
        for (int b = 0; b < 2; ++b)
#pragma unroll
            for (int m = 0; m < 4; ++m)
#pragma unroll
                for (int n = 0; n < 2; ++n) acc[a][b][m][n] = (f32x4){0.f, 0.f, 0.f, 0.f};
    bf16x8 At[4][2], B0[2][2], B1[2][2];
    const char* cA = (const char*)g.A + (size_t)cur.pm * tstep; const char* cB = (const char*)g.Bt + (size_t)cur.pn * tstep;
    S.a_ready(cur);
    if constexpr (SP2) {
        PG8_STAGE(PG8_SB(0, 0), cB, voffB); PG8_STAGE(PG8_SB(0, 1), cB + hstep, voffB); PG8_STAGE(PG8_SA(0, 0), cA, voffA); PG8_STAGE(PG8_SA(0, 1), cA + hstep, voffA);
        if (wr == 1) PG8_BAR;
        PG8_WAIT_V(2); PG8_BAR;
        PG8_STAGE(PG8_SB(1, 0), cB + kstep, voffB); PG8_STAGE(PG8_SA(1, 0), cA + kstep, voffA); PG8_STAGE(PG8_SB(1, 1), cB + hstep + kstep, voffB);
        PG8_WAIT_V(6); PG8_BAR;
    } else {
        PG8_STAGE(PG8_SB(0, 0), cB, voffB); PG8_STAGE(PG8_SA(0, 0), cA, voffA); PG8_STAGE(PG8_SB(0, 1), cB + hstep, voffB); PG8_STAGE(PG8_SA(0, 1), cA + hstep, voffA);
        if (wr == 1) PG8_BAR;
        PG8_WAIT_V(4); PG8_BAR;
        PG8_STAGE(PG8_SB(1, 0), cB + kstep, voffB); PG8_STAGE(PG8_SA(1, 0), cA + kstep, voffA); PG8_STAGE(PG8_SB(1, 1), cB + hstep + kstep, voffB);
        PG8_WAIT_V(6); PG8_BAR;
    }
    int fresh = 0;
    for (;;) {
        const bool has_next = S.next(ui + 1, nxt);
        const char* nA = has_next ? (const char*)g.A + (size_t)nxt.pm * tstep : cA; const char* nB = has_next ? (const char*)g.Bt + (size_t)nxt.pn * tstep : cB;
        for (int t = 0; t < nt; t += 2) {
            const bool last = (t == nt - 2);
            const char* a1 = cA + (size_t)(t + 1) * kstep;
            const char* a2 = last ? nA : cA + (size_t)(t + 2) * kstep; const char* b2 = last ? nB : cB + (size_t)(t + 2) * kstep;
            const char* a3 = a2 + kstep; const char* b3 = b2 + kstep;
            if (last && has_next) S.a_ready(nxt);
            if constexpr (SP2) {
            const bool relax = Epi::EPI_VMEM > 0 && __builtin_amdgcn_readfirstlane(fresh) != 0;
            PG8_LDB(B0, 0, 0); PG8_LDB(B1, 0, 1); PG8_SCHED; PG8_LDA(At, 0, 0); PG8_STAGE(PG8_SA(1, 1), a1 + hstep, voffA);
            if (relax) { asm volatile("s_waitcnt vmcnt(%0)" :: "n"(8 + Epi::EPI_VMEM) : "memory"); } else { PG8_WAIT_V(8); }
            PG8_WAIT_L(0); PG8_BAR; PG8_MMA(0, 0, At, B0); PG8_MMA(0, 1, At, B1); PG8_BAR; PG8_SCHED;
            PG8_LDA(At, 0, 1); PG8_STAGE(PG8_SB(0, 0), b2, voffB); PG8_STAGE(PG8_SB(0, 1), b2 + hstep, voffB); PG8_STAGE(PG8_SA(0, 0), a2, voffA);
            if (relax) { asm volatile("s_waitcnt vmcnt(%0)" :: "n"(8 + Epi::EPI_VMEM) : "memory"); } else { PG8_WAIT_V(8); }
            PG8_WAIT_L(0); PG8_BAR; PG8_MMA(1, 0, At, B0); PG8_MMA(1, 1, At, B1); PG8_BAR; PG8_SCHED;
            PG8_LDB(B0, 1, 0); PG8_LDB(B1, 1, 1); PG8_SCHED; PG8_LDA(At, 1, 0); PG8_STAGE(PG8_SA(0, 1), a2 + hstep, voffA);
            PG8_WAIT_V(8); PG8_WAIT_L(0); PG8_BAR; PG8_MMA(0, 0, At, B0); PG8_MMA(0, 1, At, B1); PG8_BAR; PG8_SCHED;
            PG8_LDA(At, 1, 1); PG8_STAGE(PG8_SB(1, 0), b3, voffB); PG8_STAGE(PG8_SB(1, 1), b3 + hstep, voffB); PG8_STAGE(PG8_SA(1, 0), a3, voffA);
            PG8_WAIT_V(8); PG8_WAIT_L(0); PG8_BAR; PG8_MMA(1, 0, At, B0); PG8_MMA(1, 1, At, B1); PG8_BAR; PG8_SCHED;
            fresh = 0;
            } else {
            PG8_LDB(B0, 0, 0); PG8_SCHED; PG8_LDA(At, 0, 0); PG8_STAGE(PG8_SA(1, 1), a1 + hstep, voffA);
            PG8_WAIT_L(8); PG8_BAR; PG8_WAIT_L(0); PG8_MMA(0, 0, At, B0); PG8_BAR; PG8_SCHED;
            PG8_LDB(B1, 0, 1); PG8_STAGE(PG8_SB(0, 0), b2, voffB);
            PG8_BAR; PG8_WAIT_L(0); PG8_MMA(0, 1, At, B1); PG8_BAR;
            PG8_LDA(At, 0, 1); PG8_STAGE(PG8_SA(0, 0), a2, voffA);
            PG8_BAR; PG8_WAIT_L(0); PG8_MMA(1, 0, At, B0); PG8_BAR; PG8_SCHED;
            PG8_STAGE(PG8_SB(0, 1), b2 + hstep, voffB);
            PG8_WAIT_V(6); PG8_BAR; PG8_MMA(1, 1, At, B1); PG8_BAR;
            PG8_LDB(B0, 1, 0); PG8_SCHED; PG8_LDA(At, 1, 0); PG8_STAGE(PG8_SA(0, 1), a2 + hstep, voffA);
            PG8_WAIT_L(8); PG8_BAR; PG8_WAIT_L(0); PG8_MMA(0, 0, At, B0); PG8_BAR; PG8_SCHED;
            PG8_LDB(B1, 1, 1); PG8_STAGE(PG8_SB(1, 0), b3, voffB);
            PG8_BAR; PG8_WAIT_L(0); PG8_MMA(0, 1, At, B1); PG8_BAR;
            PG8_LDA(At, 1, 1); PG8_STAGE(PG8_SA(1, 0), a3, voffA);
            PG8_BAR; PG8_WAIT_L(0); PG8_MMA(1, 0, At, B0); PG8_BAR; PG8_SCHED;
            PG8_STAGE(PG8_SB(1, 1), b3 + hstep, voffB);
            PG8_WAIT_V(6); PG8_BAR; PG8_MMA(1, 1, At, B1); PG8_BAR;
            }
        }
        if constexpr (ALIGN_EPI) { if (wr == 0) PG8_BAR; }
        if constexpr (!Epi::AFTER_DRAIN) { int fr_ = fr, fq_ = fq; asm volatile("" : "+v"(fr_), "+v"(fq_));
            E(acc, cur, wr, wc, fr_, fq_); S.done(cur); }
        if (!has_next) break;
#pragma unroll
        for (int a = 0; a < 2; ++a)
#pragma unroll
            for (int b = 0; b < 2; ++b)
#pragma unroll
                for (int m = 0; m < 4; ++m)
#pragma unroll
                    for (int n = 0; n < 2; ++n) acc[a][b][m][n] = (f32x4){0.f, 0.f, 0.f, 0.f};
        cur = nxt; cA = nA; cB = nB; ++ui; fresh = 1;
        if constexpr (ALIGN_EPI) { if (wr == 1) PG8_BAR; }
    }
    PG8_WAIT_V(0);
    if constexpr (!ALIGN_EPI) { if (wr == 0) PG8_BAR; }
    PG8_BAR;
    if constexpr (Epi::AFTER_DRAIN) { E.fused(acc, cur, wr, wc, fr, fq, lds, wid, lane); S.done(cur); }
#undef PG8_SA
#undef PG8_SB
#undef PG8_STAGE
#undef PG8_LDA
#undef PG8_LDB
#undef PG8_MMA
#undef PG8_WAIT_V
#undef PG8_WAIT_L
#undef PG8_BAR
#undef PG8_SCHED
}
}

#ifndef PG8_SP2
#define PG8_SP2 true
#endif
#ifndef PG8_ALIGN
#define PG8_ALIGN true
#endif
namespace pg8 {
__device__ __forceinline__ float silu_f(float v) { return v * __builtin_amdgcn_rcpf(1.0f + __builtin_amdgcn_exp2f(-1.4426950408889634f * v)); }
__device__ __forceinline__ u32x4 pack8(const f32x4& a, const f32x4& b) { u32x4 w; w.x = cvt_pk_bf16(a[0], a[1]); w.y = cvt_pk_bf16(a[2], a[3]); w.z = cvt_pk_bf16(b[0], b[1]); w.w = cvt_pk_bf16(b[2], b[3]); return w; }
struct EpiIn {
    static constexpr bool PERM = true, AFTER_DRAIN = false;
    static constexpr int EPI_VMEM = 16;
    const float* rstd; bf16_t* ZQ; bf16_t* XBC; bf16_t* Kb; bf16_t* Vb; bf16_t* Gb; const float* qw; const float* kw; float* out; PG8_LAS float* P;
    __device__ __forceinline__ void operator()(f32x4 (&acc)[2][2][4][2], const Unit& u, int wr, int wc, int fr, int fq) const {
        const int pn = u.pn, rbase = u.pm * BM + wr * 64 + fr, lc = wc * 32 + 8 * fq;
#pragma unroll
        for (int ai = 0; ai < 2; ++ai)
#pragma unroll
            for (int m = 0; m < 4; ++m) { const float rs = rstd[rbase + ai * HALF + m * 16];
#pragma unroll
                for (int bj = 0; bj < 2; ++bj) { acc[ai][bj][m][0] = acc[ai][bj][m][0] * rs; acc[ai][bj][m][1] = acc[ai][bj][m][1] * rs; } }
        if (pn < 8 || pn >= 44) {
            bf16_t* base = pn < 8 ? ZQ + pn * BM + lc : Gb + (pn - 44) * BM + lc; const int ld = pn < 8 ? 4096 : 2048;
#pragma unroll
            for (int ai = 0; ai < 2; ++ai)
#pragma unroll
                for (int m = 0; m < 4; ++m) { bf16_t* rowp = base + (size_t)(rbase + ai * HALF + m * 16) * ld;
#pragma unroll
                    for (int bj = 0; bj < 2; ++bj) { f32x4 a = acc[ai][bj][m][0], b = acc[ai][bj][m][1];
#pragma unroll
                        for (int e = 0; e < 4; ++e) { a[e] = silu_f(a[e]); b[e] = silu_f(b[e]); }
                        *(u32x4*)(rowp + bj * HALF) = pack8(a, b); } }
        } else if (pn < 20) {
            const int cx = (pn - 8) * BM + lc;
#pragma unroll
            for (int ai = 0; ai < 2; ++ai)
#pragma unroll
                for (int m = 0; m < 4; ++m) { const int row = rbase + ai * HALF + m * 16; bf16_t* rowp = XBC + (size_t)row * XLD + cx;
#pragma unroll
                    for (int bj = 0; bj < 2; ++bj) *(u32x4*)(rowp + bj * HALF) = pack8(acc[ai][bj][m][0], acc[ai][bj][m][1]);
                    if ((m & 1) && fr >= 13 && row >= TP - 3) {
                        float* o = row < TP ? out + O_PCONV + (size_t)(row - (TP - 3)) * CONVD + cx
                                            : out + O_SCONV + (size_t)(((row - TP) >> 5) * 3 + ((row & 31) - 29)) * CONVD + cx;
#pragma unroll
                        for (int bj = 0; bj < 2; ++bj) { *(f32x4*)(o + bj * HALF) = acc[ai][bj][m][0]; *(f32x4*)(o + bj * HALF + 4) = acc[ai][bj][m][1]; } } }
        } else if (pn < 36) {
            const bool isq = pn < 28;
#pragma unroll
            for (int ai = 0; ai < 2; ++ai)
#pragma unroll
                for (int m = 0; m < 4; ++m)
#pragma unroll
                    for (int bj = 0; bj < 2; ++bj) { const f32x4 a = acc[ai][bj][m][0], b = acc[ai][bj][m][1];
                        float s = (a[0] * a[0] + a[1] * a[1]) + (a[2] * a[2] + a[3] * a[3]) + (b[0] * b[0] + b[1] * b[1]) + (b[2] * b[2] + b[3] * b[3]);
                        s += __shfl_xor(s, 16); s += __shfl_xor(s, 32);
                        if (fq == 0) P[((ai * HALF + wr * 64 + m * 16 + fr) * 2 + bj) * 4 + wc] = s; }
            const float* nw = isq ? qw : kw; const f32x4 w0 = *(const f32x4*)(nw + lc), w1 = *(const f32x4*)(nw + lc + 4);
            asm volatile("s_waitcnt lgkmcnt(0)" ::: "memory"); __builtin_amdgcn_s_barrier(); asm volatile("" ::: "memory");
            const float extra = isq ? 0.1275174313f : 1.0f;
            bf16_t* base = isq ? ZQ + 2048 + (pn - 20) * BM + lc : Kb + (pn - 28) * BM + lc; const int ld = isq ? 4096 : 2048;
            const int ck = (pn - 28) * BM + lc;
#pragma unroll
            for (int ai = 0; ai < 2; ++ai)
#pragma unroll
                for (int m = 0; m < 4; ++m) { const int row = rbase + ai * HALF + m * 16; bf16_t* rowp = base + (size_t)row * ld;
#pragma unroll
                    for (int bj = 0; bj < 2; ++bj) { const f32x4 p4 = *(const PG8_LAS f32x4*)(P + ((ai * HALF + wr * 64 + m * 16 + fr) * 2 + bj) * 4);
                        const float sc = __builtin_amdgcn_rsqf(((p4[0] + p4[1]) + (p4[2] + p4[3])) * (1.0f / 128.0f) + EPS) * extra;
                        const f32x4 a = acc[ai][bj][m][0] * sc * w0, b = acc[ai][bj][m][1] * sc * w1;
                        *(u32x4*)(rowp + bj * HALF) = pack8(a, b);
                        if (!isq && row >= TP - 512) { float* o = (row < TP ? out + O_PK + (size_t)(row - (TP - 512)) * 2048 : out + O_SK + (size_t)(row - TP) * 2048) + ck + bj * HALF;
                            *(f32x4*)o = a; *(f32x4*)(o + 4) = b; } } }
        } else {
            const int cv = (pn - 36) * BM + lc;
#pragma unroll
            for (int ai = 0; ai < 2; ++ai)
#pragma unroll
                for (int m = 0; m < 4; ++m) { const int row = rbase + ai * HALF + m * 16; bf16_t* rowp = Vb + (size_t)row * 2048 + cv;
#pragma unroll
                    for (int bj = 0; bj < 2; ++bj) { *(u32x4*)(rowp + bj * HALF) = pack8(acc[ai][bj][m][0], acc[ai][bj][m][1]);
                        if (row >= TP - 512) { float* o = (row < TP ? out + O_PV + (size_t)(row - (TP - 512)) * 2048 : out + O_SV + (size_t)(row - TP) * 2048) + cv + bj * HALF;
                            *(f32x4*)o = acc[ai][bj][m][0]; *(f32x4*)(o + 4) = acc[ai][bj][m][1]; } } }
        }
    }
};
struct EpiOut {
    static constexpr bool PERM = false, AFTER_DRAIN = false;
    static constexpr int EPI_VMEM = 0;
    const float* xp; const float* xs; float* out;
    __device__ __forceinline__ void operator()(f32x4 (&acc)[2][2][4][2], const Unit& u, int wr, int wc, int fr, int fq) const {
        const int row0 = u.pm * BM + wr * 64 + fr, col0 = u.pn * BM + wc * 32 + 4 * fq;
        const float* xb = u.pm < TP / BM ? xp + (size_t)row0 * DM : xs + (size_t)(row0 - TP) * DM;
        float* ob = out + (size_t)row0 * DM;
#pragma unroll
        for (int ai = 0; ai < 2; ++ai) {
            f32x4 xv[4][2][2];
#pragma unroll
            for (int m = 0; m < 4; ++m)
#pragma unroll
                for (int bj = 0; bj < 2; ++bj)
#pragma unroll
                    for (int n = 0; n < 2; ++n) xv[m][bj][n] = *(const f32x4*)(xb + (size_t)(ai * HALF + m * 16) * DM + col0 + bj * HALF + n * 16);
#pragma unroll
            for (int m = 0; m < 4; ++m)
#pragma unroll
                for (int bj = 0; bj < 2; ++bj)
#pragma unroll
                    for (int n = 0; n < 2; ++n) *(f32x4*)(ob + (size_t)(ai * HALF + m * 16) * DM + col0 + bj * HALF + n * 16) = acc[ai][bj][m][n] + xv[m][bj][n];
        }
    }
};
struct EpiNull {
    static constexpr bool PERM = true, AFTER_DRAIN = false;
    static constexpr int EPI_VMEM = 0;
    __device__ __forceinline__ void operator()(f32x4 (&acc)[2][2][4][2], const Unit&, int, int, int, int) const {
#pragma unroll
        for (int ai = 0; ai < 2; ++ai)
#pragma unroll
            for (int bj = 0; bj < 2; ++bj)
#pragma unroll
                for (int m = 0; m < 4; ++m) { asm volatile("" :: "v"(acc[ai][bj][m][0]), "v"(acc[ai][bj][m][1])); }
    }
};
struct HotOrder { int c; __device__ __forceinline__ bool next(int i, Unit& u) const { if (i >= 14) return false; u.pm = (c >> 3) & 1; u.pn = c & 7; return true; } __device__ __forceinline__ void a_ready(const Unit&) const {} __device__ __forceinline__ void done(const Unit&) const {} };
struct OneUnit { Unit u; __device__ __forceinline__ bool next(int i, Unit& o) const { if (i) return false; o = u; return true; } __device__ __forceinline__ void a_ready(const Unit&) const {} __device__ __forceinline__ void done(const Unit&) const {} };
struct EpiSlab {
    static constexpr bool PERM = true, AFTER_DRAIN = false;
    static constexpr int EPI_VMEM = 0;
    unsigned short* slab;
    __device__ __forceinline__ void operator()(f32x4 (&acc)[2][2][4][2], const Unit&, int wr, int wc, int fr, int fq) const {
        unsigned short* ob = slab + (size_t)(wr * 64 + fr) * 256 + wc * 32 + 8 * fq;
#pragma unroll
        for (int ai = 0; ai < 2; ++ai)
#pragma unroll
            for (int m = 0; m < 4; ++m)
#pragma unroll
                for (int bj = 0; bj < 2; ++bj) *(u32x4*)(ob + (size_t)(ai * HALF + m * 16) * 256 + bj * HALF) = pack8(acc[ai][bj][m][0], acc[ai][bj][m][1]);
    }
};
}
#define GAS __attribute__((address_space(1)))
#define LAS __attribute__((address_space(3)))
typedef unsigned short bf16;
typedef unsigned v4u __attribute__((ext_vector_type(4)));
typedef float f32x4 __attribute__((ext_vector_type(4)));
typedef short bf16x8 __attribute__((ext_vector_type(8)));
typedef GAS unsigned gu32;
typedef GAS unsigned long long gu64;
#define RLX_AGENT __ATOMIC_RELAXED, __HIP_MEMORY_SCOPE_AGENT
#define LDS_WAIT() asm volatile("s_waitcnt lgkmcnt(0)" ::: "memory")
#define VM_WAIT() asm volatile("s_waitcnt vmcnt(0)" ::: "memory")
__device__ __forceinline__ unsigned long long rt() { return __builtin_amdgcn_s_memrealtime(); }
__device__ __forceinline__ unsigned f2bf(float f) { unsigned u = __builtin_bit_cast(unsigned, f); return (u + 0x7fffu + ((u >> 16) & 1u)) >> 16; }
__device__ __forceinline__ unsigned pk2(float lo, float hi) { return f2bf(lo) | (f2bf(hi) << 16); }

#define XB_TMO      128
#define XB_XCNT(j)  (256  + 64 * (j))
#define XB_XSUB(j)  (1280 + 64 * (j))
#define XB_XGEN(j)  (2304 + 64 * (j))
#define XB_TOP      3328
#define XB_TOPGEN   3392
#define XCD_BAR_WORDS 3456
#define XB_SPIN_CAP (1u << 18)

__device__ __forceinline__ unsigned xb_ld(unsigned* p)              { return __hip_atomic_load(p, __ATOMIC_RELAXED, __HIP_MEMORY_SCOPE_AGENT); }
__device__ __forceinline__ unsigned xb_add(unsigned* p, unsigned v) { return __hip_atomic_fetch_add(p, v, __ATOMIC_RELAXED, __HIP_MEMORY_SCOPE_AGENT); }
__device__ __forceinline__ unsigned xb_xcc_id() { return (unsigned)__builtin_amdgcn_s_getreg((3 << 11) | 20) & 0xFu; }
#define XB_SPIN(cond, bar) do { unsigned _sp = 0; while (cond) { __builtin_amdgcn_s_sleep(1); \
    if ((++_sp & 255u) == 0u) { if (xb_ld(&(bar)[XB_TMO])) break; if (_sp > XB_SPIN_CAP) { atomicAdd(&(bar)[XB_TMO], 1u); break; } } } } while (0)

__device__ __forceinline__ int lane_now() { int l; asm volatile("v_mbcnt_lo_u32_b32 %0, -1, 0\n\tv_mbcnt_hi_u32_b32 %0, -1, %0" : "=&v"(l)); return l; }
struct XcdBarrier {
    unsigned w0;
    unsigned* bar; unsigned x;
    volatile LAS unsigned* st;
};

__device__ __forceinline__ XcdBarrier xcd_barrier_post(unsigned* bar, volatile LAS unsigned* st) {
    XcdBarrier b; b.bar = bar; b.x = xb_xcc_id(); b.st = st; b.w0 = __builtin_amdgcn_readfirstlane(threadIdx.x >> 6) == 0 ? 1u : 0u;
    if (threadIdx.x == 0) (void)xb_add(&bar[XB_XCNT(b.x)], 1u);
    return b;
}
__device__ __forceinline__ void xcd_barrier_complete(unsigned* bar, unsigned x, unsigned& nloc, unsigned& nx) {
    const unsigned G = gridDim.x * gridDim.y * gridDim.z;
    unsigned sum, cnt, mine, sp = 0u;
    for (;;) {
        sum = 0u; cnt = 0u; mine = 0u;
#pragma unroll
        for (unsigned j = 0; j < 16; ++j) { const unsigned c = xb_ld(&bar[XB_XCNT(j)]); sum += c; cnt += (c > 0u) ? 1u : 0u; mine = (j == x) ? c : mine; }
        if (sum == G) break;
        __builtin_amdgcn_s_sleep(1);
        if ((++sp & 255u) == 0u) { if (xb_ld(&bar[XB_TMO])) break; if (sp > XB_SPIN_CAP) { atomicAdd(&bar[XB_TMO], 1u); break; } }
    }
    nloc = mine > 0u ? mine : 1u; nx = cnt > 0u ? cnt : 1u;
}

__device__ __forceinline__ void xcd_barrier(const XcdBarrier& b) {
    asm volatile("s_waitcnt vmcnt(0)" ::: "memory");
    __syncthreads();
    if (b.w0 != 0u && lane_now() == 0) {
        unsigned* bar = b.bar;
        __builtin_amdgcn_s_waitcnt(0);
        unsigned nloc = b.st[0], nx = b.st[1];
        if (nloc == 0u) { xcd_barrier_complete(bar, b.x, nloc, nx); b.st[0] = nloc; b.st[1] = nx; }
        const unsigned old = xb_add(&bar[XB_XSUB(b.x)], 1u);
        const unsigned gen = old / nloc;
        if (old + 1u == (gen + 1u) * nloc) {
            __builtin_amdgcn_fence(__ATOMIC_RELEASE, "agent");
            asm volatile("s_waitcnt vmcnt(0)" ::: "memory");
            const unsigned og = xb_add(&bar[XB_TOP], 1u);
            const unsigned tg = og / nx;
            if (og + 1u == (tg + 1u) * nx) xb_add(&bar[XB_TOPGEN], 1u);
            else XB_SPIN(xb_ld(&bar[XB_TOPGEN]) == tg, bar);
            __builtin_amdgcn_fence(__ATOMIC_ACQUIRE, "agent");
            xb_add(&bar[XB_XGEN(b.x)], 1u);
            asm volatile("s_waitcnt vmcnt(0)" ::: "memory");
        } else {
            XB_SPIN(xb_ld(&bar[XB_XGEN(b.x)]) == gen, bar);
            __builtin_amdgcn_fence(__ATOMIC_ACQUIRE, "agent");
            asm volatile("s_waitcnt vmcnt(0)" ::: "memory");
        }
    }
    __syncthreads();
}

struct Frame {
    LAS unsigned char* lds; volatile LAS unsigned* MISC; gu32* ctl;
    int tid, lane, wave, vcu, G;
};
__device__ __forceinline__ float wave_sum(float v) {
#pragma unroll
    for (int o = 1; o < 64; o <<= 1) v += __shfl_xor(v, o);
    return v;
}
typedef float p0f4 __attribute__((ext_vector_type(4)));
struct P0Item { const float* W; size_t ldw; int k0, n0; bf16* dst; size_t ldt; const float* sc; };
__device__ __forceinline__ void p0_item_load(const P0Item& it, int lane, p0f4 (&v)[8], float (&sv)[8]) {
    const int r8 = lane >> 3, c4 = (lane & 7) * 4;
#pragma unroll
    for (int i = 0; i < 8; ++i) { v[i] = *(const p0f4*)(it.W + (size_t)(it.k0 + 8 * i + r8) * it.ldw + it.n0 + c4); sv[i] = it.sc ? it.sc[it.k0 + 8 * i + r8] : 1.0f; }
}
__device__ __forceinline__ void p0_item_store(const P0Item& it, int lane, const p0f4 (&v)[8], const float (&sv)[8], LAS float* scr) {
    const int r8 = lane >> 3, c4 = (lane & 7) * 4;
#pragma unroll
    for (int i = 0; i < 8; ++i) { LAS float* p = scr + (8 * i + r8) * 33 + c4; p[0] = v[i][0] * sv[i]; p[1] = v[i][1] * sv[i]; p[2] = v[i][2] * sv[i]; p[3] = v[i][3] * sv[i]; }
    LDS_WAIT(); asm volatile("" ::: "memory");
    const int c = lane & 7;
#pragma unroll
    for (int j = 0; j < 4; ++j) { const int n = (lane >> 3) + 8 * j; const LAS float* s = scr + (8 * c) * 33 + n;
        v4u o; o.x = pk2(s[0 * 33], s[1 * 33]); o.y = pk2(s[2 * 33], s[3 * 33]); o.z = pk2(s[4 * 33], s[5 * 33]); o.w = pk2(s[6 * 33], s[7 * 33]);
        *(GAS v4u*)(it.dst + (size_t)n * it.ldt + it.k0 + 8 * c) = o; }
    LDS_WAIT(); asm volatile("" ::: "memory");
}
__device__ __forceinline__ P0Item p0_decode(int it, const float* w_in, const float* w_out, const float* norm_w, bf16* WinT, bf16* WdtT, bf16* WoutT) {
    constexpr int NB_IN = SRC_LD / 32  , I_IN = 32 * NB_IN;
    P0Item r;
    if (it < I_IN) { const int kb = it / NB_IN, nb = it % NB_IN;
        r.W = w_in; r.ldw = SRC_LD; r.k0 = 64 * kb; r.n0 = 32 * nb; r.ldt = 2048; r.sc = norm_w;
        r.dst = nb < 160 ? WinT + (size_t)(32 * nb) * 2048 : (nb == 160 ? WdtT : WinT + (size_t)(32 * (nb - 1)) * 2048);
    } else { const int q = it - I_IN, kb = q / 64, nb = q % 64;
        r.W = w_out; r.ldw = 2048; r.k0 = 64 * kb; r.n0 = 32 * nb; r.ldt = 4096; r.sc = nullptr; r.dst = WoutT + (size_t)(32 * nb) * 4096; }
    return r;
}
__device__ __forceinline__ void p0a_weights(Frame& F, const float* w_in, const float* w_out, const float* norm_w, bf16* WinT, bf16* WdtT, bf16* WoutT) {
    LAS float* scr = (LAS float*)(F.lds + RING_OFF + F.wave * 16384);
    const int gw = F.wave * F.G + F.vcu, NGW = F.G * NWAVES;
    const int NITEMS = 32 * (SRC_LD / 32) + (F.G == 256 ? 0 : 64 * 64);
    constexpr int NXB = MTOK / 16;
    const int nheavy = (F.G == 256) ? NXB - (NXB / F.G) * F.G : 0;
    const bool heavy = F.vcu < nheavy;
    const int lw = (F.vcu - nheavy) * NWAVES + F.wave;
    const int norph = nheavy * NWAVES * 2;
    const int DT = (F.G == 256) ? 4 : 6;
    int extra = -1;
    if (!heavy && nheavy > 0 && lw < norph) { const int kk = lw / (nheavy * NWAVES), r = lw - kk * nheavy * NWAVES, ow = r / nheavy, ov = r - ow * nheavy; extra = ow * F.G + ov + (DT + kk) * NGW; if (extra >= NITEMS) extra = -1; }
    if (gw >= NITEMS) return;
    const int nb = (NITEMS - gw + NGW - 1) / NGW;
    const int ntrip = heavy ? nb - (nb > DT ? (nb > DT + 1 ? 2 : 1) : 0) : nb + (extra >= 0 ? 1 : 0);
#define P0_ITEM(J) (heavy ? gw + ((J) < DT ? (J) : (J) + 2) * NGW : ((J) < nb ? gw + (J) * NGW : extra))
    P0Item cur = p0_decode(P0_ITEM(0), w_in, w_out, norm_w, WinT, WdtT, WoutT);
    p0f4 v[8]; float sv[8];
    p0_item_load(cur, F.lane, v, sv);
#pragma unroll 1
    for (int j = 0; j < ntrip; ++j) {
        const int jn = j + 1 < ntrip ? j + 1 : j;
        P0Item nxt = p0_decode(P0_ITEM(jn), w_in, w_out, norm_w, WinT, WdtT, WoutT);
        p0f4 v2[8]; float sv2[8];
        p0_item_load(nxt, F.lane, v2, sv2);
        p0_item_store(cur, F.lane, v, sv, scr);
        cur = nxt;
#pragma unroll
        for (int i = 0; i < 8; ++i) { v[i] = v2[i]; sv[i] = sv2[i]; }
    }
#undef P0_ITEM
}
__device__ __forceinline__ void p0a_wout(Frame& F, int wv, int nwv, const float* w_in, const float* w_out, const float* norm_w, bf16* WinT, bf16* WdtT, bf16* WoutT) {
    LAS float* scr = (LAS float*)(F.lds + RING_OFF + F.wave * 16384);
    constexpr int I0 = 32 * (SRC_LD / 32), I1 = I0 + 64 * 64;
    int it = I0 + wv;
    if (it >= I1) return;
    P0Item cur = p0_decode(it, w_in, w_out, norm_w, WinT, WdtT, WoutT);
    p0f4 v[8]; float sv[8];
    p0_item_load(cur, F.lane, v, sv);
#pragma unroll 1
    for (; it < I1; it += nwv) {
        const int itn = it + nwv < I1 ? it + nwv : it;
        P0Item nxt = p0_decode(itn, w_in, w_out, norm_w, WinT, WdtT, WoutT);
        p0f4 v2[8]; float sv2[8];
        p0_item_load(nxt, F.lane, v2, sv2);
        p0_item_store(cur, F.lane, v, sv, scr);
        cur = nxt;
#pragma unroll
        for (int i = 0; i < 8; ++i) { v[i] = v2[i]; sv[i] = sv2[i]; }
    }
}
typedef float f32x4v __attribute__((ext_vector_type(4)));
__device__ __forceinline__ void p0b_rows(Frame& F, const float* __restrict__ xp, const float* __restrict__ xs, const bf16* __restrict__ WdtT, const float* __restrict__ dt_bias, bf16* __restrict__ H, float* __restrict__ rstd, float* __restrict__ dtb) {
    const int gw = F.wave * F.G + F.vcu, NGW = F.G * NWAVES, lane = F.lane, r = lane & 15, kq = lane >> 4;
    for (int blk = gw; blk < MTOK / 16; blk += NGW) {
        const int row = blk * 16 + r;
        const float* __restrict__ xr = (row < TP ? xp + (size_t)row * DM : xs + (size_t)(row - TP) * DM) + 8 * kq;
        bf16* __restrict__ hr = H + (size_t)row * DM + 8 * kq;
        const bf16* __restrict__ w0 = WdtT + (size_t)r * DM + 8 * kq; const bf16* __restrict__ w1 = w0 + (size_t)16 * DM;
        f32x4v a0 = {0.f, 0.f, 0.f, 0.f}, a1 = {0.f, 0.f, 0.f, 0.f}; float ss = 0.f;
#pragma unroll 1
        for (int s8 = 0; s8 < 8; ++s8) {
            f32x4v xu[8], xv[8]; bf16x8 b0[8], b1[8];
#pragma unroll
            for (int i = 0; i < 8; ++i) { const int s = s8 * 8 + i; xu[i] = *(const f32x4v*)(xr + 32 * s); xv[i] = *(const f32x4v*)(xr + 32 * s + 4); b0[i] = *(const bf16x8*)(w0 + 32 * s); b1[i] = *(const bf16x8*)(w1 + 32 * s); }
#pragma unroll
            for (int i = 0; i < 8; ++i) { const int s = s8 * 8 + i; const f32x4v u = xu[i], v = xv[i];
                ss += (u[0] * u[0] + u[1] * u[1]) + (u[2] * u[2] + u[3] * u[3]) + (v[0] * v[0] + v[1] * v[1]) + (v[2] * v[2] + v[3] * v[3]);
                v4u p; p.x = pg8::cvt_pk_bf16(u[0], u[1]); p.y = pg8::cvt_pk_bf16(u[2], u[3]); p.z = pg8::cvt_pk_bf16(v[0], v[1]); p.w = pg8::cvt_pk_bf16(v[2], v[3]);
                *(v4u*)(hr + 32 * s) = p;
                const bf16x8 af = __builtin_bit_cast(bf16x8, p);
                a0 = __builtin_amdgcn_mfma_f32_16x16x32_bf16(af, b0[i], a0, 0, 0, 0);
                a1 = __builtin_amdgcn_mfma_f32_16x16x32_bf16(af, b1[i], a1, 0, 0, 0); }
        }
        ss += __shfl_xor(ss, 16); ss += __shfl_xor(ss, 32);
        const float rs = __builtin_amdgcn_rsqf(ss * (1.0f / DM) + EPS);
        if (lane < 16) rstd[row] = rs;
        const float bia0 = dt_bias[r], bia1 = dt_bias[16 + r];
#pragma unroll
        for (int i = 0; i < 4; ++i) {
            const float rsi = __shfl(rs, 4 * kq + i);
            float v0 = a0[i] * rsi + bia0, v1 = a1[i] * rsi + bia1;
            v0 = v0 > 20.f ? v0 : __logf(1.0f + __expf(v0)); v1 = v1 > 20.f ? v1 : __logf(1.0f + __expf(v1));
            float* o = dtb + (size_t)(blk * 16 + 4 * kq + i) * 32;
            o[r] = v0; o[16 + r] = v1;
        }
    }
}

__device__ __forceinline__ void p0x_rows(Frame& F, const float* __restrict__ xp, const float* __restrict__ xs, const float* __restrict__ w_in, const float* __restrict__ norm_w, const float* __restrict__ dt_bias,
                                         bf16* __restrict__ H, float* __restrict__ rstd, float* __restrict__ dtb) {
    const int lane = F.lane, r = lane & 15, kq = lane >> 4, w = F.wave, tid = F.tid;
    LAS float* scr = (LAS float*)(F.lds + RING_OFF + w * 16384);
    bf16x8 b0[8], b1[8];
    {
        const int r8 = lane >> 3, c4 = (lane & 7) * 4;
#pragma unroll
        for (int q = 0; q < 4; ++q) {
            const int k0 = 256 * w + 64 * q;
            p0f4 v[8]; float sv[8];
#pragma unroll
            for (int i = 0; i < 8; ++i) { v[i] = *(const p0f4*)(w_in + (size_t)(k0 + 8 * i + r8) * SRC_LD + 5120 + c4); sv[i] = norm_w[k0 + 8 * i + r8]; }
#pragma unroll
            for (int i = 0; i < 8; ++i) { LAS float* p = scr + (8 * i + r8) * 33 + c4; p[0] = v[i][0] * sv[i]; p[1] = v[i][1] * sv[i]; p[2] = v[i][2] * sv[i]; p[3] = v[i][3] * sv[i]; }
            LDS_WAIT(); asm volatile("" ::: "memory");
#pragma unroll
            for (int t = 0; t < 2; ++t) { const LAS float* s0 = scr + (32 * t + 8 * kq) * 33 + r; const LAS float* s1 = s0 + 16;
                v4u o0, o1;
                o0.x = pk2(s0[0 * 33], s0[1 * 33]); o0.y = pk2(s0[2 * 33], s0[3 * 33]); o0.z = pk2(s0[4 * 33], s0[5 * 33]); o0.w = pk2(s0[6 * 33], s0[7 * 33]);
                o1.x = pk2(s1[0 * 33], s1[1 * 33]); o1.y = pk2(s1[2 * 33], s1[3 * 33]); o1.z = pk2(s1[4 * 33], s1[5 * 33]); o1.w = pk2(s1[6 * 33], s1[7 * 33]);
                b0[2 * q + t] = __builtin_bit_cast(bf16x8, o0); b1[2 * q + t] = __builtin_bit_cast(bf16x8, o1); }
            LDS_WAIT(); asm volatile("" ::: "memory");
        }
    }
#define P0X_RED(PAR, W) ((LAS float*)(F.lds + RING_OFF + (W) * 16384 + 8448 + (PAR) * 2304))
    const int nblk = MTOK / 16;
    int blk = F.vcu;
    f32x4v xu[8], xv[8];
    if (blk < nblk) { const int row = blk * 16 + r; const float* xr = (row < TP ? xp + (size_t)row * DM : xs + (size_t)(row - TP) * DM) + 256 * w + 8 * kq;
#pragma unroll
        for (int i = 0; i < 8; ++i) { xu[i] = *(const f32x4v*)(xr + 32 * i); xv[i] = *(const f32x4v*)(xr + 32 * i + 4); } }
    int par = 0;
#pragma unroll 1
    for (; blk < nblk; blk += F.G, par ^= 1) {
        const int row = blk * 16 + r;
        bf16* __restrict__ hr = H + (size_t)row * DM + 256 * w + 8 * kq;
        f32x4v a0 = {0.f, 0.f, 0.f, 0.f}, a1 = {0.f, 0.f, 0.f, 0.f}; float ss = 0.f;
#pragma unroll
        for (int i = 0; i < 8; ++i) { const f32x4v u = xu[i], v = xv[i];
            ss += (u[0] * u[0] + u[1] * u[1]) + (u[2] * u[2] + u[3] * u[3]) + (v[0] * v[0] + v[1] * v[1]) + (v[2] * v[2] + v[3] * v[3]);
            v4u p; p.x = pg8::cvt_pk_bf16(u[0], u[1]); p.y = pg8::cvt_pk_bf16(u[2], u[3]); p.z = pg8::cvt_pk_bf16(v[0], v[1]); p.w = pg8::cvt_pk_bf16(v[2], v[3]);
            *(v4u*)(hr + 32 * i) = p;
            const bf16x8 af = __builtin_bit_cast(bf16x8, p);
            a0 = __builtin_amdgcn_mfma_f32_16x16x32_bf16(af, b0[i], a0, 0, 0, 0);
            a1 = __builtin_amdgcn_mfma_f32_16x16x32_bf16(af, b1[i], a1, 0, 0, 0); }
        {
            const int nb = blk + F.G;
            if (nb < nblk) { const int nrow = nb * 16 + r; const float* xr = (nrow < TP ? xp + (size_t)nrow * DM : xs + (size_t)(nrow - TP) * DM) + 256 * w + 8 * kq;
#pragma unroll
                for (int i = 0; i < 8; ++i) { xu[i] = *(const f32x4v*)(xr + 32 * i); xv[i] = *(const f32x4v*)(xr + 32 * i + 4); } }
        }
        ss += __shfl_xor(ss, 16); ss += __shfl_xor(ss, 32);
        LAS float* rw = P0X_RED(par, w);
#pragma unroll
        for (int i = 0; i < 4; ++i) { rw[i * 64 + lane] = a0[i]; rw[(4 + i) * 64 + lane] = a1[i]; }
        rw[8 * 64 + lane] = ss;
        __syncthreads();
        {
            const int rho = tid >> 5, eta = tid & 31, sl = (eta & 15) + 16 * (rho >> 2), j = (eta >> 4) * 4 + (rho & 3);
            float acc = 0.f, sq = 0.f;
#pragma unroll
            for (int ww = 0; ww < 8; ++ww) { const LAS float* q = P0X_RED(par, ww); acc += q[j * 64 + sl]; sq += q[8 * 64 + rho]; }
            const float rs = __builtin_amdgcn_rsqf(sq * (1.0f / DM) + EPS);
            if (eta == 0) rstd[blk * 16 + rho] = rs;
            float v0 = acc * rs + dt_bias[eta];
            v0 = v0 > 20.f ? v0 : __logf(1.0f + __expf(v0));
            dtb[(size_t)blk * 512 + tid] = v0;
        }
    }
}
namespace ssd {
typedef _Float16 half8 __attribute__((ext_vector_type(8)));
typedef float f32x16 __attribute__((ext_vector_type(16)));
typedef float f4 __attribute__((ext_vector_type(4)));
typedef unsigned u2 __attribute__((ext_vector_type(2)));
typedef unsigned u4 __attribute__((ext_vector_type(4)));
constexpr int XT_OFF = 0, BT_OFF = 36864, BS_OFF = 55296, CS_OFF = 72704, GT_OFF = 90112, TAB_OFF = 102400, RED_OFF = 107520, TOTA_OFF = 111616, RS_OFF = 112640;
constexpr float LOG2E = 1.4426950408889634f;
#define MFMA16(a, b, c) __builtin_amdgcn_mfma_f32_32x32x16_f16((a), (b), (c), 0, 0, 0)
#define LBAR() do { asm volatile("s_waitcnt lgkmcnt(0)" ::: "memory"); __builtin_amdgcn_s_barrier(); asm volatile("" ::: "memory"); } while (0)
__device__ __forceinline__ int xt_addr(int hl, int p, int ch) { return XT_OFF + (hl * 64 + p) * 144 + (ch << 4); }
__device__ __forceinline__ int bt_addr(int n, int ch) { return BT_OFF + n * 144 + (ch << 4); }
__device__ __forceinline__ int bs_addr(int j, int ch) { return BS_OFF + j * 272 + (ch << 4); }
__device__ __forceinline__ int cs_addr(int i, int ch) { return CS_OFF + i * 272 + (ch << 4); }
__device__ __forceinline__ unsigned pkh(float a, float b) { return __builtin_bit_cast(unsigned, __builtin_amdgcn_cvt_pkrtz(a, b)); }
__device__ __forceinline__ half8 pack_step(const f32x16& x, int s) {
    u4 p; p.x = pkh(x[8 * s], x[8 * s + 1]); p.y = pkh(x[8 * s + 2], x[8 * s + 3]); p.z = pkh(x[8 * s + 4], x[8 * s + 5]); p.w = pkh(x[8 * s + 6], x[8 * s + 7]);
    return __builtin_bit_cast(half8, p);
}
__device__ __forceinline__ half8 ld2x8(const LAS unsigned char* lds, int a0, int a1) {
    const u2 lo = *(const LAS u2*)(lds + a0), hi = *(const LAS u2*)(lds + a1); u4 p; p.x = lo.x; p.y = lo.y; p.z = hi.x; p.w = hi.y; return __builtin_bit_cast(half8, p);
}
__device__ __forceinline__ f4 bf4(u2 r) { return (f4){__uint_as_float(r.x << 16), __uint_as_float(r.x & 0xffff0000u), __uint_as_float(r.y << 16), __uint_as_float(r.y & 0xffff0000u)}; }
struct Ctx {
    const unsigned short* XBC; const float* DT; unsigned short* ZQ; const float* conv_w; const float* conv_b; const float* a_log; const float* d_skip; const float* ssm_norm_w; const float* state_conv; unsigned short* YO; unsigned char* BCC;
};
template <bool FULL, bool SAMPLE>
__device__ __forceinline__ void chunk(const Frame& F, const Ctx& c, int g, int hh, int row0, int hb, int ci, f32x16 (&S)[4], float& dec2, int cmode = -1, unsigned char* cch = nullptr) {
    constexpr int nvalid = SAMPLE ? 32 : 64;
    const LAS unsigned char* ldr = F.lds; LAS unsigned char* ldw = F.lds;
    int z0; asm volatile("v_mov_b32 %0, 0" : "=v"(z0));
    const int tid = F.tid + z0, lane = F.lane + z0, w = F.wave, l31 = lane & 31, h = lane >> 5, hl = w >> 1, ph = w & 1, head = g * 8 + hh * 4 + hl;
    LAS float* tab_a = (LAS float*)(ldw + TAB_OFF + w * 640); LAS float* tab_d = tab_a + 64; LAS _Float16* tab_w = (LAS _Float16*)(tab_a + 128);
    const float alog = c.a_log[head];
    const float dtv = lane < nvalid ? c.DT[(size_t)(row0 + lane) * 32 + head] : 0.f;
    {
        const bool cached = cmode == 1;
        constexpr int BCB = FULL ? 53248 : 18432;
        if (cached) {
#pragma unroll
            for (int k = 0; k < (BCB / 1024 + 7) / 8; ++k) { const int pc = w + 8 * k;
                if (pc < BCB / 1024) __builtin_amdgcn_global_load_lds((const unsigned*)(cch + pc * 1024 + lane * 16), (LAS unsigned*)(ldw + BT_OFF + pc * 1024), 16, 0, 0); }
        }
        const int kind = cached ? (w & 1) : (w & 3), tq0 = cached ? (w >> 1) : (w >> 2);
        const int nrnd = cached ? 1 : 2;
        const bool isx = kind < 2, isb = kind == 2;
        if (FULL || kind < 3) {
            const int colbase = isx ? 512 * g + 256 * hh + 128 * kind : (isb ? 2048 + 128 * g : 2560 + 128 * g);
            const unsigned lane2 = (unsigned)lane * 2u;
            typedef float f2 __attribute__((ext_vector_type(2)));
            const float* wbase = c.conv_w + colbase;
            const f2 w0 = *(const f2*)(wbase + lane2), w1 = *(const f2*)(wbase + CONVD + lane2), w2 = *(const f2*)(wbase + 2 * CONVD + lane2), w3 = *(const f2*)(wbase + 3 * CONVD + lane2), cb = *(const f2*)(c.conv_b + colbase + lane2);
#define BF2(u) ((f2){__uint_as_float((u) << 16), __uint_as_float((u) & 0xffff0000u)})
            unsigned hraw[2][3], rv[2][16]; f2 hst[3];
#pragma unroll
            for (int rnd = 0; rnd < 2; ++rnd) if (rnd < nrnd) {
                const int tq = tq0 + 2 * rnd;
#pragma unroll
                for (int t = 0; t < 3; ++t) { const int j = 16 * tq - 3 + t;
                    const int r = SAMPLE ? row0 + (j < 0 ? 0 : (j & 31)) : (row0 + j < 0 ? 0 : row0 + j);
                    hraw[rnd][t] = *(const unsigned*)(c.XBC + (size_t)r * XLD + colbase + lane2); }
                const unsigned short* xr = c.XBC + (size_t)(row0 + (SAMPLE ? ((16 * tq) & 31) : 16 * tq)) * XLD + colbase;
#pragma unroll
                for (int i = 0; i < 16; ++i) rv[rnd][i] = *(const unsigned*)(xr + (size_t)i * XLD + lane2);
            }
            if (SAMPLE) {
#pragma unroll
                for (int t = 0; t < 3; ++t) hst[t] = *(const f2*)(c.state_conv + ((size_t)hb * 3 + t) * CONVD + colbase + lane2);
            }
            const int xt_l = XT_OFF + (128 * (kind & 1) + 2 * lane) * 144, bt_l = BT_OFF + 2 * lane * 144;
            const int rm_l = (isb ? BS_OFF : CS_OFF) + 4 * lane;
#pragma unroll
            for (int rnd = 0; rnd < 2; ++rnd) if (rnd < nrnd) {
                const int tq = tq0 + 2 * rnd;
                f2 win0, win1, win2;
                if (SAMPLE) { const bool first = (tq == 0); win0 = first ? hst[0] : BF2(hraw[rnd][0]); win1 = first ? hst[1] : BF2(hraw[rnd][1]); win2 = first ? hst[2] : BF2(hraw[rnd][2]); }
                else { const bool zer = (row0 + 16 * tq) < 3;
                    win0 = zer ? (f2){0.f, 0.f} : BF2(hraw[rnd][0]); win1 = zer ? (f2){0.f, 0.f} : BF2(hraw[rnd][1]); win2 = zer ? (f2){0.f, 0.f} : BF2(hraw[rnd][2]); }
                const bool ok = !SAMPLE || tq < 2;
#pragma unroll
                for (int tgl = 0; tgl < 2; ++tgl) {
                    const int tg = 2 * tq + tgl, j0 = 8 * tg;
                    unsigned pt[2][4];
                    unsigned pr[8];
#pragma unroll
                    for (int i2 = 0; i2 < 4; ++i2) {
                        f2 oa, ob;
                        { const f2 cur = BF2(rv[rnd][8 * tgl + 2 * i2]); const f2 cv = cb + w0 * win0 + w1 * win1 + w2 * win2 + w3 * cur;
#pragma unroll
                          for (int e = 0; e < 2; ++e) oa[e] = ok ? cv[e] * __builtin_amdgcn_rcpf(1.0f + __builtin_amdgcn_exp2f(-LOG2E * cv[e])) : 0.f;
                          win0 = win1; win1 = win2; win2 = cur; }
                        { const f2 cur = BF2(rv[rnd][8 * tgl + 2 * i2 + 1]); const f2 cv = cb + w0 * win0 + w1 * win1 + w2 * win2 + w3 * cur;
#pragma unroll
                          for (int e = 0; e < 2; ++e) ob[e] = ok ? cv[e] * __builtin_amdgcn_rcpf(1.0f + __builtin_amdgcn_exp2f(-LOG2E * cv[e])) : 0.f;
                          win0 = win1; win1 = win2; win2 = cur; }
                        pt[0][i2] = pkh(oa[0], ob[0]); pt[1][i2] = pkh(oa[1], ob[1]);
                        pr[2 * i2] = pkh(oa[0], oa[1]); pr[2 * i2 + 1] = pkh(ob[0], ob[1]);
                    }
                    if (isx || isb) {
#pragma unroll
                        for (int e = 0; e < 2; ++e) { u4 pk; pk.x = pt[e][0]; pk.y = pt[e][1]; pk.z = pt[e][2]; pk.w = pt[e][3];
                            *(LAS u4*)(ldw + (isx ? xt_l : bt_l) + e * 144 + tg * 16) = pk; }
                    }
                    if (!isx && FULL) {
#pragma unroll
                        for (int i = 0; i < 8; ++i) *(LAS unsigned*)(ldw + rm_l + (j0 + i) * 272) = pr[i];
                    }
                }
            }
#undef BF2
        }
    }
    float a2_last;
    {
        const float A2 = -__expf(alog) * LOG2E;
        float a = dtv * A2;
#pragma unroll
        for (int o = 1; o < 64; o <<= 1) { const float t = __shfl_up(a, o); if (lane >= o) a += t; }
        a2_last = __shfl(a, 63);
        tab_a[lane] = a; tab_d[lane] = dtv; tab_w[lane] = (_Float16)(dtv * __builtin_amdgcn_exp2f(a2_last - a));
        dec2 += a2_last;
    }
    if (cmode == 1) asm volatile("s_waitcnt vmcnt(0)" ::: "memory");
    LBAR();
    if (cmode == 0) {
        constexpr int BCB = FULL ? 53248 : 18432;
#pragma unroll
        for (int k = 0; k < (BCB / 16 + 511) / 512; ++k) { const int pc = tid + 512 * k;
            if (pc < BCB / 16) *(u4*)(cch + pc * 16) = *(const LAS u4*)(ldr + BT_OFF + pc * 16); }
    }
    if constexpr (FULL) {
        const float Dk = c.d_skip[head];
        u2 zc[4]; f4 nwv[4];
#pragma unroll
        for (int q = 0; q < 4; ++q) nwv[q] = *(const f4*)(c.ssm_norm_w + head * 64 + 32 * ph + 8 * q + 4 * h);
#pragma unroll
        for (int q = 0; q < 4; ++q) zc[q] = *(const u2*)(c.ZQ + (size_t)(row0 + l31) * 4096 + head * 64 + 32 * ph + 8 * q + 4 * h);
        u2 zn[4];
        if (!SAMPLE) {
#pragma unroll
            for (int q = 0; q < 4; ++q) zn[q] = *(const u2*)(c.ZQ + (size_t)(row0 + 32 + l31) * 4096 + head * 64 + 32 * ph + 8 * q + 4 * h);
        }
        if (w < 4 && w != 2) {
            const int jt = w >> 1, it = w & 1; f32x16 gacc;
#pragma unroll
            for (int r = 0; r < 16; ++r) gacc[r] = 0.f;
#pragma unroll
            for (int s = 0; s < 8; ++s) {
                const half8 a = *(const LAS half8*)(ldr + bs_addr(32 * jt + l31, 2 * s + h)), b = *(const LAS half8*)(ldr + cs_addr(32 * it + l31, 2 * s + h));
                gacc = MFMA16(a, b, gacc);
            }
            LAS f4* gt = (LAS f4*)(ldw + GT_OFF + (jt + it) * 4096);
#pragma unroll
            for (int q = 0; q < 4; ++q) gt[q * 64 + lane] = (f4){gacc[4 * q], gacc[4 * q + 1], gacc[4 * q + 2], gacc[4 * q + 3]};
        }
        LBAR();
        LAS float* tota = (LAS float*)(ldw + TOTA_OFF) + ci * 64; LAS float* rsv = (LAS float*)(ldw + RS_OFF);
#pragma unroll
        for (int it = 0; it < (SAMPLE ? 1 : 2); ++it) {
            const int i = 32 * it + l31; const float a2i = tab_a[i];
            f32x16 yd, yo;
#pragma unroll
            for (int r = 0; r < 16; ++r) { yd[r] = 0.f; yo[r] = 0.f; }
            const int p = 32 * ph + l31;
#pragma unroll 1
            for (int jt = 0; jt <= it; ++jt) {
                f32x16 m;
                const LAS f4* gt = (const LAS f4*)(ldr + GT_OFF + (jt + it) * 4096);
#pragma unroll
                for (int q = 0; q < 4; ++q) {
                    const f4 gv = gt[q * 64 + lane]; const int jb = 32 * jt + 8 * q + 4 * h;
                    const f4 aj = *(const LAS f4*)(tab_a + jb), dj = *(const LAS f4*)(tab_d + jb);
#pragma unroll
                    for (int e = 0; e < 4; ++e) { const float v = gv[e] * __builtin_amdgcn_exp2f(fminf(a2i - aj[e], 0.f)) * dj[e]; m[4 * q + e] = (jb + e <= i) ? v : 0.f; }
                    __builtin_amdgcn_sched_barrier(0);
                }
#pragma unroll
                for (int s = 0; s < 2; ++s) {
                    const half8 pa = ld2x8(ldr, xt_addr(hl, p, 4 * jt + 2 * s) + 8 * h, xt_addr(hl, p, 4 * jt + 2 * s + 1) + 8 * h);
                    yd = MFMA16(pa, pack_step(m, s), yd);
                    __builtin_amdgcn_sched_barrier(0);
                }
            }
#pragma unroll
            for (int nt = 0; nt < 4; ++nt)
#pragma unroll
                for (int s = 0; s < 2; ++s) {
                    const half8 pb = ld2x8(ldr, cs_addr(i, 4 * nt + 2 * s) + 8 * h, cs_addr(i, 4 * nt + 2 * s + 1) + 8 * h);
                    yo = MFMA16(pack_step(S[nt], s), pb, yo);
                    __builtin_amdgcn_sched_barrier(0);
                }
            const float sci = __builtin_amdgcn_exp2f(a2i);
            const unsigned short* zrow = c.ZQ + (size_t)(row0 + i) * 4096 + head * 64; unsigned short* yrow = c.YO + (size_t)(row0 + i) * 4096 + head * 64;
            float ss = 0.f;
#pragma unroll
            for (int q = 0; q < 4; ++q) {
                const int p0 = 32 * ph + 8 * q + 4 * h;
                const f4 zg = bf4(zc[q]);
#pragma unroll
                for (int e = 0; e < 4; ++e) { const int pp = p0 + e;
                    const float xv = (float)*(const LAS _Float16*)(ldr + xt_addr(hl, pp, i >> 3) + 2 * (i & 7));
                    float y = yd[4 * q + e] + sci * yo[4 * q + e] + Dk * xv; y *= zg[e]; yd[4 * q + e] = y; ss += y * y; }
                __builtin_amdgcn_sched_barrier(0);
            }
            ss += __shfl_xor(ss, 32);
            LAS float* red = (LAS float*)(ldw + RED_OFF + it * 2048);
            if (h == 0) red[w * 64 + i] = ss;
            LBAR();
            float tot = 0.f;
#pragma unroll
            for (int ww = 0; ww < 8; ++ww) tot += red[ww * 64 + i];
            float rs = 1.0f;
            if (hh == 0) { if (w == 0 && h == 0) tota[i] = tot; }
            else { tot += tota[i]; rs = __builtin_amdgcn_rsqf(tot * (1.0f / 512.0f) + EPS); if (w == 0 && h == 0) rsv[i] = rs; }
#pragma unroll
            for (int q = 0; q < 4; ++q) { const int p0 = 32 * ph + 8 * q + 4 * h; const f4 nw = nwv[q];
                u2 o; o.x = pg8::cvt_pk_bf16(yd[4 * q] * rs * nw[0], yd[4 * q + 1] * rs * nw[1]); o.y = pg8::cvt_pk_bf16(yd[4 * q + 2] * rs * nw[2], yd[4 * q + 3] * rs * nw[3]);
                *(u2*)(yrow + p0) = o; __builtin_amdgcn_sched_barrier(0); }
            if (!SAMPLE && it == 0) {
#pragma unroll
                for (int q = 0; q < 4; ++q) zc[q] = zn[q];
            }
        }
    }
    u4 fx[4]; unsigned short* fzp = c.YO + (size_t)(row0 + (tid >> 3)) * 4096 + g * 512 + (tid & 7) * 32;
    const bool dofix = FULL && hh == 1 && (tid >> 3) < nvalid;
    if (dofix) {
#pragma unroll
        for (int v = 0; v < 4; ++v) fx[v] = *(const u4*)(fzp + 8 * v);
    }
    {
        const float dk = __builtin_amdgcn_exp2f(a2_last);
#pragma unroll
        for (int t = 0; t < 4; ++t)
#pragma unroll
            for (int r = 0; r < 16; ++r) S[t][r] *= dk;
#pragma unroll 1
        for (int s = 0; s < 4; ++s) {
            const half8 w8 = *(const LAS half8*)(tab_w + 16 * s + 8 * h);
            const half8 xw = *(const LAS half8*)(ldr + xt_addr(hl, 32 * ph + l31, 2 * s + h)) * w8;
#pragma unroll
            for (int nt = 0; nt < 4; ++nt) S[nt] = MFMA16(*(const LAS half8*)(ldr + bt_addr(32 * nt + l31, 2 * s + h)), xw, S[nt]);
            __builtin_amdgcn_sched_barrier(0);
        }
    }
    LBAR();
    if (dofix) {
        const float rs = ((const LAS float*)(ldr + RS_OFF))[tid >> 3];
#pragma unroll
        for (int v = 0; v < 4; ++v) { const u4 x = fx[v]; u4 o;
            o.x = pg8::cvt_pk_bf16(__uint_as_float(x.x << 16) * rs, __uint_as_float(x.x & 0xffff0000u) * rs); o.y = pg8::cvt_pk_bf16(__uint_as_float(x.y << 16) * rs, __uint_as_float(x.y & 0xffff0000u) * rs);
            o.z = pg8::cvt_pk_bf16(__uint_as_float(x.z << 16) * rs, __uint_as_float(x.z & 0xffff0000u) * rs); o.w = pg8::cvt_pk_bf16(__uint_as_float(x.w << 16) * rs, __uint_as_float(x.w & 0xffff0000u) * rs);
            *(u4*)(fzp + 8 * v) = o; }
    }
}
__device__ __forceinline__ void state_store_native(float* dst, const f32x16 (&S)[4], int lane, int ph) {
#pragma unroll
    for (int nt = 0; nt < 4; ++nt)
#pragma unroll
        for (int q = 0; q < 4; ++q) *(f4*)(dst + ((size_t)((nt * 2 + ph) * 4 + q) * 64 + lane) * 4) = (f4){S[nt][4 * q], S[nt][4 * q + 1], S[nt][4 * q + 2], S[nt][4 * q + 3]};
}
__device__ __forceinline__ void state_load_native(const float* src, f32x16 (&S)[4], int lane, int ph) {
#pragma unroll
    for (int nt = 0; nt < 4; ++nt)
#pragma unroll
        for (int q = 0; q < 4; ++q) { const f4 v = *(const f4*)(src + ((size_t)((nt * 2 + ph) * 4 + q) * 64 + lane) * 4); S[nt][4 * q] = v[0]; S[nt][4 * q + 1] = v[1]; S[nt][4 * q + 2] = v[2]; S[nt][4 * q + 3] = v[3]; }
}
__device__ __forceinline__ void state_store_pn(float* dst, const f32x16 (&S)[4], int lane, int ph) {
    const int l31 = lane & 31, h = lane >> 5;
#pragma unroll
    for (int nt = 0; nt < 4; ++nt)
#pragma unroll
        for (int q = 0; q < 4; ++q) *(f4*)(dst + (size_t)(32 * ph + l31) * NST + 32 * nt + 8 * q + 4 * h) = (f4){S[nt][4 * q], S[nt][4 * q + 1], S[nt][4 * q + 2], S[nt][4 * q + 3]};
}
__device__ __forceinline__ void state_load_pn(const float* src, f32x16 (&S)[4], int lane, int ph) {
    const int l31 = lane & 31, h = lane >> 5;
#pragma unroll
    for (int nt = 0; nt < 4; ++nt)
#pragma unroll
        for (int q = 0; q < 4; ++q) { const f4 v = *(const f4*)(src + (size_t)(32 * ph + l31) * NST + 32 * nt + 8 * q + 4 * h); S[nt][4 * q] = v[0]; S[nt][4 * q + 1] = v[1]; S[nt][4 * q + 2] = v[2]; S[nt][4 * q + 3] = v[3]; }
}
__device__ __forceinline__ void pass1_unit(const Frame& F, const Ctx& c, int u, float* seg, float* segdec) {
    const int sg = u >> 2, g = u & 3, hl = F.wave >> 1, ph = F.wave & 1;
#pragma unroll 1
    for (int hh = 0; hh < 2; ++hh) {
        const int head = g * 8 + hh * 4 + hl;
        f32x16 S[4];
#pragma unroll
        for (int t = 0; t < 4; ++t)
#pragma unroll
            for (int r = 0; r < 16; ++r) S[t][r] = 0.f;
        float dec2 = 0.f;
#pragma unroll 1
        for (int ch = 0; ch < 4; ++ch) { const int row0 = sg * 256 + ch * 64; chunk<false, false>(F, c, g, hh, row0, 0, ch, S, dec2, hh, c.BCC + ((size_t)u * 4 + ch) * 53248); }
        state_store_native(seg + ((size_t)sg * NHS + head) * 8192, S, F.lane, ph);
        if (F.lane == 0 && ph == 0) segdec[sg * NHS + head] = __builtin_amdgcn_exp2f(dec2);
        __syncthreads();
    }
}
__device__ __forceinline__ void pass2_unit(const Frame& F, const Ctx& c, int u, const float* seg, const float* state_ssm, float* out) {
    const int g = u & 3, hl = F.wave >> 1, ph = F.wave & 1;
#pragma unroll 1
    for (int hh = 0; hh < 2; ++hh) {
        const int head = g * 8 + hh * 4 + hl;
        f32x16 S[4]; float dec2 = 0.f;
        if (u < 256) {
            const int sg = u >> 2;
            state_load_native(seg + ((size_t)sg * NHS + head) * 8192, S, F.lane, ph);
#pragma unroll 1
            for (int ch = 0; ch < 4; ++ch) { const int row0 = sg * 256 + ch * 64; chunk<true, false>(F, c, g, hh, row0, 0, ch, S, dec2, hh, c.BCC + ((size_t)u * 4 + ch) * 53248); }
            if (sg == 63) state_store_pn(out + O_PSSM + (size_t)head * PH * NST, S, F.lane, ph);
        } else {
            const int b = (u - 256) >> 2;
            state_load_pn(state_ssm + ((size_t)b * NHS + head) * PH * NST, S, F.lane, ph);
            chunk<true, true>(F, c, g, hh, TP + b * 32, b, 0, S, dec2);
            state_store_pn(out + O_SSSM + ((size_t)b * NHS + head) * PH * NST, S, F.lane, ph);
        }
        __syncthreads();
    }
}
__device__ __forceinline__ void combine(const Frame& F, float* seg, const float* segdec) {
    const int gid = blockIdx.x * 512 + F.tid;
    if (gid < 65536) {
        const int head = gid >> 11; f4 R = {0.f, 0.f, 0.f, 0.f};
        f4* p = (f4*)seg + gid;
#pragma unroll 8
        for (int s = 0; s < 64; ++s) { const f4 t = p[(size_t)s * 65536]; const float d = segdec[s * NHS + head]; p[(size_t)s * 65536] = R; R = R * d + t; }
    }
}
#undef MFMA16
#undef LBAR
}
namespace att {
using bf16x8 = __attribute__((ext_vector_type(8))) short;
using s16x4  = __attribute__((ext_vector_type(4))) short;
using f32x16 = __attribute__((ext_vector_type(16))) float;
using u32x4  = __attribute__((ext_vector_type(4))) unsigned;
constexpr int SHM_K = 17408, SHM_V = 16384, WREG = 17408;
constexpr int V_OFF = 0, K_OFF = 2 * SHM_V, TAB_OFF = 8 * WREG  , TAB_STRIDE = 1028  , LI_OFF = TAB_OFF + 16 * TAB_STRIDE  ;
#ifndef ATSEC
#define ATSEC -1
#endif
#define ATS(k) do { if (ATSEC == (k) && F.tid == 0) atst = __builtin_amdgcn_s_memrealtime(); } while (0)
#define ATE(k) do { if (ATSEC == (k) && F.tid == 0) { F.MISC[17] += (unsigned)(__builtin_amdgcn_s_memrealtime() - atst); } } while (0)
#define KSWZ(row, colB) ((row) * 272 + (colB))
#define SBAR() __builtin_amdgcn_sched_barrier(0)
__device__ __forceinline__ int crow(int r, int hi) { return (r & 3) + 8 * (r >> 2) + 4 * hi; }
__device__ __forceinline__ unsigned cvtpk(float lo, float hi) { unsigned r; asm volatile("v_cvt_pk_bf16_f32 %0, %1, %2" : "=v"(r) : "v"(lo), "v"(hi)); return r; }
__device__ __forceinline__ int v_st(int k, int c) { const int kk = (k & ~0xC) | ((k & 4) << 1) | ((k & 8) >> 1); return ((kk >> 3) * 4 + (c >> 5)) * 512 + ((kk & 7) * 32 + (c & 31)) * 2; }
__device__ __forceinline__ int v_rd_base(int lane) { return ((lane & 3) << 3) | (((lane >> 2) & 3) << 6) | (((lane >> 4) & 1) << 5) | (((lane >> 5) & 1) << 8); }
constexpr int v_rd_off(int d0, int ks, int half) { return d0 * 512 + ks * 4096 + half * 2048; }
template <int OFF> __device__ __forceinline__ s16x4 tr_read(int vb) { s16x4 r; asm volatile("ds_read_b64_tr_b16 %0, %1 offset:%2" : "=&v"(r) : "v"(vb), "i"(OFF) : "memory"); return r; }
__device__ __forceinline__ void qkt(f32x16& p0, f32x16& p1, const LAS unsigned char* Ks, const bf16x8* qr, int r32, int hi) {
#pragma unroll
    for (int r = 0; r < 16; ++r) { p0[r] = 0.f; p1[r] = 0.f; }
#pragma unroll
    for (int d0 = 0; d0 < 8; ++d0) { const int cb = (d0 * 16 + hi * 8) * 2;
        const bf16x8 b0 = *(const LAS bf16x8*)(Ks + KSWZ(r32, cb)), b1 = *(const LAS bf16x8*)(Ks + KSWZ(32 + r32, cb));
        p0 = __builtin_amdgcn_mfma_f32_32x32x16_bf16(b0, qr[d0], p0, 0, 0, 0);
        p1 = __builtin_amdgcn_mfma_f32_32x32x16_bf16(b1, qr[d0], p1, 0, 0, 0);
        if (d0 & 1) SBAR(); }
}
template <int D0> __device__ __forceinline__ void pv_one(f32x16& od, int vb, bf16x8 pa0, bf16x8 pa1, bf16x8 pa2, bf16x8 pa3) {
    const s16x4 l0 = tr_read<v_rd_off(D0, 0, 0)>(vb), h0 = tr_read<v_rd_off(D0, 0, 1)>(vb), l1 = tr_read<v_rd_off(D0, 1, 0)>(vb), h1 = tr_read<v_rd_off(D0, 1, 1)>(vb);
    const s16x4 l2 = tr_read<v_rd_off(D0, 2, 0)>(vb), h2 = tr_read<v_rd_off(D0, 2, 1)>(vb), l3 = tr_read<v_rd_off(D0, 3, 0)>(vb), h3 = tr_read<v_rd_off(D0, 3, 1)>(vb);
    asm volatile("s_waitcnt lgkmcnt(0)" ::: "memory"); SBAR();
#define PK(L, H) (bf16x8){L[0], L[1], L[2], L[3], H[0], H[1], H[2], H[3]}
    od = __builtin_amdgcn_mfma_f32_32x32x16_bf16(pa0, PK(l0, h0), od, 0, 0, 0);
    od = __builtin_amdgcn_mfma_f32_32x32x16_bf16(pa1, PK(l1, h1), od, 0, 0, 0);
    od = __builtin_amdgcn_mfma_f32_32x32x16_bf16(pa2, PK(l2, h2), od, 0, 0, 0);
    od = __builtin_amdgcn_mfma_f32_32x32x16_bf16(pa3, PK(l3, h3), od, 0, 0, 0);
#undef PK
}
__device__ __forceinline__ void pack_p(const f32x16& p0, const f32x16& p1, bf16x8& pa0, bf16x8& pa1, bf16x8& pa2, bf16x8& pa3) {
#define PK4(P, BASE, OUT) do { unsigned a0 = cvtpk(P[BASE + 0], P[BASE + 1]), a1 = cvtpk(P[BASE + 2], P[BASE + 3]);   \
    unsigned b0 = cvtpk(P[BASE + 4], P[BASE + 5]), b1 = cvtpk(P[BASE + 6], P[BASE + 7]);                              \
    auto r0 = __builtin_amdgcn_permlane32_swap(a0, b0, false, false); auto r1 = __builtin_amdgcn_permlane32_swap(a1, b1, false, false); \
    u32x4 w = {r0[0], r1[0], r0[1], r1[1]}; OUT = __builtin_bit_cast(bf16x8, w); } while (0)
    PK4(p0, 0, pa0); PK4(p0, 8, pa1); PK4(p1, 0, pa2); PK4(p1, 8, pa3);
#undef PK4
}

template <int KH, int D0> __device__ __forceinline__ void pv_half(f32x16& od, int vb, bf16x8 pa0, bf16x8 pa1) {
    const s16x4 l0 = tr_read<v_rd_off(D0, 2 * KH, 0)>(vb), h0 = tr_read<v_rd_off(D0, 2 * KH, 1)>(vb), l1 = tr_read<v_rd_off(D0, 2 * KH + 1, 0)>(vb), h1 = tr_read<v_rd_off(D0, 2 * KH + 1, 1)>(vb);
    asm volatile("s_waitcnt lgkmcnt(0)" ::: "memory"); SBAR();
    od = __builtin_amdgcn_mfma_f32_32x32x16_bf16(pa0, ((bf16x8){l0[0], l0[1], l0[2], l0[3], h0[0], h0[1], h0[2], h0[3]}), od, 0, 0, 0);
    od = __builtin_amdgcn_mfma_f32_32x32x16_bf16(pa1, ((bf16x8){l1[0], l1[1], l1[2], l1[3], h1[0], h1[1], h1[2], h1[3]}), od, 0, 0, 0);
}
template <int KH> __device__ __forceinline__ void half_tile(f32x16 (&o)[4], float& l_reg, const LAS unsigned char* Ks, int vb, const bf16x8* qr, const LAS float* tab, bool far_, float cfar, int base, int r32, int hi) {
    f32x16 p;
#pragma unroll
    for (int r = 0; r < 16; ++r) p[r] = 0.f;
#pragma unroll
    for (int d0 = 0; d0 < 8; ++d0) { const bf16x8 kf = *(const LAS bf16x8*)(Ks + KSWZ(32 * KH + r32, (d0 * 16 + hi * 8) * 2)); p = __builtin_amdgcn_mfma_f32_32x32x16_bf16(kf, qr[d0], p, 0, 0, 0); if ((d0 & 3) == 3) SBAR(); }
    float ps = 0.f;
    if (far_) {
#pragma unroll
        for (int r = 0; r < 16; ++r) { p[r] = __builtin_amdgcn_exp2f(p[r] + cfar); ps += p[r]; }
    } else {
#pragma unroll
        for (int r = 0; r < 16; ++r) { const int i0 = min(base - 32 * KH - crow(r, hi), 256); p[r] = __builtin_amdgcn_exp2f(p[r] + tab[i0]); ps += p[r]; }
    }
    l_reg += ps;
    bf16x8 pa0, pa1;
#define PK4(P, BASE, OUT) do { unsigned a0 = cvtpk(P[BASE + 0], P[BASE + 1]), a1 = cvtpk(P[BASE + 2], P[BASE + 3]);   \
    unsigned b0 = cvtpk(P[BASE + 4], P[BASE + 5]), b1 = cvtpk(P[BASE + 6], P[BASE + 7]);                              \
    auto r0 = __builtin_amdgcn_permlane32_swap(a0, b0, false, false); auto r1 = __builtin_amdgcn_permlane32_swap(a1, b1, false, false); \
    u32x4 w = {r0[0], r1[0], r0[1], r1[1]}; OUT = __builtin_bit_cast(bf16x8, w); } while (0)
    PK4(p, 0, pa0); PK4(p, 8, pa1);
#undef PK4
    pv_half<KH, 0>(o[0], vb, pa0, pa1); pv_half<KH, 1>(o[1], vb, pa0, pa1); pv_half<KH, 2>(o[2], vb, pa0, pa1); pv_half<KH, 3>(o[3], vb, pa0, pa1);
    SBAR();
}
typedef bf16x8 bf16x8_t;
struct Ctx { int abl; unsigned short* ZQ; unsigned short* O; const unsigned short* Kb; const unsigned short* Vb; const unsigned short* Gb; const float* rel_bias; const float* qw; const float* kw; };
__device__ __forceinline__ void load_bias_tabs(const Frame& F, const Ctx& c) {
    float mq = 0.f, mk = 0.f;
    for (int i = F.lane; i < 128; i += 64) { mq = fmaxf(mq, fabsf(c.qw[i])); mk = fmaxf(mk, fabsf(c.kw[i])); }
#pragma unroll
    for (int o = 1; o < 64; o <<= 1) { mq = fmaxf(mq, __shfl_xor(mq, o)); mk = fmaxf(mk, __shfl_xor(mk, o)); }
    for (int h = F.wave; h < NHA; h += NWAVES) {
        const float* rb = c.rel_bias + (size_t)h * 257; float v[5]; float mb = -1e30f;
#pragma unroll
        for (int t = 0; t < 5; ++t) { const int i = F.lane + 64 * t; v[t] = i < 257 ? rb[i] : -1e30f; mb = fmaxf(mb, v[t]); }
#pragma unroll
        for (int o = 1; o < 64; o <<= 1) mb = fmaxf(mb, __shfl_xor(mb, o));
        const float moff = 16.3222312f * mq * mk + mb * 1.4426950408889634f;
        LAS float* tab = (LAS float*)(F.lds + TAB_OFF + h * TAB_STRIDE);
#pragma unroll
        for (int t = 0; t < 5; ++t) { const int i = F.lane + 64 * t; if (i < 257) tab[i] = v[t] * 1.4426950408889634f - moff; }
    }
    __syncthreads();
}
template <int KH> __device__ __forceinline__ void half_tile_x(f32x16 (&o)[4], float& l_reg, const LAS unsigned char* Ks, int vb, const bf16x8* qr, const LAS float* tab, bool far_, float cfar, int base, int r32, int hi) {
    s16x4 vl[2][2], vh[2][2];
#define TRD(S, D0) vl[S][0] = tr_read<v_rd_off(D0, 2 * KH, 0)>(vb); vh[S][0] = tr_read<v_rd_off(D0, 2 * KH, 1)>(vb); vl[S][1] = tr_read<v_rd_off(D0, 2 * KH + 1, 0)>(vb); vh[S][1] = tr_read<v_rd_off(D0, 2 * KH + 1, 1)>(vb)
    TRD(0, 0); TRD(1, 1);
    f32x16 p;
#pragma unroll
    for (int r = 0; r < 16; ++r) p[r] = 0.f;
    int kb_[4];
#pragma unroll
    for (int m = 0; m < 4; ++m) kb_[m] = 256 * r32 + ((((2 * m + hi) ^ (r32 & 7))) << 4);
#pragma unroll
    for (int d0 = 0; d0 < 8; ++d0) { const bf16x8 kf = *(const LAS bf16x8*)(Ks + kb_[d0 & 3] + (d0 >> 2) * 128 + KH * 8192); p = __builtin_amdgcn_mfma_f32_32x32x16_bf16(kf, qr[d0], p, 0, 0, 0); }
    float ps = 0.f;
    if (far_) {
#pragma unroll
        for (int r = 0; r < 16; ++r) { p[r] = __builtin_amdgcn_exp2f(p[r] + cfar); ps += p[r]; }
    } else {
#pragma unroll
        for (int r = 0; r < 16; ++r) { const int i0 = min(base - 32 * KH - crow(r, hi), 256); p[r] = __builtin_amdgcn_exp2f(p[r] + tab[i0]); ps += p[r]; }
    }
    l_reg += ps;
    bf16x8 pa0, pa1;
#define PK4(P, BASE, OUT) do { unsigned a0 = cvtpk(P[BASE + 0], P[BASE + 1]), a1 = cvtpk(P[BASE + 2], P[BASE + 3]);   \
    unsigned b0 = cvtpk(P[BASE + 4], P[BASE + 5]), b1 = cvtpk(P[BASE + 6], P[BASE + 7]);                              \
    auto r0 = __builtin_amdgcn_permlane32_swap(a0, b0, false, false); auto r1 = __builtin_amdgcn_permlane32_swap(a1, b1, false, false); \
    u32x4 w = {r0[0], r1[0], r0[1], r1[1]}; OUT = __builtin_bit_cast(bf16x8, w); } while (0)
    PK4(p, 0, pa0); PK4(p, 8, pa1);
#undef PK4
#define PVS(S, D0) do { \
        o[D0] = __builtin_amdgcn_mfma_f32_32x32x16_bf16(pa0, ((bf16x8){vl[S][0][0], vl[S][0][1], vl[S][0][2], vl[S][0][3], vh[S][0][0], vh[S][0][1], vh[S][0][2], vh[S][0][3]}), o[D0], 0, 0, 0); \
        o[D0] = __builtin_amdgcn_mfma_f32_32x32x16_bf16(pa1, ((bf16x8){vl[S][1][0], vl[S][1][1], vl[S][1][2], vl[S][1][3], vh[S][1][0], vh[S][1][1], vh[S][1][2], vh[S][1][3]}), o[D0], 0, 0, 0); } while (0)
    asm volatile("s_waitcnt lgkmcnt(0)" ::: "memory"); SBAR();
    PVS(0, 0); PVS(1, 1);
    SBAR();
    TRD(0, 2); TRD(1, 3);
    asm volatile("s_waitcnt lgkmcnt(0)" ::: "memory"); SBAR();
    PVS(0, 2); PVS(1, 3);
#undef PVS
#undef TRD
    SBAR();
}
template <int OFF> __device__ __forceinline__ bf16x8 lds_rd16(int a) { bf16x8 r; asm volatile("ds_read_b128 %0, %1 offset:%2" : "=&v"(r) : "v"(a), "i"(OFF) : "memory"); return r; }
template <int N> __device__ __forceinline__ void lds_wait2(bf16x8& a, bf16x8& b) { asm volatile("s_waitcnt lgkmcnt(%2)" : "+v"(a), "+v"(b) : "n"(N) : "memory"); }
__device__ __forceinline__ void tile_qk(float& l_reg, bf16x8& pa0, bf16x8& pa1, bf16x8& pa2, bf16x8& pa3, const LAS unsigned char* Ks, const bf16x8* qr, const LAS float* tab, bool far_, float cfar, int base, int r32, int hi) {
    f32x16 p0, p1;
#pragma unroll
    for (int r = 0; r < 16; ++r) { p0[r] = 0.f; p1[r] = 0.f; }
    int kb_[4];
#pragma unroll
    for (int m = 0; m < 4; ++m) kb_[m] = 256 * r32 + ((((2 * m + hi) ^ (r32 & 7))) << 4);
    const int kA = (int)(unsigned)(size_t)Ks;
    int ka[8];
#pragma unroll
    for (int m = 0; m < 4; ++m) { ka[m] = kA + kb_[m] + ((r32 & 8) << 4); ka[4 + m] = ka[m] ^ 128; }
    bf16x8 kf[8][2];
#define KRD(D) do { kf[D][0] = lds_rd16<0>(ka[D]); kf[D][1] = lds_rd16<8192>(ka[D]); } while (0)
#define KMM(D, N) do { lds_wait2<N>(kf[D][0], kf[D][1]); p0 = __builtin_amdgcn_mfma_f32_32x32x16_bf16(kf[D][0], qr[D], p0, 0, 0, 0); p1 = __builtin_amdgcn_mfma_f32_32x32x16_bf16(kf[D][1], qr[D], p1, 0, 0, 0); } while (0)
    asm volatile("s_waitcnt lgkmcnt(0)" ::: "memory");
    KRD(0); KRD(1);
    KRD(2); KMM(0, 4); KRD(3); KMM(1, 4); KRD(4); KMM(2, 4); KRD(5); KMM(3, 4); KRD(6); KMM(4, 4); KRD(7); KMM(5, 4); KMM(6, 2); KMM(7, 0);
#undef KRD
#undef KMM
    SBAR();
    float ps0 = 0.f, ps1 = 0.f;
    if (far_) {
#pragma unroll
        for (int r = 0; r < 16; ++r) { p0[r] = __builtin_amdgcn_exp2f(p0[r] + cfar); p1[r] = __builtin_amdgcn_exp2f(p1[r] + cfar); ps0 += p0[r]; ps1 += p1[r]; }
    } else {
#pragma unroll
        for (int r = 0; r < 16; ++r) { const int kk = crow(r, hi); const int i0 = min(base - kk, 256), i1 = min(base - 32 - kk, 256);
            p0[r] = __builtin_amdgcn_exp2f(p0[r] + tab[i0]); p1[r] = __builtin_amdgcn_exp2f(p1[r] + tab[i1]); ps0 += p0[r]; ps1 += p1[r]; }
    }
    l_reg += ps0 + ps1;
    pack_p(p0, p1, pa0, pa1, pa2, pa3);
    SBAR();
}
__device__ __forceinline__ void tile_pv(f32x16 (&o)[4], int vb, bf16x8 pa0, bf16x8 pa1, bf16x8 pa2, bf16x8 pa3) {
    s16x4 vla[4], vha[4], vlb[4], vhb[4];
#define TRD(VL, VH, D0) VL[0] = tr_read<v_rd_off(D0, 0, 0)>(vb); VH[0] = tr_read<v_rd_off(D0, 0, 1)>(vb); VL[1] = tr_read<v_rd_off(D0, 1, 0)>(vb); VH[1] = tr_read<v_rd_off(D0, 1, 1)>(vb); \
                VL[2] = tr_read<v_rd_off(D0, 2, 0)>(vb); VH[2] = tr_read<v_rd_off(D0, 2, 1)>(vb); VL[3] = tr_read<v_rd_off(D0, 3, 0)>(vb); VH[3] = tr_read<v_rd_off(D0, 3, 1)>(vb)
#define PVD(VL, VH, D0) do { \
        o[D0] = __builtin_amdgcn_mfma_f32_32x32x16_bf16(pa0, ((bf16x8){VL[0][0], VL[0][1], VL[0][2], VL[0][3], VH[0][0], VH[0][1], VH[0][2], VH[0][3]}), o[D0], 0, 0, 0); \
        o[D0] = __builtin_amdgcn_mfma_f32_32x32x16_bf16(pa1, ((bf16x8){VL[1][0], VL[1][1], VL[1][2], VL[1][3], VH[1][0], VH[1][1], VH[1][2], VH[1][3]}), o[D0], 0, 0, 0); \
        o[D0] = __builtin_amdgcn_mfma_f32_32x32x16_bf16(pa2, ((bf16x8){VL[2][0], VL[2][1], VL[2][2], VL[2][3], VH[2][0], VH[2][1], VH[2][2], VH[2][3]}), o[D0], 0, 0, 0); \
        o[D0] = __builtin_amdgcn_mfma_f32_32x32x16_bf16(pa3, ((bf16x8){VL[3][0], VL[3][1], VL[3][2], VL[3][3], VH[3][0], VH[3][1], VH[3][2], VH[3][3]}), o[D0], 0, 0, 0); } while (0)
    asm volatile("s_waitcnt lgkmcnt(0)" ::: "memory");
    TRD(vla, vha, 0); TRD(vlb, vhb, 1); asm volatile("s_waitcnt lgkmcnt(8)" ::: "memory"); SBAR();
    PVD(vla, vha, 0); SBAR(); TRD(vla, vha, 2); asm volatile("s_waitcnt lgkmcnt(8)" ::: "memory"); SBAR();
    PVD(vlb, vhb, 1); SBAR(); TRD(vlb, vhb, 3); asm volatile("s_waitcnt lgkmcnt(8)" ::: "memory"); SBAR();
    PVD(vla, vha, 2); SBAR(); asm volatile("s_waitcnt lgkmcnt(0)" ::: "memory"); SBAR();
    PVD(vlb, vhb, 3);
#undef PVD
#undef TRD
    SBAR();
}
constexpr int PF_DUMP_OFF = 131072;
__device__ __forceinline__ void prompt_unit(const Frame& F, const Ctx& c, int h, int cq, const float* pfk, const float* pfv, int pfb0, int pfh0, int pfb1, int pfh1, int pft0, int pfn, bf16x8 (&qr)[8], bool haveq, int nh, int ncq) {
    const LAS unsigned char* ldr = F.lds; LAS unsigned char* ldw = F.lds;
    int pz_; asm volatile("v_mov_b32 %0, 0" : "=v"(pz_));
    const int wid = F.wave, lane = lane_now() + pz_, tid = wid * 64 + lane, pw = wid >> 1;
    const LAS float* tab = (const LAS float*)(ldr + TAB_OFF + h * TAB_STRIDE);
    unsigned long long atst = 0; (void)atst; ATS(0); ATS(7);
    f32x16 o[4]; float l_reg = 0.f;
#pragma unroll
    for (int d = 0; d < 4; ++d)
#pragma unroll
        for (int r = 0; r < 16; ++r) o[d][r] = 0.f;
    {
        if (!haveq) {
            const unsigned short* Qw = c.ZQ + (size_t)(cq * 256 + wid * 32 + (lane & 31)) * 4096 + 2048 + h * HD + (lane >> 5) * 8;
#pragma unroll
            for (int d0 = 0; d0 < 8; ++d0) qr[d0] = *(const bf16x8*)(Qw + d0 * 16);
        }
#pragma unroll
        for (int d0 = 0; d0 < 8; ++d0) asm volatile("" : "+v"(qr[d0]));
    }
    asm volatile("s_waitcnt vmcnt(0)" ::: "memory");
    ATE(0);
    const int jstart = cq < 2 ? 8 - 4 * cq : 0;
    const unsigned short* Kh = c.Kb + h * HD; const unsigned short* Vh = c.Vb + h * HD;
#define DMA_TILE(j) do { const size_t t0 = (size_t)((4 * ((c.abl & 8) ? 2 : cq) - 8 + (j)) * 64) * 2048; const int sl = ((j) & 3) * 32768; \
    int dz_; asm volatile("v_mov_b32 %0, 0" : "=v"(dz_)); const int ld_ = lane + dz_; \
    _Pragma("unroll") for (int i = 0; i < 2; ++i) { const int pc = 2 * wid + i; \
        const int r = 4 * pc + (ld_ >> 4), chp = ld_ & 15; const unsigned ksrc = (unsigned)(r * 2048 + ((chp ^ (r & 15)) << 3)); \
        const int st = 2 * pc + (ld_ >> 5), kk = 8 * (st >> 2) + ((ld_ & 31) >> 2), k = (kk & ~0xC) | ((kk & 4) << 1) | ((kk & 8) >> 1), cc = 32 * (st & 3) + 8 * (ld_ & 3); \
        const unsigned vsrc = (unsigned)(k * 2048 + cc); \
        __builtin_amdgcn_global_load_lds((const unsigned*)(Kh + t0 + ksrc), (LAS unsigned*)(ldw + sl + pc * 1024), 16, 0, 0); \
        __builtin_amdgcn_global_load_lds((const unsigned*)(Vh + t0 + vsrc), (LAS unsigned*)(ldw + sl + 16384 + pc * 1024), 16, 0, 0); } } while (0)
    DMA_TILE(jstart); DMA_TILE(jstart + 1);
    bf16x8 pa0, pa1, pa2, pa3; bool pend = false; int vbp = 0; bool pfprev = false;
    const bool lag = wid >= 4;
#pragma unroll 1
    for (int j = jstart; j < 12; ++j) {
        ATS(1);
        if (j == 11) asm volatile("s_waitcnt vmcnt(0)" ::: "memory"); else if (pfprev) asm volatile("s_waitcnt vmcnt(5)" ::: "memory"); else asm volatile("s_waitcnt vmcnt(4)" ::: "memory");
        __builtin_amdgcn_s_barrier(); asm volatile("" ::: "memory");
        ATE(1); ATS(2);
        pfprev = false;
        if (j + 2 < 12) {
            const int tt = j - jstart;
            if (tt < pfn) {
                const int t = pft0 + tt, un = t >> 3, rg = (t & 7) >> 1, kv = t & 1;
                int pz2_; asm volatile("v_mov_b32 %0, 0" : "=v"(pz2_)); const int lp = lane + pz2_;
                const int pb = un ? pfb1 : pfb0, phd = un ? pfh1 : pfh0;
                const size_t off = (((size_t)pb * 512 + wid * 64 + 16 * rg + (lp >> 2)) * NHA + phd) * HD + (lp & 3) * 32;
                const float* pbase = pfk; if (kv) pbase = pfv;
                __builtin_amdgcn_global_load_lds((const unsigned*)(pbase + off), (LAS unsigned*)(ldw + PF_DUMP_OFF + wid * 256), 4, 0, 0);
                pfprev = true;
            }
            DMA_TILE(j + 2);
        }
        ATE(2);
        if (lag && pend) { if (!(c.abl & 1)) tile_pv(o, vbp, pa0, pa1, pa2, pa3); pend = false; }
        const int dl = pw + 8 - j;
        if (dl >= 0 && dl <= 8 && !(c.abl & 4)) {
            int lz_; asm volatile("v_mov_b32 %0, 0" : "=v"(lz_)); const int lz = lane + lz_, r32z = lz & 31, hiz = lz >> 5;
            const int sl = (j & 3) * 32768;
            const int vb = (int)(unsigned)(size_t)(F.lds) + sl + 16384 + v_rd_base(lz); const int base = 128 + 64 * dl + 32 * (wid & 1) + r32z;
            const float cfar = tab[256];
            ATS(3);
            if (!(c.abl & 2)) tile_qk(l_reg, pa0, pa1, pa2, pa3, ldr + sl, qr, tab, dl >= 3, cfar, base, r32z, hiz);
            ATE(3); ATS(4);
            if (lag) { pend = true; vbp = vb; } else if (!(c.abl & 1)) tile_pv(o, vb, pa0, pa1, pa2, pa3);
            ATE(4);
        }
    }
    if (lag && pend && !(c.abl & 1)) tile_pv(o, vbp, pa0, pa1, pa2, pa3);
#undef DMA_TILE
    ATS(5);
    const size_t rowbase = (size_t)(cq * 256 + wid * 32); const int rr0 = lane >> 4, cg = (lane & 15) * 8;
    u32x4 gv[8];
#pragma unroll
    for (int i = 0; i < 8; ++i) gv[i] = *(const u32x4*)(c.Gb + (rowbase + rr0 + 4 * i) * 2048 + h * HD + cg);
    if (nh >= 0) {
        const unsigned short* Qn = c.ZQ + (size_t)(ncq * 256 + wid * 32 + (lane & 31)) * 4096 + 2048 + nh * HD + (lane >> 5) * 8;
#pragma unroll
        for (int d0 = 0; d0 < 8; ++d0) qr[d0] = *(const bf16x8*)(Qn + d0 * 16);
    }
    __builtin_amdgcn_s_barrier(); asm volatile("" ::: "memory");
    ATE(5); ATS(6);
    const int r32 = lane & 31, hi = lane >> 5;
    { auto rr = __builtin_amdgcn_permlane32_swap(__float_as_uint(l_reg), __float_as_uint(l_reg), false, false); l_reg = __uint_as_float(rr[0]) + __uint_as_float(rr[1]); }
    LAS float* li = (LAS float*)(ldw + LI_OFF) + wid * 32;
    if (hi == 0) li[r32] = l_reg;
    asm volatile("s_waitcnt lgkmcnt(0)" ::: "memory");
    LAS float* po = (LAS float*)(ldw + wid * 16384);
#pragma unroll
    for (int r = 0; r < 16; ++r) { const int orow = crow(r, hi); const float rl = __builtin_amdgcn_rcpf(li[orow]);
#pragma unroll
        for (int d0 = 0; d0 < 4; ++d0) po[orow * 128 + d0 * 32 + r32] = o[d0][r] * rl; }
    asm volatile("s_waitcnt lgkmcnt(0)" ::: "memory");
    {
        typedef float fv4_ __attribute__((ext_vector_type(4)));
#pragma unroll
        for (int i = 0; i < 8; ++i) { const int row = rr0 + 4 * i;
            const fv4_ x = *(const LAS fv4_*)(po + row * 128 + cg), y = *(const LAS fv4_*)(po + row * 128 + cg + 4);
            u32x4 ov; ov.x = cvtpk(x[0] * __uint_as_float(gv[i].x << 16), x[1] * __uint_as_float(gv[i].x & 0xffff0000u)); ov.y = cvtpk(x[2] * __uint_as_float(gv[i].y << 16), x[3] * __uint_as_float(gv[i].y & 0xffff0000u));
            ov.z = cvtpk(y[0] * __uint_as_float(gv[i].z << 16), y[1] * __uint_as_float(gv[i].z & 0xffff0000u)); ov.w = cvtpk(y[2] * __uint_as_float(gv[i].w << 16), y[3] * __uint_as_float(gv[i].w & 0xffff0000u));
            *(u32x4*)(c.O + (rowbase + row) * 4096 + 2048 + h * HD + cg) = ov; }
    }
    ATE(6); ATE(7);
    asm volatile("s_waitcnt lgkmcnt(0)" ::: "memory"); __builtin_amdgcn_s_barrier(); asm volatile("" ::: "memory");
}
typedef float fv4 __attribute__((ext_vector_type(4)));
struct SCtx { unsigned short* ZQ; unsigned short* O; const unsigned short* Kb; const unsigned short* Vb; const unsigned short* Gb; const float* cache_k; const float* cache_v; };
__device__ __forceinline__ bf16x8 cvt8(const fv4 a, const fv4 b) { u32x4 w = {cvtpk(a.x, a.y), cvtpk(a.z, a.w), cvtpk(b.x, b.y), cvtpk(b.z, b.w)}; return __builtin_bit_cast(bf16x8, w); }
__device__ __forceinline__ void sample_unit(const Frame& F, const SCtx& c, int b, int h) {
    const LAS unsigned char* ldr = F.lds; LAS unsigned char* ldw = F.lds;
    int lz_; asm volatile("v_mov_b32 %0, 0" : "=v"(lz_));
    const int wid = F.wave, lane = lane_now() + lz_, tid = wid * 64 + lane, r32 = lane & 31, hi = lane >> 5, srow = lane >> 4, sch = lane & 15;
    const LAS float* tab = (const LAS float*)(ldr + TAB_OFF + h * TAB_STRIDE);
    const int kreg = wid * WREG, vreg = wid * WREG + 8704;
    const int vb = (int)(unsigned)(size_t)(F.lds + vreg) + v_rd_base(lane);
    f32x16 o[4]; float l_reg = 0.f; bf16x8 qr[8];
    fv4 ka[8][2], va[8][2];
#define LDG(DST, SRC, KB) do { const float* p_ = (SRC) + (((size_t)b * 512 + (KB) * 32 + srow) * NHA + h) * HD + sch * 8; \
        _Pragma("unroll") for (int k = 0; k < 8; ++k) { const size_t ro = (size_t)(4 * k) * (NHA * HD); DST[k][0] = *(const fv4*)(p_ + ro); DST[k][1] = *(const fv4*)(p_ + ro + 4); } } while (0)
#define STK() do { _Pragma("unroll") for (int k = 0; k < 8; ++k) *(LAS bf16x8*)(ldw + kreg + KSWZ(4 * k + srow, sch * 16)) = cvt8(ka[k][0], ka[k][1]); } while (0)
#define STV() do { _Pragma("unroll") for (int k = 0; k < 8; ++k) *(LAS bf16x8*)(ldw + vreg + v_st(4 * k + srow, sch * 8)) = cvt8(va[k][0], va[k][1]); } while (0)
#define PK4(P, BASE, OUT) do { unsigned a0 = cvtpk(P[BASE + 0], P[BASE + 1]), a1 = cvtpk(P[BASE + 2], P[BASE + 3]);   \
    unsigned b0 = cvtpk(P[BASE + 4], P[BASE + 5]), b1 = cvtpk(P[BASE + 6], P[BASE + 7]);                              \
    auto r0 = __builtin_amdgcn_permlane32_swap(a0, b0, false, false); auto r1 = __builtin_amdgcn_permlane32_swap(a1, b1, false, false); \
    u32x4 w = {r0[0], r1[0], r0[1], r1[1]}; OUT = __builtin_bit_cast(bf16x8, w); } while (0)
    bf16x8 pa0, pa1;
#define QKS(KB) do { asm volatile("s_waitcnt lgkmcnt(0)" ::: "memory"); f32x16 p0; \
        _Pragma("unroll") for (int r = 0; r < 16; ++r) p0[r] = 0.f; \
        _Pragma("unroll") for (int d0 = 0; d0 < 8; ++d0) { const bf16x8 kf = *(const LAS bf16x8*)(ldr + kreg + KSWZ(r32, (d0 * 16 + hi * 8) * 2)); p0 = __builtin_amdgcn_mfma_f32_32x32x16_bf16(kf, qr[d0], p0, 0, 0, 0); } \
        const int base = r32 + 640 - 32 * (KB);                         \
        float ps = 0.f; \
        _Pragma("unroll") for (int r = 0; r < 16; ++r) { const int i0 = min(base - crow(r, hi), 256); p0[r] = __builtin_amdgcn_exp2f(p0[r] + tab[i0]); ps += p0[r]; } \
        l_reg += ps; PK4(p0, 0, pa0); PK4(p0, 8, pa1); } while (0)
#define PVH(D0, CIN) do { const s16x4 l0 = tr_read<v_rd_off(D0, 0, 0)>(vb), h0 = tr_read<v_rd_off(D0, 0, 1)>(vb), l1 = tr_read<v_rd_off(D0, 1, 0)>(vb), h1 = tr_read<v_rd_off(D0, 1, 1)>(vb); \
    asm volatile("s_waitcnt lgkmcnt(0)" ::: "memory"); SBAR(); \
    o[D0] = __builtin_amdgcn_mfma_f32_32x32x16_bf16(pa0, ((bf16x8){l0[0], l0[1], l0[2], l0[3], h0[0], h0[1], h0[2], h0[3]}), CIN, 0, 0, 0); \
    o[D0] = __builtin_amdgcn_mfma_f32_32x32x16_bf16(pa1, ((bf16x8){l1[0], l1[1], l1[2], l1[3], h1[0], h1[1], h1[2], h1[3]}), o[D0], 0, 0, 0); } while (0)
#define PVS() do { asm volatile("s_waitcnt lgkmcnt(0)" ::: "memory"); PVH(0, o[0]); PVH(1, o[1]); PVH(2, o[2]); PVH(3, o[3]); SBAR(); } while (0)
#define PVS0() do { const f32x16 z16 = {0.f, 0.f, 0.f, 0.f, 0.f, 0.f, 0.f, 0.f, 0.f, 0.f, 0.f, 0.f, 0.f, 0.f, 0.f, 0.f}; asm volatile("s_waitcnt lgkmcnt(0)" ::: "memory"); PVH(0, z16); PVH(1, z16); PVH(2, z16); PVH(3, z16); SBAR(); } while (0)
#define LDQ() do { const unsigned short* Qw = c.ZQ + (size_t)(TP + b * 32 + r32) * 4096 + 2048 + h * HD + hi * 8; _Pragma("unroll") for (int d0 = 0; d0 < 8; ++d0) qr[d0] = *(const bf16x8*)(Qw + d0 * 16); } while (0)
    LDG(ka, c.cache_k, 2 * wid); LDG(va, c.cache_v, 2 * wid); LDQ();
    STK(); SBAR(); LDG(ka, c.cache_k, 2 * wid + 1); SBAR();
    QKS(2 * wid); SBAR();
    STV(); SBAR();
    PVS0();
    LDG(va, c.cache_v, 2 * wid + 1); SBAR();
    STK(); SBAR();
    LDQ(); SBAR();
    QKS(2 * wid + 1); SBAR();
    STV(); SBAR();
    PVS();
    if (wid == 0) {
        const unsigned short* kp = c.Kb + (size_t)(TP + b * 32 + srow) * 2048 + h * HD + sch * 8;
        const unsigned short* vp = c.Vb + (size_t)(TP + b * 32 + srow) * 2048 + h * HD + sch * 8;
        bf16x8 kn[8], vn[8];
#pragma unroll
        for (int k = 0; k < 8; ++k) kn[k] = *(const bf16x8*)(kp + (size_t)(4 * k) * 2048);
#pragma unroll
        for (int k = 0; k < 8; ++k) vn[k] = *(const bf16x8*)(vp + (size_t)(4 * k) * 2048);
#pragma unroll
        for (int k = 0; k < 8; ++k) *(LAS bf16x8*)(ldw + kreg + KSWZ(4 * k + srow, sch * 16)) = kn[k];
        SBAR();
        QKS(16); SBAR();
#pragma unroll
        for (int k = 0; k < 8; ++k) *(LAS bf16x8*)(ldw + vreg + v_st(4 * k + srow, sch * 8)) = vn[k];
        SBAR();
        PVS();
    }
#undef LDG
#undef LDQ
#undef STK
#undef STV
#undef PK4
#undef QKS
#undef PVH
#undef PVS
#undef PVS0
    { auto rr = __builtin_amdgcn_permlane32_swap(__float_as_uint(l_reg), __float_as_uint(l_reg), false, false); l_reg = __uint_as_float(rr[0]) + __uint_as_float(rr[1]); }
    LAS float* po = (LAS float*)(ldw + wid * WREG);
#pragma unroll
    for (int d0 = 0; d0 < 4; ++d0)
#pragma unroll
        for (int r = 0; r < 16; ++r) po[crow(r, hi) * 128 + d0 * 32 + r32] = o[d0][r];
    LAS float* li = (LAS float*)(ldw + LI_OFF);
    if (hi == 0) li[wid * 32 + r32] = l_reg;
    __syncthreads();
    {
        int tz_; asm volatile("v_mov_b32 %0, 0" : "=v"(tz_)); const int tz = tid + tz_, q = tz >> 4, dg = (tz & 15) * 8;
        const size_t row = (size_t)(TP + b * 32 + q);
        const u32x4 gv = *(const u32x4*)(c.Gb + row * 2048 + h * HD + dg);
        float acc[8] = {0.f, 0.f, 0.f, 0.f, 0.f, 0.f, 0.f, 0.f}; float l = 0.f;
#pragma unroll
        for (int w = 0; w < 8; ++w) { const LAS fv4* pp = (const LAS fv4*)(ldr + w * WREG + (q * 128 + dg) * 4); const fv4 x = pp[0], y = pp[1];
            acc[0] += x.x; acc[1] += x.y; acc[2] += x.z; acc[3] += x.w; acc[4] += y.x; acc[5] += y.y; acc[6] += y.z; acc[7] += y.w; l += li[w * 32 + q]; }
        const float rl = __builtin_amdgcn_rcpf(l);
        const unsigned gw[4] = {gv.x, gv.y, gv.z, gv.w}; u32x4 ov; unsigned ow[4];
#pragma unroll
        for (int e = 0; e < 4; ++e) ow[e] = cvtpk(acc[2 * e] * rl * __uint_as_float(gw[e] << 16), acc[2 * e + 1] * rl * __uint_as_float(gw[e] & 0xffff0000u));
        ov.x = ow[0]; ov.y = ow[1]; ov.z = ow[2]; ov.w = ow[3];
        *(u32x4*)(c.O + row * 4096 + 2048 + h * HD + dg) = ov;
    }
    __syncthreads();
}
#undef KSWZ
#undef SBAR
}
struct Args { const float* in[18]; float* out; unsigned char* ws; };
__global__ void __launch_bounds__(NWAVES * 64, 2) hyb_fwd(Args args) {
    extern __shared__ __attribute__((aligned(16))) unsigned char lds[];
    Frame F;
    F.lds = (LAS unsigned char*)lds; F.MISC = (volatile LAS unsigned*)(F.lds + MISC_OFF);
    F.tid = threadIdx.x; F.lane = F.tid & 63; F.wave = __builtin_amdgcn_readfirstlane(F.tid >> 6);
    F.G = gridDim.x; { const int bx = blockIdx.x; F.vcu = (F.G % 8 == 0) ? (bx % 8) * (F.G / 8) + bx / 8 : bx; }
    F.ctl = (gu32*)(args.ws + WS_CTL);
    for (int u = F.tid; u < (LDS_BYTES - LDSCTL_OFF) / 4; u += NWAVES * 64) ((LAS unsigned*)(F.lds + LDSCTL_OFF))[u] = 0u;
    __syncthreads();
    XcdBarrier bar = xcd_barrier_post((unsigned*)(F.ctl + CW_BAR), F.MISC + 8);
    unsigned char* ws = args.ws;
#define OPQ() Frame Fp = F; { Fp.lane = lane_now(); Fp.tid = F.wave * 64 + Fp.lane; }
#define RUN_W() do { OPQ(); p0a_weights(Fp, args.in[7], args.in[17], args.in[6], (bf16*)(ws + WS_WIN), (bf16*)(ws + WS_WDT), (bf16*)(ws + WS_WOUT)); } while (0)
#define RUN_X() do { OPQ(); p0x_rows(Fp, args.in[0], args.in[1], args.in[7], args.in[6], args.in[10], (bf16*)(ws + WS_H), (float*)(ws + WS_RSTD), (float*)(ws + WS_DT)); } while (0)
#define RUN_INPROJ() do { \
        if (F.G == 256 && ((blockIdx.x >> 3) & 1) != 0) { Frame Fq = F; Fq.lane = lane_now(); Fq.tid = F.wave * 64 + Fq.lane;     \
            p0a_wout(Fq, (int)((blockIdx.x >> 4) * 8 + (blockIdx.x & 7)) * NWAVES + F.wave, 128 * NWAVES, args.in[7], args.in[17], args.in[6], (bf16*)(ws + WS_WIN), (bf16*)(ws + WS_WDT), (bf16*)(ws + WS_WOUT)); __syncthreads(); } \
        OPQ(); pg8::Gemm g{(const bf16*)(ws + WS_H), (const bf16*)(ws + WS_WIN), MTOK, NIN, DM, DM}; pg8::StaticOrder S; S.init(MTOK, NIN, F.G, (int)blockIdx.x); \
        pg8::EpiIn E{(const float*)(ws + WS_RSTD), (bf16*)(ws + WS_ZQ), (bf16*)args.out, (bf16*)(ws + WS_K), (bf16*)(ws + WS_V), (bf16*)(ws + WS_G), args.in[14], args.in[15], args.out, (PG8_LAS float*)(F.lds + EPI_P_OFF)}; \
        pg8::gemm_phase<pg8::EpiIn, pg8::StaticOrder, true, true>(F.lds + RING_OFF, g, S, E, Fp.tid); } while (0)
#define SSD_CTX() ssd::Ctx sc{(const unsigned short*)args.out, (const float*)(ws + WS_DT), (bf16*)(ws + WS_ZQ), args.in[8], args.in[9], args.in[11], args.in[12], args.in[13], args.in[2], SSD_YO, ws + WS_WIN}; \
        float* seg = (float*)(ws + WS_SEG); float* segdec = (float*)(ws + WS_SEGDEC); (void)seg; (void)segdec
#define SSD_YO (bf16*)(ws + WS_ZQ)
#define ATT_O (bf16*)(ws + WS_ZQ)
#define DRY_O ((bf16*)args.out - 2048)
#define RUN_SSD1() do { OPQ(); SSD_CTX(); for (int u = blockIdx.x; u < 256; u += F.G) ssd::pass1_unit(Fp, sc, u, seg, segdec); } while (0)
#define RUN_COMB() do { OPQ(); SSD_CTX(); if (blockIdx.x < 128 || F.G != 256) ssd::combine(Fp, seg, segdec); \
        if (F.G == 256) { if (blockIdx.x >= 128) ssd::pass2_unit(Fp, sc, 128 + blockIdx.x, seg, args.in[3], args.out); } \
        else { for (int u = 256 + blockIdx.x; u < 384; u += F.G) ssd::pass2_unit(Fp, sc, u, seg, args.in[3], args.out); } } while (0)
#define RUN_SSD2() do { OPQ(); SSD_CTX(); for (int u = blockIdx.x; u < 256; u += F.G) ssd::pass2_unit(Fp, sc, u, seg, args.in[3], args.out); } while (0)
#ifndef SDUP
#define SDUP 1
#endif
#ifndef SDUPHOT
#define SDUPHOT 0
#endif
#ifndef SPF
#define SPF 0
#endif
#ifndef SPOSN
#define SPOSN 5
#endif
#define RUN_ATT() do { OPQ(); att::Ctx ac{0, (bf16*)(ws + WS_ZQ), ATT_O, (const bf16*)(ws + WS_K), (const bf16*)(ws + WS_V), (const bf16*)(ws + WS_G), args.in[16], args.in[14], args.in[15]}; att::load_bias_tabs(Fp, ac); \
        att::SCtx sx{(bf16*)(ws + WS_ZQ), ATT_O, (const bf16*)(ws + WS_K), (const bf16*)(ws + WS_V), (const bf16*)(ws + WS_G), args.in[4], args.in[5]}; att::SCtx sxd = sx; sxd.O = DRY_O; (void)sxd; \
        const int np_ = (1024 - F.vcu + F.G - 1) / F.G, pos_ = SPF ? 1 + (int)((blockIdx.x >> 3) % 4) * (np_ - 1) / 3 : (int)((blockIdx.x >> 3) % SPOSN) * np_ / (SPOSN - 1);     \
          \
        { att::bf16x8_t qc[8]; _Pragma("unroll 1") for (int i = 0; i < pos_ && i < np_; ++i) { const int u = F.vcu + i * F.G, un = u + F.G; const bool nx = i + 1 < pos_ && i + 1 < np_; \
            att::prompt_unit(Fp, ac, u >> 6, u & 63, args.in[4], args.in[5], 0, 0, 0, 0, 0, 0, qc, i > 0, nx ? un >> 6 : -1, un & 63); } } \
        _Pragma("unroll 1") for (int u = blockIdx.x; u < 512 * SDUP; u += F.G) { const bool dry_ = SDUP > 1 && u < 512 * (SDUP - 1); const int b = (SDUPHOT && dry_) ? 0 : (u & 511) >> 4, h = u & 15; att::sample_unit(Fp, dry_ ? sxd : sx, b, h); } \
        { att::bf16x8_t qc[8]; _Pragma("unroll 1") for (int i = pos_; i < np_; ++i) { const int u = F.vcu + i * F.G, un = u + F.G; const bool nx = i + 1 < np_; \
            att::prompt_unit(Fp, ac, u >> 6, u & 63, args.in[4], args.in[5], 0, 0, 0, 0, 0, 0, qc, i > pos_, nx ? un >> 6 : -1, un & 63); } } } while (0)
#define RUN_OUT() do { OPQ(); pg8::Gemm g{(const bf16*)(ws + WS_ZQ), (const bf16*)(ws + WS_WOUT), MTOK, DM, 4096, 4096}; pg8::StaticOrder S; S.init(MTOK, DM, F.G, (int)blockIdx.x, F.G == 256 ? 512 : -1); \
        pg8::EpiOut E{args.in[0], args.in[1], args.out}; \
        pg8::gemm_phase<pg8::EpiOut, pg8::StaticOrder, true, true>(F.lds + RING_OFF, g, S, E, Fp.tid); \
        if (F.G == 256) { const int t = blockIdx.x >> 3, ks = blockIdx.x & 7; pg8::OneUnit S1; S.map(512 + t, S1.u); \
            pg8::Gemm g1{(const bf16*)(ws + WS_ZQ) + ks * 512, (const bf16*)(ws + WS_WOUT) + ks * 512, MTOK, DM, 512, 4096}; \
            pg8::EpiSlab E1{(unsigned short*)(ws + WS_H) + (size_t)blockIdx.x * 65536}; \
            pg8::gemm_phase<pg8::EpiSlab, pg8::OneUnit, true, true>(F.lds + RING_OFF, g1, S1, E1, Fp.tid); } } while (0)
#define RUN_OUTRED() do { OPQ(); if (F.G == 256) { pg8::StaticOrder S; S.init(MTOK, DM, F.G, 0); pg8::Unit u; const int t = blockIdx.x >> 3, part = blockIdx.x & 7; S.map(512 + t, u); \
        const unsigned short* slab = (const unsigned short*)(ws + WS_H) + (size_t)(t * 8) * 65536; const int r0 = u.pm * 256 + part * 32; \
        typedef float f4_ __attribute__((ext_vector_type(4))); \
        f4_ a[4]; \
        _Pragma("unroll") for (int i = 0; i < 4; ++i) { const int e = Fp.tid + 512 * i, rr = e >> 6, c4 = (e & 63) * 4, row = r0 + rr, col = u.pn * 256 + c4; \
            a[i] = row < TP ? *(const f4_*)(args.in[0] + (size_t)row * DM + col) : *(const f4_*)(args.in[1] + (size_t)(row - TP) * DM + col); } \
        typedef unsigned u2_ __attribute__((ext_vector_type(2))); \
        _Pragma("unroll") for (int s = 0; s < 8; ++s) { u2_ v[4]; \
            _Pragma("unroll") for (int i = 0; i < 4; ++i) { const int e = Fp.tid + 512 * i, rr = e >> 6, c4 = (e & 63) * 4; v[i] = *(const u2_*)(slab + (size_t)s * 65536 + (part * 32 + rr) * 256 + c4); } \
            _Pragma("unroll") for (int i = 0; i < 4; ++i) { a[i].x += __builtin_bit_cast(float, v[i].x << 16); a[i].y += __builtin_bit_cast(float, v[i].x & 0xffff0000u); \
                a[i].z += __builtin_bit_cast(float, v[i].y << 16); a[i].w += __builtin_bit_cast(float, v[i].y & 0xffff0000u); } } \
        _Pragma("unroll") for (int i = 0; i < 4; ++i) { const int e = Fp.tid + 512 * i, rr = e >> 6, c4 = (e & 63) * 4, row = r0 + rr, col = u.pn * 256 + c4; *(f4_*)(args.out + (size_t)row * DM + col) = a[i]; } } } while (0)
#define RUN_ATTP(P_) do { OPQ(); att::Ctx ac{0, (bf16*)(ws + WS_ZQ), ATT_O, (const bf16*)(ws + WS_K), (const bf16*)(ws + WS_V), (const bf16*)(ws + WS_G), args.in[16], args.in[14], args.in[15]}; att::load_bias_tabs(Fp, ac); \
        att::SCtx sx{(bf16*)(ws + WS_ZQ), ATT_O, (const bf16*)(ws + WS_K), (const bf16*)(ws + WS_V), (const bf16*)(ws + WS_G), args.in[4], args.in[5]}; \
        const int np_ = (1024 - F.vcu + F.G - 1) / F.G, h_ = np_ / 2, lo_ = (P_) ? h_ : 0, hi_ = (P_) ? np_ : h_, sp_ = (int)((blockIdx.x >> 4) % 3); \
        const int mid_ = sp_ == 0 ? lo_ : (sp_ == 1 ? (lo_ + 1 < hi_ ? lo_ + 1 : hi_) : hi_); \
        { att::bf16x8_t qc[8]; _Pragma("unroll 1") for (int i = lo_; i < mid_; ++i) { const int u = F.vcu + i * F.G, un = u + F.G; const bool nx = i + 1 < mid_; \
            att::prompt_unit(Fp, ac, u >> 6, u & 63, args.in[4], args.in[5], 0, 0, 0, 0, 0, 0, qc, i > lo_, nx ? un >> 6 : -1, un & 63); } } \
        _Pragma("unroll 1") for (int u = blockIdx.x, k_ = 0; u < 512; u += F.G, ++k_) { if ((k_ & 1) == (P_)) att::sample_unit(Fp, sx, u >> 4, u & 15); } \
        { att::bf16x8_t qc[8]; _Pragma("unroll 1") for (int i = mid_; i < hi_; ++i) { const int u = F.vcu + i * F.G, un = u + F.G; const bool nx = i + 1 < hi_; \
            att::prompt_unit(Fp, ac, u >> 6, u & 63, args.in[4], args.in[5], 0, 0, 0, 0, 0, 0, qc, i > mid_, nx ? un >> 6 : -1, un & 63); } } } while (0)
#define RUN_SSD1_ATT() do { const bool af_ = ((blockIdx.x >> 3) & 1) != 0; if (af_) { RUN_ATTP(0); RUN_SSD1(); } else { RUN_SSD1(); RUN_ATTP(0); } } while (0)
#define RUN_SSD2_ATTB() do { const bool af_ = ((blockIdx.x >> 3) & 1) == 0;     if (af_) { RUN_ATTP(1); RUN_SSD2(); } else { RUN_SSD2(); RUN_ATTP(1); } } while (0)
#define RUN_SSD2_ATT() do { const bool af_ = ((blockIdx.x >> 3) & 1) != 0; if (af_) { RUN_ATT(); RUN_SSD2(); } else { RUN_SSD2(); RUN_ATT(); } } while (0)
#define BAR() xcd_barrier(bar)
#ifndef PHASE_PROGRAM
#define PHASE_PROGRAM RUN_W(); RUN_X(); BAR(); RUN_INPROJ(); BAR(); RUN_SSD1_ATT(); BAR(); RUN_COMB(); BAR(); RUN_SSD2_ATTB(); BAR(); RUN_OUT(); BAR(); RUN_OUTRED();
#endif
    PHASE_PROGRAM
}
extern "C" void kernel_launch(void* const* d_in, const int* in_sizes, int n_in, void* d_out, int out_size, void* d_ws, size_t ws_size, hipStream_t stream) {
    static int grid = 0;
    if (grid == 0) {
        if (n_in != 18 || in_sizes[0] != TP * DM || (size_t)out_size != O_END || ws_size < WS_END) { fprintf(stderr, "kernel_launch: shape mismatch n_in %d in0 %d out %d ws %zu (need %zu)\n", n_in, n_in > 0 ? in_sizes[0] : -1, out_size, ws_size, (size_t)WS_END); grid = -1; return; }
        int dev = 0, cus = 0;
        if (hipGetDevice(&dev) != hipSuccess || hipDeviceGetAttribute(&cus, hipDeviceAttributeMultiprocessorCount, dev) != hipSuccess) { grid = -1; return; }
        if (hipFuncSetAttribute((const void*)hyb_fwd, hipFuncAttributeMaxDynamicSharedMemorySize, LDS_BYTES) != hipSuccess) { fprintf(stderr, "kernel_launch: hipFuncSetAttribute failed\n"); grid = -1; return; }
        (void)hipGetLastError();
        grid = cus;
    }
    if (grid < 0) return;
    if (hipMemsetAsync((char*)d_ws + WS_CTL, 0, CTL_ZERO_BYTES, stream) != hipSuccess) return;
    Args a{};
    for (int i = 0; i < 18; ++i) a.in[i] = (const float*)d_in[i];
    a.out = (float*)d_out; a.ws = (unsigned char*)d_ws;
    hipLaunchKernelGGL(hyb_fwd, dim3(grid), dim3(NWAVES * 64), LDS_BYTES, stream, a);
}
```
